# Optimizing an MI355X kernel written in HIP

```python
import math
import jax, jax.numpy as jnp
from jax import lax
import numpy as np

D_MODEL = 2048
BATCH = 8
SEQ = 2048
DEPTH = 1

PLE_DIM = 256
MIX_WIDTH = D_MODEL
N_HEADS = 8
QK_NOPE_DIM = 128
QK_ROPE_DIM = 64
V_HEAD_DIM = 128
QK_HEAD_DIM = QK_NOPE_DIM + QK_ROPE_DIM
Q_LORA = 512
KV_LORA = 256
ATTN_WIDTH = N_HEADS * V_HEAD_DIM
ROPE_THETA = 10000.0
Q_BLOCK = 128
SSM_WIDTH = MIX_WIDTH - ATTN_WIDTH
SSM_GROUP = 16
SSM_GROUPS = SSM_WIDTH // SSM_GROUP
SSM_STATE = 64
DT_MIN = 1e-3
DT_MAX = 1e-1
N_IN = Q_LORA + KV_LORA + QK_ROPE_DIM + SSM_WIDTH
D_FF = int(math.ceil((8 * D_MODEL / 3) / 256) * 256)
EPS = 1e-6

kernel_name = "hybrid_mla_s5_parallel_heads"


def rms_norm(t, g):
    tf = t.astype(jnp.float32)
    y = tf * lax.rsqrt(jnp.mean(tf * tf, axis=-1, keepdims=True) + EPS)
    return (y * g.astype(jnp.float32)).astype(t.dtype)


def rope_tables(positions):
    inv_freq = 1.0 / (ROPE_THETA ** (jnp.arange(0, QK_ROPE_DIM, 2, dtype=jnp.float32) / QK_ROPE_DIM))
    ang = positions.astype(jnp.float32)[..., None] * inv_freq
    return jnp.cos(ang)[:, None], jnp.sin(ang)[:, None]


def apply_rope(t, cos, sin):
    half = QK_ROPE_DIM // 2
    t1 = t[..., :half].astype(jnp.float32)
    t2 = t[..., half:].astype(jnp.float32)
    return jnp.concatenate([t1 * cos - t2 * sin, t2 * cos + t1 * sin], axis=-1).astype(t.dtype)


def causal_block_attention(q, k, v):
    L = q.shape[2]
    scale = QK_HEAD_DIM ** -0.5
    outs = []
    for i in range(L // Q_BLOCK):
        kv_len = (i + 1) * Q_BLOCK
        q_blk = q[:, :, i * Q_BLOCK:kv_len]
        s = jnp.einsum('bhqd,bhkd->bhqk', q_blk, k[:, :, :kv_len]).astype(jnp.float32) * scale
        q_idx = i * Q_BLOCK + jnp.arange(Q_BLOCK)[:, None]
        k_idx = jnp.arange(kv_len)[None, :]
        s = jnp.where(k_idx <= q_idx, s, -jnp.inf)
        pr = jax.nn.softmax(s, axis=-1).astype(v.dtype)
        outs.append(jnp.einsum('bhqk,bhkd->bhqd', pr, v[:, :, :kv_len]))
    return jnp.concatenate(outs, axis=2)


def mla_mixer(z_q, z_kv, z_kr, cos, sin, g_q_lora, w_uq, g_kv_lora, w_ukv, g_q_head, g_k_head):
    B_, L, _ = z_q.shape
    c_q = rms_norm(z_q, g_q_lora)
    q = (c_q @ w_uq).reshape(B_, L, N_HEADS, QK_HEAD_DIM)
    c_kv = rms_norm(z_kv, g_kv_lora)
    kv = (c_kv @ w_ukv).reshape(B_, L, N_HEADS, QK_NOPE_DIM + V_HEAD_DIM)
    k_nope, v = kv[..., :QK_NOPE_DIM], kv[..., QK_NOPE_DIM:]
    k_rope = jnp.broadcast_to(z_kr[:, :, None, :], (B_, L, N_HEADS, QK_ROPE_DIM))
    k = jnp.concatenate([k_nope, k_rope], axis=-1)
    q = rms_norm(q, g_q_head).transpose(0, 2, 1, 3)
    k = rms_norm(k, g_k_head).transpose(0, 2, 1, 3)
    v = v.transpose(0, 2, 1, 3)
    q = jnp.concatenate([q[..., :QK_NOPE_DIM], apply_rope(q[..., QK_NOPE_DIM:], cos, sin)], axis=-1)
    k = jnp.concatenate([k[..., :QK_NOPE_DIM], apply_rope(k[..., QK_NOPE_DIM:], cos, sin)], axis=-1)
    o = causal_block_attention(q, k, v)
    return o.transpose(0, 2, 1, 3).reshape(B_, L, ATTN_WIDTH)


def _ssm_combine(earlier, later):
    ar_i, ai_i, br_i, bi_i = earlier
    ar_j, ai_j, br_j, bi_j = later
    ar = ar_j * ar_i - ai_j * ai_i
    ai = ar_j * ai_i + ai_j * ar_i
    br = ar_j * br_i - ai_j * bi_i + br_j
    bi = ar_j * bi_i + ai_j * br_i + bi_j
    return ar, ai, br, bi


def s5_mixer(u, lam_re, lam_im, log_dt, b_re, b_im, c_re, c_im, d_skip, w_glu, b_glu):
    B_, L, _ = u.shape
    f32 = jnp.float32
    uf = u.astype(f32).reshape(B_, L, SSM_GROUPS, SSM_GROUP)
    lr = jnp.minimum(lam_re.astype(f32), -1e-4)
    li = lam_im.astype(f32)
    dt = jnp.exp(log_dt.astype(f32))[:, None]
    mag = jnp.exp(lr * dt)
    abar_re = mag * jnp.cos(li * dt)
    abar_im = mag * jnp.sin(li * dt)
    den = lr * lr + li * li
    num_re = abar_re - 1.0
    num_im = abar_im
    coef_re = (num_re * lr + num_im * li) / den
    coef_im = (num_im * lr - num_re * li) / den
    br = b_re.astype(f32)
    bim = b_im.astype(f32)
    bb_re = coef_re[..., None] * br - coef_im[..., None] * bim
    bb_im = coef_re[..., None] * bim + coef_im[..., None] * br
    bu_re = jnp.einsum('blgh,gph->blgp', uf, bb_re)
    bu_im = jnp.einsum('blgh,gph->blgp', uf, bb_im)
    a_re = jnp.broadcast_to(abar_re[None, None], (1, L, SSM_GROUPS, SSM_STATE))
    a_im = jnp.broadcast_to(abar_im[None, None], (1, L, SSM_GROUPS, SSM_STATE))
    _, _, s_re, s_im = lax.associative_scan(_ssm_combine, (a_re, a_im, bu_re, bu_im), axis=1)
    y = (jnp.einsum('blgp,ghp->blgh', s_re, c_re.astype(f32))
         - jnp.einsum('blgp,ghp->blgh', s_im, c_im.astype(f32))
         + d_skip.astype(f32) * uf)
    y = jax.nn.gelu(y.reshape(B_, L, SSM_WIDTH).astype(u.dtype))
    return y * jax.nn.sigmoid(y @ w_glu + b_glu)


def setup_inputs(seed: int = 0) -> dict:
    key = jax.random.key(seed)
    ks = jax.random.split(key, 32)
    f32 = jnp.float32

    def nrm(k, shape, scale):
        return jax.random.normal(k, shape, f32) * scale

    def gain(k, n):
        return 1.0 + 0.01 * jax.random.normal(k, (DEPTH, n), f32)

    x = jax.random.normal(ks[0], (BATCH, SEQ, D_MODEL), f32)
    p = jax.random.normal(ks[1], (DEPTH, BATCH, SEQ, PLE_DIM), f32)
    offs = jax.random.randint(ks[2], (BATCH, 1), 0, 1024, dtype=jnp.int32)
    positions = (jnp.arange(SEQ, dtype=jnp.int32)[None, :] + offs).astype(jnp.int32)

    G, P, H = SSM_GROUPS, SSM_STATE, SSM_GROUP
    lam_re = -0.5 + 0.01 * jax.random.normal(ks[3], (DEPTH, G, P), f32)
    lam_im = (math.pi * jnp.arange(P, dtype=f32))[None, None] + 0.01 * jax.random.normal(ks[4], (DEPTH, G, P), f32)
    log_dt = jax.random.uniform(ks[5], (DEPTH, G), f32, math.log(DT_MIN), math.log(DT_MAX))

    return {
        "x": x,
        "p": p,
        "positions": positions,
        "g_mix_norm": gain(ks[6], D_MODEL),
        "w_in": nrm(ks[7], (DEPTH, D_MODEL, N_IN), D_MODEL ** -0.5),
        "g_q_lora": gain(ks[8], Q_LORA),
        "w_uq": nrm(ks[9], (DEPTH, Q_LORA, N_HEADS * QK_HEAD_DIM), Q_LORA ** -0.5),
        "g_kv_lora": gain(ks[10], KV_LORA),
        "w_ukv": nrm(ks[11], (DEPTH, KV_LORA, N_HEADS * (QK_NOPE_DIM + V_HEAD_DIM)), KV_LORA ** -0.5),
        "g_q_head": gain(ks[12], QK_HEAD_DIM),
        "g_k_head": gain(ks[13], QK_HEAD_DIM),
        "lam_re": lam_re,
        "lam_im": lam_im,
        "log_dt": log_dt,
        "b_re": nrm(ks[14], (DEPTH, G, P, H), (2 * H) ** -0.5),
        "b_im": nrm(ks[15], (DEPTH, G, P, H), (2 * H) ** -0.5),
        "c_re": nrm(ks[16], (DEPTH, G, H, P), (2 * P) ** -0.5 * 4.0),
        "c_im": nrm(ks[17], (DEPTH, G, H, P), (2 * P) ** -0.5 * 4.0),
        "d_skip": nrm(ks[18], (DEPTH, G, H), 1.0),
        "w_glu": nrm(ks[19], (DEPTH, SSM_WIDTH, SSM_WIDTH), SSM_WIDTH ** -0.5),
        "b_glu": nrm(ks[20], (DEPTH, SSM_WIDTH), 0.01),
        "g_out_attn": gain(ks[21], ATTN_WIDTH),
        "g_out_ssm": gain(ks[22], SSM_WIDTH),
        "w_o": nrm(ks[23], (DEPTH, MIX_WIDTH, D_MODEL), MIX_WIDTH ** -0.5),
        "g_ffn_norm": gain(ks[24], D_MODEL),
        "w_gate": nrm(ks[25], (DEPTH, D_MODEL, D_FF), D_MODEL ** -0.5),
        "w_up": nrm(ks[26], (DEPTH, D_MODEL, D_FF), D_MODEL ** -0.5),
        "w_down": nrm(ks[27], (DEPTH, D_FF, D_MODEL), D_FF ** -0.5),
        "g_ple_norm": gain(ks[28], D_MODEL),
        "w_ple_gate": nrm(ks[29], (DEPTH, D_MODEL, D_MODEL), D_MODEL ** -0.5),
        "w_ple_proj": nrm(ks[30], (DEPTH, PLE_DIM, D_MODEL), PLE_DIM ** -0.5),
    }


def reference(x, p, positions, g_mix_norm, w_in, g_q_lora, w_uq, g_kv_lora, w_ukv,
              g_q_head, g_k_head, lam_re, lam_im, log_dt, b_re, b_im, c_re, c_im, d_skip,
              w_glu, b_glu, g_out_attn, g_out_ssm, w_o, g_ffn_norm, w_gate, w_up, w_down,
              g_ple_norm, w_ple_gate, w_ple_proj):
    cos, sin = rope_tables(positions)
    o1 = Q_LORA
    o2 = o1 + KV_LORA
    o3 = o2 + QK_ROPE_DIM
    for i in range(DEPTH):
        h = rms_norm(x, g_mix_norm[i])
        z = h @ w_in[i]
        o_attn = mla_mixer(z[..., :o1], z[..., o1:o2], z[..., o2:o3], cos, sin,
                           g_q_lora[i], w_uq[i], g_kv_lora[i], w_ukv[i],
                           g_q_head[i], g_k_head[i])
        o_ssm = s5_mixer(z[..., o3:], lam_re[i], lam_im[i], log_dt[i], b_re[i], b_im[i],
                         c_re[i], c_im[i], d_skip[i], w_glu[i], b_glu[i])
        mixed = jnp.concatenate([rms_norm(o_attn, g_out_attn[i]),
                                 rms_norm(o_ssm, g_out_ssm[i])], axis=-1)
        x = x + mixed @ w_o[i]
        hf = rms_norm(x, g_ffn_norm[i])
        x = x + (jax.nn.silu(hf @ w_gate[i]) * (hf @ w_up[i])) @ w_down[i]
        gate = jax.nn.sigmoid(rms_norm(x, g_ple_norm[i]) @ w_ple_gate[i])
        x = x + gate * (p[i] @ w_ple_proj[i])
    return x
```

```cpp
#include <hip/hip_runtime.h>
#include <cstdio>
#include <cstdint>
namespace pg8 {
#define PG8_LAS __attribute__((address_space(3)))
typedef unsigned short bf16_t;
typedef short bf16x8 __attribute__((ext_vector_type(8)));
typedef float f32x4 __attribute__((ext_vector_type(4)));
typedef unsigned u32x4 __attribute__((ext_vector_type(4)));
constexpr int BM = 256, BK = 64, HALF = 128, HTB = HALF * BK * 2  , STAGE_BYTES = 8 * HTB, NXCD = 8, WGM = 8;

__host__ __device__ __forceinline__ int lds_byte(int r, int c) { const int st = (r >> 4) * 2 + (c >> 5), rr = r & 15, cc = c & 31, ob = rr * 64 + cc * 2; return st * 1024 + (ob ^ (((ob >> 9) & 1) << 5)); }
__host__ __device__ __forceinline__ void stage_rc(int b, int& R, int& C) { const int st = b / 1024, sb = b % 1024, swz = sb ^ (((sb >> 9) & 1) << 5); R = (st >> 1) * 16 + swz / 64; C = (st & 1) * 32 + (swz % 64) / 2; }
__host__ __device__ __forceinline__ int perm32(int rho) { const int n = rho >> 4, i = rho & 15; return 8 * (i >> 2) + 4 * n + (i & 3); }

struct Unit { int pm, pn; };
struct Gemm { const bf16_t* A; const bf16_t* Bt; int M, N, K, lda, ldb; };

struct StaticOrder {
    int nM, nN, nwg, G, c;
    __host__ __device__ void init(int M, int N, int G_, int c_) { nM = M / BM; nN = N / BM; nwg = nM * nN; G = G_; c = c_; }
    __host__ __device__ bool next(int i, Unit& u) const {
        const long L = (long)i * G + c; if (L >= nwg) return false;
        int wgid = (int)L; { const int q = nwg / NXCD, r = nwg % NXCD, xcd = wgid % NXCD, off = wgid / NXCD; wgid = (xcd < r ? xcd * (q + 1) : r * (q + 1) + (xcd - r) * q) + off; }
        const int nig = WGM * nN, gid = wgid / nig, fm = gid * WGM, gsz = (nM - fm) < WGM ? (nM - fm) : WGM;
        u.pm = fm + ((wgid % nig) % gsz); u.pn = (wgid % nig) / gsz; return true;
    }
    __device__ __forceinline__ void a_ready(const Unit&) const {}
    __device__ __forceinline__ void done(const Unit&) const {}
};

__device__ __forceinline__ unsigned cvt_pk_bf16(float lo, float hi) { unsigned r; asm volatile("v_cvt_pk_bf16_f32 %0, %1, %2" : "=v"(r) : "v"(lo), "v"(hi)); return r; }
typedef float f32x2 __attribute__((ext_vector_type(2)));
template <class Epi, class Sched, bool ALIGN_EPI = false, bool SP2 = false>
__device__ __forceinline__ void gemm_phase(PG8_LAS unsigned char* lds, const Gemm g, const Sched& S, const Epi& E) {
    const int tid = threadIdx.x, wid = __builtin_amdgcn_readfirstlane(tid >> 6), lane = tid & 63, wr = wid >> 2, wc = wid & 3, fr = lane & 15, fq = lane >> 4;
    const int K = g.K, nt = K / BK;
    unsigned voffA[2], voffB[2];
#pragma unroll
    for (int i = 0; i < 2; ++i) { int R, C; stage_rc(tid * 16 + i * 8192, R, C); const int Rb = Epi::PERM ? ((R & ~31) + perm32(R & 31)) : R;
        voffA[i] = (unsigned)(R * g.lda + C) * 2u; voffB[i] = (unsigned)(Rb * g.ldb + C) * 2u; }
    const size_t kstep = (size_t)(BK * 2);
    const size_t hstepA = (size_t)HALF * g.lda * 2, hstepB = (size_t)HALF * g.ldb * 2;
    const size_t tstepA = 2 * hstepA, tstepB = 2 * hstepB;
    const unsigned ldsw = (unsigned)wid * 1024u;
    const int aoff = lds_byte(wr * 64 + fr, fq * 8), boff = lds_byte(wc * 32 + fr, fq * 8);
#define PG8_SA(b, h) (((b) * 2 + (h)) * HTB)
#define PG8_SB(b, h) ((4 + (b) * 2 + (h)) * HTB)
#define PG8_STAGE(bufoff, gbase, voff) do { _Pragma("unroll") for (int _i = 0; _i < 2; ++_i) \
        __builtin_amdgcn_global_load_lds((const unsigned*)((const char*)(gbase) + (voff)[_i]), (PG8_LAS unsigned*)(lds + (bufoff) + ldsw + _i * 8192), 16, 0, 0); } while (0)
#define PG8_LDA(dst, b, h) do { _Pragma("unroll") for (int m = 0; m < 4; ++m) _Pragma("unroll") for (int k = 0; k < 2; ++k) dst[m][k] = *(const PG8_LAS bf16x8*)(lds + PG8_SA(b, h) + aoff + m * 2048 + k * 1024); } while (0)
#define PG8_LDB(dst, b, h) do { _Pragma("unroll") for (int n = 0; n < 2; ++n) _Pragma("unroll") for (int k = 0; k < 2; ++k) dst[n][k] = *(const PG8_LAS bf16x8*)(lds + PG8_SB(b, h) + boff + n * 2048 + k * 1024); } while (0)
#define PG8_MMA(ai, bj, At, Bt) do { __builtin_amdgcn_s_setprio(1); _Pragma("unroll") for (int m = 0; m < 4; ++m) _Pragma("unroll") for (int n = 0; n < 2; ++n) _Pragma("unroll") for (int k = 0; k < 2; ++k) \
        acc[ai][bj][m][n] = __builtin_amdgcn_mfma_f32_16x16x32_bf16(Bt[n][k], At[m][k], acc[ai][bj][m][n], 0, 0, 0); __builtin_amdgcn_s_setprio(0); } while (0)
#define PG8_WAIT_V(n) asm volatile("s_waitcnt vmcnt(" #n ")" ::: "memory")
#define PG8_WAIT_L(n) asm volatile("s_waitcnt lgkmcnt(" #n ")" ::: "memory")
#define PG8_BAR __builtin_amdgcn_s_barrier()
#define PG8_SCHED __builtin_amdgcn_sched_barrier(0)
    Unit cur, nxt; int ui = 0;
    if (!S.next(0, cur)) return;
    f32x4 acc[2][2][4][2];
#pragma unroll
    for (int a = 0; a < 2; ++a)
#pragma unroll
        for (int b = 0; b < 2; ++b)
#pragma unroll
            for (int m = 0; m < 4; ++m)
#pragma unroll
                for (int n = 0; n < 2; ++n) acc[a][b][m][n] = (f32x4){0.f, 0.f, 0.f, 0.f};
    bf16x8 At[4][2], B0[2][2], B1[2][2];
    const char* cA = (const char*)g.A + (size_t)cur.pm * tstepA; const char* cB = (const char*)g.Bt + (size_t)cur.pn * tstepB;
    S.a_ready(cur);
    if constexpr (SP2) {
        PG8_STAGE(PG8_SB(0, 0), cB, voffB); PG8_STAGE(PG8_SB(0, 1), cB + hstepB, voffB); PG8_STAGE(PG8_SA(0, 0), cA, voffA); PG8_STAGE(PG8_SA(0, 1), cA + hstepA, voffA);
        if (wr == 1) PG8_BAR;
        PG8_WAIT_V(2); PG8_BAR;
        PG8_STAGE(PG8_SB(1, 0), cB + kstep, voffB); PG8_STAGE(PG8_SA(1, 0), cA + kstep, voffA); PG8_STAGE(PG8_SB(1, 1), cB + hstepB + kstep, voffB);
        PG8_WAIT_V(6); PG8_BAR;
    } else {
        PG8_STAGE(PG8_SB(0, 0), cB, voffB); PG8_STAGE(PG8_SA(0, 0), cA, voffA); PG8_STAGE(PG8_SB(0, 1), cB + hstepB, voffB); PG8_STAGE(PG8_SA(0, 1), cA + hstepA, voffA);
        if (wr == 1) PG8_BAR;
        PG8_WAIT_V(4); PG8_BAR;
        PG8_STAGE(PG8_SB(1, 0), cB + kstep, voffB); PG8_STAGE(PG8_SA(1, 0), cA + kstep, voffA); PG8_STAGE(PG8_SB(1, 1), cB + hstepB + kstep, voffB);
        PG8_WAIT_V(6); PG8_BAR;
    }
    for (;;) {
        const bool has_next = S.next(ui + 1, nxt);
        const char* nA = has_next ? (const char*)g.A + (size_t)nxt.pm * tstepA : cA; const char* nB = has_next ? (const char*)g.Bt + (size_t)nxt.pn * tstepB : cB;
        for (int t = 0; t < nt; t += 2) {
            const bool last = (t == nt - 2);
            const char* a1 = cA + (size_t)(t + 1) * kstep;
            const char* a2 = last ? nA : cA + (size_t)(t + 2) * kstep; const char* b2 = last ? nB : cB + (size_t)(t + 2) * kstep;
            const char* a3 = a2 + kstep; const char* b3 = b2 + kstep;
            if (last && has_next) S.a_ready(nxt);
            if constexpr (SP2) {
            PG8_LDB(B0, 0, 0); PG8_LDB(B1, 0, 1); PG8_SCHED; PG8_LDA(At, 0, 0); PG8_STAGE(PG8_SA(1, 1), a1 + hstepA, voffA);
            PG8_WAIT_V(8); PG8_WAIT_L(0); PG8_BAR; PG8_MMA(0, 0, At, B0); PG8_MMA(0, 1, At, B1); PG8_BAR; PG8_SCHED;
            PG8_LDA(At, 0, 1); PG8_STAGE(PG8_SB(0, 0), b2, voffB); PG8_STAGE(PG8_SB(0, 1), b2 + hstepB, voffB); PG8_STAGE(PG8_SA(0, 0), a2, voffA);
            PG8_WAIT_V(8); PG8_WAIT_L(0); PG8_BAR; PG8_MMA(1, 0, At, B0); PG8_MMA(1, 1, At, B1); PG8_BAR; PG8_SCHED;
            PG8_LDB(B0, 1, 0); PG8_LDB(B1, 1, 1); PG8_SCHED; PG8_LDA(At, 1, 0); PG8_STAGE(PG8_SA(0, 1), a2 + hstepA, voffA);
            PG8_WAIT_V(8); PG8_WAIT_L(0); PG8_BAR; PG8_MMA(0, 0, At, B0); PG8_MMA(0, 1, At, B1); PG8_BAR; PG8_SCHED;
            PG8_LDA(At, 1, 1); PG8_STAGE(PG8_SB(1, 0), b3, voffB); PG8_STAGE(PG8_SB(1, 1), b3 + hstepB, voffB); PG8_STAGE(PG8_SA(1, 0), a3, voffA);
            PG8_WAIT_V(8); PG8_WAIT_L(0); PG8_BAR; PG8_MMA(1, 0, At, B0); PG8_MMA(1, 1, At, B1); PG8_BAR; PG8_SCHED;
            } else {
            PG8_LDB(B0, 0, 0); PG8_SCHED; PG8_LDA(At, 0, 0); PG8_STAGE(PG8_SA(1, 1), a1 + hstepA, voffA);
            PG8_WAIT_L(8); PG8_BAR; PG8_WAIT_L(0); PG8_MMA(0, 0, At, B0); PG8_BAR; PG8_SCHED;
            PG8_LDB(B1, 0, 1); PG8_STAGE(PG8_SB(0, 0), b2, voffB);
            PG8_BAR; PG8_WAIT_L(0); PG8_MMA(0, 1, At, B1); PG8_BAR;
            PG8_LDA(At, 0, 1); PG8_STAGE(PG8_SA(0, 0), a2, voffA);
            PG8_BAR; PG8_WAIT_L(0); PG8_MMA(1, 0, At, B0); PG8_BAR; PG8_SCHED;
            PG8_STAGE(PG8_SB(0, 1), b2 + hstepB, voffB);
            PG8_WAIT_V(6); PG8_BAR; PG8_MMA(1, 1, At, B1); PG8_BAR;
            PG8_LDB(B0, 1, 0); PG8_SCHED; PG8_LDA(At, 1, 0); PG8_STAGE(PG8_SA(0, 1), a2 + hstepA, voffA);
            PG8_WAIT_L(8); PG8_BAR; PG8_WAIT_L(0); PG8_MMA(0, 0, At, B0); PG8_BAR; PG8_SCHED;
            PG8_LDB(B1, 1, 1); PG8_STAGE(PG8_SB(1, 0), b3, voffB);
            PG8_BAR; PG8_WAIT_L(0); PG8_MMA(0, 1, At, B1); PG8_BAR;
            PG8_LDA(At, 1, 1); PG8_STAGE(PG8_SA(1, 0), a3, voffA);
            PG8_BAR; PG8_WAIT_L(0); PG8_MMA(1, 0, At, B0); PG8_BAR; PG8_SCHED;
            PG8_STAGE(PG8_SB(1, 1), b3 + hstepB, voffB);
            PG8_WAIT_V(6); PG8_BAR; PG8_MMA(1, 1, At, B1); PG8_BAR;
            }
        }
        if constexpr (ALIGN_EPI) { if (wr == 0) PG8_BAR; }
        if constexpr (!Epi::AFTER_DRAIN) { E(acc, cur, wr, wc, fr, fq); S.done(cur); }
        if (!has_next) break;
#pragma unroll
        for (int a = 0; a < 2; ++a)
#pragma unroll
            for (int b = 0; b < 2; ++b)
#pragma unroll
                for (int m = 0; m < 4; ++m)
#pragma unroll
                    for (int n = 0; n < 2; ++n) acc[a][b][m][n] = (f32x4){0.f, 0.f, 0.f, 0.f};
        cur = nxt; cA = nA; cB = nB; ++ui;
        if constexpr (ALIGN_EPI) { if (wr == 1) PG8_BAR; }
    }
    PG8_WAIT_V(0);
    if constexpr (!ALIGN_EPI) { if (wr == 0) PG8_BAR; }
    PG8_BAR;
    if constexpr (Epi::AFTER_DRAIN) { E.fused(acc, cur, wr, wc, fr, fq, lds, wid, lane); S.done(cur); }
#undef PG8_SA
#undef PG8_SB
#undef PG8_STAGE
#undef PG8_LDA
#undef PG8_LDB
#undef PG8_MMA
#undef PG8_WAIT_V
#undef PG8_WAIT_L
#undef PG8_BAR
#undef PG8_SCHED
}
}

#ifndef PG8_SP2
#define PG8_SP2 true
#endif
#ifndef PG8_ALIGN
#define PG8_ALIGN true
#endif
#ifndef MK_N_LAUNCHES
#define MK_N_LAUNCHES 10
#endif

constexpr int M = 16384, SEQ = 2048, NB = 8, D = 2048, NH = 8, DQK = 192, DV = 128;
constexpr int QL = 512, KVL = 256, NG = 64, GH = 16, NP = 64, FF = 5632, PLE = 256, SSMW = 1024;
constexpr float EPS = 1e-6f;
constexpr int ZC_Q = 0, ZC_KV = 512, ZC_U = 768, ZC_KR = 1792, ZLD = 2048;
constexpr int NPHASES = 10;

constexpr size_t MiB = 1u << 20;
constexpr size_t WS_CTL = 0, CTL_ZERO_BYTES = 1 * MiB;
constexpr int CW_BAR = 4096;
constexpr size_t SQ_Q = 65536 * 1, SQ_KV = 65536 * 2, SQ_X1 = 65536 * 3, SQ_X2 = 65536 * 4;
constexpr size_t WS_ABAR = 1 * MiB, WS_BBR = 1 * MiB + 65536, WS_BBI = 1 * MiB + 65536 + 262144;
constexpr size_t WS_WIN = 2 * MiB, WS_WUQ = 10 * MiB, WS_WUKV = 12 * MiB, WS_WGLU = 13 * MiB, WS_WO = 15 * MiB, WS_WGU = 23 * MiB, WS_WDN = 67 * MiB, WS_WPG = 89 * MiB, WS_WPP = 97 * MiB;
constexpr size_t WS_HN = 100 * MiB;
constexpr size_t WS_Z = 164 * MiB;
constexpr size_t WS_QRAW = 228 * MiB, WS_KVRAW = 276 * MiB;
constexpr size_t WS_Q = 340 * MiB, WS_K = 388 * MiB, WS_V = 436 * MiB;
constexpr size_t WS_YG = 468 * MiB, WS_PB = 500 * MiB;
constexpr size_t WS_OA = 228 * MiB, WS_OS = 260 * MiB;
constexpr size_t WS_H = 228 * MiB, WS_PP = 404 * MiB, WS_END = 508 * MiB;

constexpr int RING_BYTES = 131072, MISC_OFF = 139264 + 320, LDS_BYTES = 147456;
constexpr int NWAVES = 8;

#define GAS __attribute__((address_space(1)))
#define LAS __attribute__((address_space(3)))
typedef unsigned short bf16;
typedef unsigned v4u __attribute__((ext_vector_type(4)));
typedef unsigned v2u __attribute__((ext_vector_type(2)));
typedef float f32x4 __attribute__((ext_vector_type(4)));
typedef GAS unsigned gu32;
#define LDS_WAIT() asm volatile("s_waitcnt lgkmcnt(0)" ::: "memory")
__device__ __forceinline__ unsigned f2bf(float f) { unsigned u = __builtin_bit_cast(unsigned, f); return (u + 0x7fffu + ((u >> 16) & 1u)) >> 16; }
__device__ __forceinline__ unsigned pk2(float lo, float hi) { return f2bf(lo) | (f2bf(hi) << 16); }
__device__ __forceinline__ float bf2f(unsigned h) { return __builtin_bit_cast(float, h << 16); }
__device__ __forceinline__ float bflo(unsigned w) { return __builtin_bit_cast(float, w << 16); }
__device__ __forceinline__ float bfhi(unsigned w) { return __builtin_bit_cast(float, w & 0xffff0000u); }
__device__ __forceinline__ float wave_sum(float v) {
#pragma unroll
    for (int o = 1; o < 64; o <<= 1) v += __shfl_xor(v, o);
    return v;
}
__device__ __forceinline__ float wave_max(float v) {
#pragma unroll
    for (int o = 1; o < 64; o <<= 1) v = fmaxf(v, __shfl_xor(v, o));
    return v;
}
__device__ __forceinline__ float sigmoid_f(float v) { return __builtin_amdgcn_rcpf(1.0f + __builtin_amdgcn_exp2f(-1.4426950408889634f * v)); }
__device__ __forceinline__ float gelu_tanh(float v) {
    const float z = 0.7978845608028654f * (v + 0.044715f * v * v * v);
    const float e = __builtin_amdgcn_exp2f(2.0f * 1.4426950408889634f * z);
    const float th = 1.0f - 2.0f * __builtin_amdgcn_rcpf(e + 1.0f);
    return 0.5f * v * (1.0f + th);
}

#define XB_TMO      128
#define XB_XCNT(j)  (256  + 64 * (j))
#define XB_XSUB(j)  (1280 + 64 * (j))
#define XB_XGEN(j)  (2304 + 64 * (j))
#define XB_TOP      3328
#define XB_TOPGEN   3392
#define XCD_BAR_WORDS 3456
#define XB_SPIN_CAP (1u << 18)
__device__ __forceinline__ unsigned xb_ld(unsigned* p)              { return __hip_atomic_load(p, __ATOMIC_RELAXED, __HIP_MEMORY_SCOPE_AGENT); }
__device__ __forceinline__ unsigned xb_add(unsigned* p, unsigned v) { return __hip_atomic_fetch_add(p, v, __ATOMIC_RELAXED, __HIP_MEMORY_SCOPE_AGENT); }
__device__ __forceinline__ unsigned xb_xcc_id() { return (unsigned)__builtin_amdgcn_s_getreg((3 << 11) | 20) & 0xFu; }
#define XB_SPIN(cond, bar) do { unsigned _sp = 0; while (cond) { __builtin_amdgcn_s_sleep(1); \
    if ((++_sp & 255u) == 0u) { if (xb_ld(&(bar)[XB_TMO])) break; if (_sp > XB_SPIN_CAP) { atomicAdd(&(bar)[XB_TMO], 1u); break; } } } } while (0)
struct XcdBarrier { unsigned* bar; unsigned x; volatile LAS unsigned* st; };
__device__ __forceinline__ XcdBarrier xcd_barrier_post(unsigned* bar, volatile LAS unsigned* st) {
    XcdBarrier b; b.bar = bar; b.x = xb_xcc_id(); b.st = st;
    if (threadIdx.x == 0) (void)xb_add(&bar[XB_XCNT(b.x)], 1u);
    return b;
}
__device__ __forceinline__ void xcd_barrier_complete(unsigned* bar, unsigned x, unsigned& nloc, unsigned& nx) {
    const unsigned G = gridDim.x * gridDim.y * gridDim.z;
    unsigned sum, cnt, mine, sp = 0u;
    for (;;) {
        sum = 0u; cnt = 0u; mine = 0u;
#pragma unroll
        for (unsigned j = 0; j < 16; ++j) { const unsigned c = xb_ld(&bar[XB_XCNT(j)]); sum += c; cnt += (c > 0u) ? 1u : 0u; mine = (j == x) ? c : mine; }
        if (sum == G) break;
        __builtin_amdgcn_s_sleep(1);
        if ((++sp & 255u) == 0u) { if (xb_ld(&bar[XB_TMO])) break; if (sp > XB_SPIN_CAP) { atomicAdd(&bar[XB_TMO], 1u); break; } }
    }
    nloc = mine > 0u ? mine : 1u; nx = cnt > 0u ? cnt : 1u;
}
__device__ __forceinline__ void xcd_barrier(const XcdBarrier& b) {
    asm volatile("s_waitcnt vmcnt(0)" ::: "memory");
    __syncthreads();
    if (threadIdx.x == 0) {
        unsigned* bar = b.bar;
        __builtin_amdgcn_s_waitcnt(0);
        unsigned nloc = b.st[0], nx = b.st[1];
        if (nloc == 0u) { xcd_barrier_complete(bar, b.x, nloc, nx); b.st[0] = nloc; b.st[1] = nx; }
        const unsigned old = xb_add(&bar[XB_XSUB(b.x)], 1u);
        const unsigned gen = old / nloc;
        if (old + 1u == (gen + 1u) * nloc) {
            __builtin_amdgcn_fence(__ATOMIC_RELEASE, "agent");
            asm volatile("s_waitcnt vmcnt(0)" ::: "memory");
            const unsigned og = xb_add(&bar[XB_TOP], 1u);
            const unsigned tg = og / nx;
            if (og + 1u == (tg + 1u) * nx) xb_add(&bar[XB_TOPGEN], 1u);
            else XB_SPIN(xb_ld(&bar[XB_TOPGEN]) == tg, bar);
            __builtin_amdgcn_fence(__ATOMIC_ACQUIRE, "agent");
            xb_add(&bar[XB_XGEN(b.x)], 1u);
            asm volatile("s_waitcnt vmcnt(0)" ::: "memory");
        } else {
            XB_SPIN(xb_ld(&bar[XB_XGEN(b.x)]) == gen, bar);
            __builtin_amdgcn_fence(__ATOMIC_ACQUIRE, "agent");
            asm volatile("s_waitcnt vmcnt(0)" ::: "memory");
        }
    }
    __syncthreads();
}

using pg8::Unit; using pg8::cvt_pk_bf16;
#define EPI_LOOP_AM _Pragma("unroll") for (int ai = 0; ai < 2; ++ai) _Pragma("unroll") for (int m = 0; m < 4; ++m)
__device__ __forceinline__ float sq8(const f32x4& a, const f32x4& b) { return (a[0] * a[0] + a[1] * a[1]) + (a[2] * a[2] + a[3] * a[3]) + (b[0] * b[0] + b[1] * b[1]) + (b[2] * b[2] + b[3] * b[3]); }
__device__ __forceinline__ v4u pack8(const f32x4& a, const f32x4& b) { v4u w; w.x = cvt_pk_bf16(a[0], a[1]); w.y = cvt_pk_bf16(a[2], a[3]); w.z = cvt_pk_bf16(b[0], b[1]); w.w = cvt_pk_bf16(b[2], b[3]); return w; }

struct EpiZ {
    static constexpr bool PERM = true, AFTER_DRAIN = false;
    bf16* Z; float* sqq; float* sqkv;
    __device__ __forceinline__ void operator()(const f32x4 (&acc)[2][2][4][2], const Unit& u, int wr, int wc, int fr, int fq) const {
        const int row0 = u.pm * 256 + wr * 64 + fr, col0 = u.pn * 256 + wc * 32 + 8 * fq;
        float* sq = u.pn < 2 ? sqq : (u.pn == 2 ? sqkv : nullptr);
        EPI_LOOP_AM { const int row = row0 + ai * 128 + m * 16; bf16* rowp = Z + (size_t)row * ZLD + col0; float s = 0.f;
#pragma unroll
            for (int bj = 0; bj < 2; ++bj) { *(v4u*)(rowp + bj * 128) = pack8(acc[ai][bj][m][0], acc[ai][bj][m][1]); s += sq8(acc[ai][bj][m][0], acc[ai][bj][m][1]); }
            if (sq) { s += __shfl_xor(s, 16); s += __shfl_xor(s, 32); if (fq == 0) atomicAdd(sq + row, s); } }
    }
};
struct EpiScale {
    static constexpr bool PERM = true, AFTER_DRAIN = false;
    bf16* O; int ldc; const float* sq; float invk;
    __device__ __forceinline__ void operator()(const f32x4 (&acc)[2][2][4][2], const Unit& u, int wr, int wc, int fr, int fq) const {
        const int row0 = u.pm * 256 + wr * 64 + fr, col0 = u.pn * 256 + wc * 32 + 8 * fq;
        EPI_LOOP_AM { const int row = row0 + ai * 128 + m * 16; bf16* rowp = O + (size_t)row * ldc + col0; const float rs = __builtin_amdgcn_rsqf(sq[row] * invk + EPS);
#pragma unroll
            for (int bj = 0; bj < 2; ++bj) *(v4u*)(rowp + bj * 128) = pack8(acc[ai][bj][m][0] * rs, acc[ai][bj][m][1] * rs); }
    }
};
struct EpiPlain {
    static constexpr bool PERM = true, AFTER_DRAIN = false;
    bf16* O; int ldc;
    __device__ __forceinline__ void operator()(const f32x4 (&acc)[2][2][4][2], const Unit& u, int wr, int wc, int fr, int fq) const {
        const int row0 = u.pm * 256 + wr * 64 + fr, col0 = u.pn * 256 + wc * 32 + 8 * fq;
        EPI_LOOP_AM { bf16* rowp = O + (size_t)(row0 + ai * 128 + m * 16) * ldc + col0;
#pragma unroll
            for (int bj = 0; bj < 2; ++bj) *(v4u*)(rowp + bj * 128) = pack8(acc[ai][bj][m][0], acc[ai][bj][m][1]); }
    }
};
__device__ __forceinline__ void unpack8(const v4u w, float (&f)[8]) { f[0] = bflo(w.x); f[1] = bfhi(w.x); f[2] = bflo(w.y); f[3] = bfhi(w.y); f[4] = bflo(w.z); f[5] = bfhi(w.z); f[6] = bflo(w.w); f[7] = bfhi(w.w); }
struct EpiGlu {
    static constexpr bool PERM = true, AFTER_DRAIN = false;
    const bf16* YG; const float* bias; bf16* O;
    __device__ __forceinline__ void operator()(const f32x4 (&acc)[2][2][4][2], const Unit& u, int wr, int wc, int fr, int fq) const {
        const int row0 = u.pm * 256 + wr * 64 + fr, col0 = u.pn * 256 + wc * 32 + 8 * fq;
        f32x4 bv[2][2];
#pragma unroll
        for (int bj = 0; bj < 2; ++bj) { bv[bj][0] = *(const f32x4*)(bias + col0 + bj * 128); bv[bj][1] = *(const f32x4*)(bias + col0 + bj * 128 + 4); }
        EPI_LOOP_AM { const size_t off = (size_t)(row0 + ai * 128 + m * 16) * SSMW + col0;
#pragma unroll
            for (int bj = 0; bj < 2; ++bj) { float y[8]; unpack8(*(const v4u*)(YG + off + bj * 128), y);
                f32x4 a = acc[ai][bj][m][0] + bv[bj][0], b = acc[ai][bj][m][1] + bv[bj][1];
#pragma unroll
                for (int j = 0; j < 4; ++j) { a[j] = y[j] * sigmoid_f(a[j]); b[j] = y[4 + j] * sigmoid_f(b[j]); }
                *(v4u*)(O + off + bj * 128) = pack8(a, b); } }
    }
};
struct EpiResid {
    static constexpr bool PERM = true, AFTER_DRAIN = false;
    const float* xin; float* xout; bf16* xb; float* sq;
    __device__ __forceinline__ void operator()(const f32x4 (&acc)[2][2][4][2], const Unit& u, int wr, int wc, int fr, int fq) const {
        const int row0 = u.pm * 256 + wr * 64 + fr, col0 = u.pn * 256 + wc * 32 + 8 * fq;
        EPI_LOOP_AM { const int row = row0 + ai * 128 + m * 16; const size_t off = (size_t)row * D + col0; float s = 0.f;
#pragma unroll
            for (int bj = 0; bj < 2; ++bj) { const f32x4 a = *(const f32x4*)(xin + off + bj * 128) + acc[ai][bj][m][0], b = *(const f32x4*)(xin + off + bj * 128 + 4) + acc[ai][bj][m][1];
                *(f32x4*)(xout + off + bj * 128) = a; *(f32x4*)(xout + off + bj * 128 + 4) = b; *(v4u*)(xb + off + bj * 128) = pack8(a, b); s += sq8(a, b); }
            s += __shfl_xor(s, 16); s += __shfl_xor(s, 32); if (fq == 0) atomicAdd(sq + row, s); }
    }
};
struct EpiGateUp {
    static constexpr bool PERM = true, AFTER_DRAIN = false;
    bf16* H; const float* sq;
    __device__ __forceinline__ void operator()(const f32x4 (&acc)[2][2][4][2], const Unit& u, int wr, int wc, int fr, int fq) const {
        const int row0 = u.pm * 256 + wr * 64 + fr, col0 = u.pn * 128 + wc * 32 + 8 * fq;
        EPI_LOOP_AM { const int row = row0 + ai * 128 + m * 16; const float rs = __builtin_amdgcn_rsqf(sq[row] * (1.0f / D) + EPS);
            f32x4 a, b;
#pragma unroll
            for (int j = 0; j < 4; ++j) { const float g0 = acc[ai][0][m][0][j] * rs, u0 = acc[ai][1][m][0][j] * rs, g1 = acc[ai][0][m][1][j] * rs, u1 = acc[ai][1][m][1][j] * rs;
                a[j] = g0 * sigmoid_f(g0) * u0; b[j] = g1 * sigmoid_f(g1) * u1; }
            *(v4u*)(H + (size_t)row * FF + col0) = pack8(a, b); }
    }
};
struct EpiPle {
    static constexpr bool PERM = true, AFTER_DRAIN = false;
    float* xio; const bf16* PP; const float* sq;
    __device__ __forceinline__ void operator()(const f32x4 (&acc)[2][2][4][2], const Unit& u, int wr, int wc, int fr, int fq) const {
        const int row0 = u.pm * 256 + wr * 64 + fr, col0 = u.pn * 256 + wc * 32 + 8 * fq;
        EPI_LOOP_AM { const int row = row0 + ai * 128 + m * 16; const size_t off = (size_t)row * D + col0; const float rs = __builtin_amdgcn_rsqf(sq[row] * (1.0f / D) + EPS);
#pragma unroll
            for (int bj = 0; bj < 2; ++bj) { float pp[8]; unpack8(*(const v4u*)(PP + off + bj * 128), pp);
                f32x4 a = *(const f32x4*)(xio + off + bj * 128), b = *(const f32x4*)(xio + off + bj * 128 + 4);
#pragma unroll
                for (int j = 0; j < 4; ++j) { a[j] += sigmoid_f(acc[ai][bj][m][0][j] * rs) * pp[j]; b[j] += sigmoid_f(acc[ai][bj][m][1][j] * rs) * pp[4 + j]; }
                *(f32x4*)(xio + off + bj * 128) = a; *(f32x4*)(xio + off + bj * 128 + 4) = b; } }
    }
};

__device__ __forceinline__ int dest_row(int mode, int n) {
    if (mode == 0) return n;
    if (mode == 1) return n < 768 ? n : (n < 832 ? n + 1024 : n - 64);
    if (mode == 2) return 256 * (n >> 7) + (n & 127);
    return 256 * (n >> 7) + 128 + (n & 127);
}
__device__ __forceinline__ void transpose_item(const float* W, int Nsrc, bf16* WT, int ldwt, const float* gain, int mode, LAS float* scr, int item, int lane) {
    const int nblk = Nsrc / 32, kb = item / nblk, nb = item % nblk, k0 = 64 * kb, n0 = 32 * nb;
#pragma unroll 8
    for (int i = 0; i < 32; ++i) { const int kk = 2 * i + (lane >> 5); float v = W[(size_t)(k0 + kk) * Nsrc + n0 + (lane & 31)]; if (gain) v *= gain[k0 + kk]; scr[kk * 33 + (lane & 31)] = v; }
    LDS_WAIT(); asm volatile("" ::: "memory");
    const int c = lane & 7; const int r0 = dest_row(mode, n0);
#pragma unroll
    for (int j = 0; j < 4; ++j) { const int n = (lane >> 3) + 8 * j; const LAS float* s = scr + (8 * c) * 33 + n;
        v4u o; o.x = pk2(s[0 * 33], s[1 * 33]); o.y = pk2(s[2 * 33], s[3 * 33]); o.z = pk2(s[4 * 33], s[5 * 33]); o.w = pk2(s[6 * 33], s[7 * 33]);
        *(GAS v4u*)(WT + (size_t)(r0 + n) * ldwt + k0 + 8 * c) = o; }
    LDS_WAIT(); asm volatile("" ::: "memory");
}
struct Args { const void* in[31]; float* out; unsigned char* ws; int ph_lo, ph_hi; };
#define INF(i) ((const float*)args.in[i])

__device__ __forceinline__ void phase_prologue(const Args& args, LAS unsigned char* lds, int gw, int NGW, int wave, int lane) {
    unsigned char* ws = args.ws;
    LAS float* scr = (LAS float*)(lds + wave * 16384);
    constexpr int I0 = 32 * 58, I1 = 8 * 48, I2 = 4 * 64, I3 = 16 * 32, I4 = 16 * 64, I5 = 16 * 64, I6 = 32 * 176, I7 = 32 * 176, I8 = 88 * 64, I9 = 32 * 64, I10 = 4 * 64;
    constexpr int NITEMS = I0 + I1 + I2 + I3 + I4 + I5 + I6 + I7 + I8 + I9 + I10;
    for (int it = gw; it < NITEMS; it += NGW) {
        int r = it;
        if (r < I0) { transpose_item(INF(4), 1856, (bf16*)(ws + WS_WIN), 2048, INF(3), 1, scr, r, lane); continue; } r -= I0;
        if (r < I1) { transpose_item(INF(6), 1536, (bf16*)(ws + WS_WUQ), 512, INF(5), 0, scr, r, lane); continue; } r -= I1;
        if (r < I2) { transpose_item(INF(8), 2048, (bf16*)(ws + WS_WUKV), 256, INF(7), 0, scr, r, lane); continue; } r -= I2;
        if (r < I3) { transpose_item(INF(19), 1024, (bf16*)(ws + WS_WGLU), 1024, nullptr, 0, scr, r, lane); continue; } r -= I3;
        if (r < I4) { transpose_item(INF(23), 2048, (bf16*)(ws + WS_WO), 2048, INF(21), 0, scr, r, lane); continue; } r -= I4;
        if (r < I5) { transpose_item(INF(23) + (size_t)1024 * 2048, 2048, (bf16*)(ws + WS_WO) + 1024, 2048, INF(22), 0, scr, r, lane); continue; } r -= I5;
        if (r < I6) { transpose_item(INF(25), FF, (bf16*)(ws + WS_WGU), 2048, INF(24), 2, scr, r, lane); continue; } r -= I6;
        if (r < I7) { transpose_item(INF(26), FF, (bf16*)(ws + WS_WGU), 2048, INF(24), 3, scr, r, lane); continue; } r -= I7;
        if (r < I8) { transpose_item(INF(27), 2048, (bf16*)(ws + WS_WDN), FF, nullptr, 0, scr, r, lane); continue; } r -= I8;
        if (r < I9) { transpose_item(INF(29), 2048, (bf16*)(ws + WS_WPG), 2048, INF(28), 0, scr, r, lane); continue; } r -= I9;
        transpose_item(INF(30), 2048, (bf16*)(ws + WS_WPP), 256, nullptr, 0, scr, r, lane);
    }
    { GAS v4u* z = (GAS v4u*)(ws + WS_WIN + (size_t)1856 * 2048 * 2); const int n16 = 192 * 2048 * 2 / 16;
      for (int i = gw * 64 + lane; i < n16; i += NGW * 64) z[i] = (v4u){0u, 0u, 0u, 0u}; }
    for (int r = gw; r < M; r += NGW) {
        const GAS f32x4* xr = (const GAS f32x4*)(INF(0) + (size_t)r * D) + lane;
        f32x4 v[8]; float s = 0.f;
#pragma unroll
        for (int j = 0; j < 8; ++j) { v[j] = xr[64 * j]; s += (v[j][0] * v[j][0] + v[j][1] * v[j][1]) + (v[j][2] * v[j][2] + v[j][3] * v[j][3]); }
        const float rs = 1.0f / sqrtf(wave_sum(s) * (1.0f / D) + EPS);
        GAS v2u* o = (GAS v2u*)((bf16*)(ws + WS_HN) + (size_t)r * D) + lane;
#pragma unroll
        for (int j = 0; j < 8; ++j) { v2u w; w.x = pk2(v[j][0] * rs, v[j][1] * rs); w.y = pk2(v[j][2] * rs, v[j][3] * rs); o[64 * j] = w; }
    }
    { const GAS f32x4* p4 = (const GAS f32x4*)INF(1); GAS v2u* o = (GAS v2u*)(ws + WS_PB); const int n4 = M * PLE / 4;
      for (int i = gw * 64 + lane; i < n4; i += NGW * 64) { const f32x4 v = p4[i]; v2u w; w.x = pk2(v[0], v[1]); w.y = pk2(v[2], v[3]); o[i] = w; } }
    for (int i = gw * 64 + lane; i < NG * NP; i += NGW * 64) {
        const int g = i / NP;
        const double lr = fmin((double)INF(11)[i], -1e-4), li = (double)INF(12)[i], dt = exp((double)INF(13)[g]);
        const double mag = exp(lr * dt), are = mag * cos(li * dt), aim = mag * sin(li * dt), den = lr * lr + li * li;
        const double nre = are - 1.0, nim = aim, cre = (nre * lr + nim * li) / den, cim = (nim * lr - nre * li) / den;
        float* ab = (float*)(ws + WS_ABAR); ab[2 * i] = (float)are; ab[2 * i + 1] = (float)aim;
        float* bbr = (float*)(ws + WS_BBR) + (size_t)i * GH; float* bbi = (float*)(ws + WS_BBI) + (size_t)i * GH;
        for (int h = 0; h < GH; ++h) { const double br = INF(14)[(size_t)i * GH + h], bi = INF(15)[(size_t)i * GH + h]; bbr[h] = (float)(cre * br - cim * bi); bbi[h] = (float)(cre * bi + cim * br); }
    }
}

__device__ __forceinline__ void phase_s5_naive(const Args& args, LAS unsigned char* lds, int gw, int NGW, int wave, int lane) {
    unsigned char* ws = args.ws;
    LAS float* SR = (LAS float*)(lds + wave * 16384); LAS float* SI = SR + 32 * 64;
    const bf16* Z = (const bf16*)(ws + WS_Z); bf16* YG = (bf16*)(ws + WS_YG);
    for (int unit = gw; unit < NB * NG; unit += NGW) {
        const int b = unit / NG, g = unit % NG, p = lane;
        const float are = ((const float*)(ws + WS_ABAR))[2 * (g * NP + p)], aim = ((const float*)(ws + WS_ABAR))[2 * (g * NP + p) + 1];
        float bbr[GH], bbi[GH];
#pragma unroll
        for (int h = 0; h < GH; ++h) { bbr[h] = ((const float*)(ws + WS_BBR))[(size_t)(g * NP + p) * GH + h]; bbi[h] = ((const float*)(ws + WS_BBI))[(size_t)(g * NP + p) * GH + h]; }
        const int hB = lane & 15, pq = lane >> 4;
        float cr[16], ci[16];
#pragma unroll
        for (int i = 0; i < 16; ++i) { cr[i] = INF(16)[(size_t)(g * GH + hB) * NP + 16 * pq + i]; ci[i] = INF(17)[(size_t)(g * GH + hB) * NP + 16 * pq + i]; }
        const float dsk = INF(18)[g * GH + hB];
        float sre = 0.f, sim = 0.f;
        for (int t0 = 0; t0 < SEQ; t0 += 32) {
            for (int tt = 0; tt < 32; ++tt) {
                const bf16* up = Z + (size_t)(b * SEQ + t0 + tt) * ZLD + ZC_U + GH * g;
                float uf[16]; { float a8[8], b8[8]; unpack8(*(const v4u*)up, a8); unpack8(*(const v4u*)(up + 8), b8);
#pragma unroll
                    for (int h = 0; h < 8; ++h) { uf[h] = a8[h]; uf[8 + h] = b8[h]; } }
                float bur = 0.f, bui = 0.f;
#pragma unroll
                for (int h = 0; h < GH; ++h) { bur = fmaf(bbr[h], uf[h], bur); bui = fmaf(bbi[h], uf[h], bui); }
                const float nr = are * sre - aim * sim + bur, ni = are * sim + aim * sre + bui; sre = nr; sim = ni;
                SR[tt * 64 + p] = sre; SI[tt * 64 + p] = sim;
            }
            LDS_WAIT(); asm volatile("" ::: "memory");
            for (int tt = 0; tt < 32; ++tt) {
                float a = 0.f;
#pragma unroll
                for (int i = 0; i < 16; ++i) { a = fmaf(SR[tt * 64 + 16 * pq + i], cr[i], a); a = fmaf(-SI[tt * 64 + 16 * pq + i], ci[i], a); }
                a += __shfl_xor(a, 16); a += __shfl_xor(a, 32);
                if (pq == 0) { const size_t tok = (size_t)(b * SEQ + t0 + tt); const float uh = bf2f(Z[tok * ZLD + ZC_U + GH * g + hB]);
                    YG[tok * SSMW + GH * g + hB] = (bf16)f2bf(gelu_tanh(a + dsk * uh)); }
            }
            LDS_WAIT(); asm volatile("" ::: "memory");
        }
    }
}

__device__ __forceinline__ void phase_qkv_finalize(const Args& args, int gw, int NGW, int lane) {
    unsigned char* ws = args.ws;
    const bf16* QRAW = (const bf16*)(ws + WS_QRAW); const bf16* KVRAW = (const bf16*)(ws + WS_KVRAW); const bf16* Z = (const bf16*)(ws + WS_Z);
    bf16* Q = (bf16*)(ws + WS_Q); bf16* K = (bf16*)(ws + WS_K); bf16* V = (bf16*)(ws + WS_V);
    const float* gq = INF(9); const float* gk = INF(10); const int* pos = (const int*)args.in[2];
    const float gq0 = gq[lane], gq1 = gq[64 + lane], gq2 = gq[128 + lane], gk0 = gk[lane], gk1 = gk[64 + lane], gk2 = gk[128 + lane];
    const float invf = exp2f(-(float)(lane & 31) * (13.287712379549449f / 32.0f));
    for (int task = gw; task < M * NH; task += NGW) {
        const int tok = task >> 3, h = task & 7, b = tok / SEQ, t = tok % SEQ;
        const float ang = (float)pos[tok] * invf; float sn, cs; sincosf(ang, &sn, &cs);
        const size_t orow = (size_t)((b * NH + h) * SEQ + t);
        { const bf16* qp = QRAW + (size_t)tok * 1536 + h * DQK;
          float v0 = bf2f(qp[lane]), v1 = bf2f(qp[64 + lane]), v2 = bf2f(qp[128 + lane]);
          const float rs = 1.0f / sqrtf(wave_sum(v0 * v0 + v1 * v1 + v2 * v2) * (1.0f / DQK) + EPS);
          v0 *= rs * gq0; v1 *= rs * gq1; v2 *= rs * gq2;
          const float pr = __shfl_xor(v2, 32); const float r2 = lane < 32 ? v2 * cs - pr * sn : v2 * cs + pr * sn;
          bf16* o = Q + orow * DQK; o[lane] = (bf16)f2bf(v0); o[64 + lane] = (bf16)f2bf(v1); o[128 + lane] = (bf16)f2bf(r2); }
        { const bf16* kp = KVRAW + (size_t)tok * 2048 + h * 256;
          float v0 = bf2f(kp[lane]), v1 = bf2f(kp[64 + lane]), v2 = bf2f(Z[(size_t)tok * ZLD + ZC_KR + lane]);
          const float rs = 1.0f / sqrtf(wave_sum(v0 * v0 + v1 * v1 + v2 * v2) * (1.0f / DQK) + EPS);
          v0 *= rs * gk0; v1 *= rs * gk1; v2 *= rs * gk2;
          const float pr = __shfl_xor(v2, 32); const float r2 = lane < 32 ? v2 * cs - pr * sn : v2 * cs + pr * sn;
          bf16* o = K + orow * DQK; o[lane] = (bf16)f2bf(v0); o[64 + lane] = (bf16)f2bf(v1); o[128 + lane] = (bf16)f2bf(r2);
          bf16* vo = V + orow * DV; vo[lane] = kp[128 + lane]; vo[64 + lane] = kp[192 + lane]; }
    }
}

__device__ __forceinline__ void phase_attn_naive(const Args& args, LAS unsigned char* lds, int gw, int NGW, int wave, int lane) {
    unsigned char* ws = args.ws;
    const bf16* Q = (const bf16*)(ws + WS_Q); const bf16* K = (const bf16*)(ws + WS_K); const bf16* V = (const bf16*)(ws + WS_V); bf16* OA = (bf16*)(ws + WS_OA);
    LAS float* qf = (LAS float*)(lds + wave * 2048); LAS float* pb = qf + 192;
    const float scale = 0.07216878364870322f;
    for (int idx = gw; idx < NB * NH * SEQ; idx += NGW) {
        const int bh = idx / SEQ, i0 = idx % SEQ, i = (bh & 1) ? SEQ - 1 - i0 : i0, b = bh / NH, h = bh % NH;
        const bf16* qp = Q + ((size_t)bh * SEQ + i) * DQK;
        qf[lane] = bf2f(qp[lane]); qf[64 + lane] = bf2f(qp[64 + lane]); qf[128 + lane] = bf2f(qp[128 + lane]);
        LDS_WAIT(); asm volatile("" ::: "memory");
        float m = -1e30f, l = 0.f, o0 = 0.f, o1 = 0.f;
        const int nch = i / 64 + 1;
        for (int c = 0; c < nch; ++c) {
            const int kj = 64 * c + lane; const bf16* kp = K + ((size_t)bh * SEQ + kj) * DQK;
            float s = 0.f;
#pragma unroll 4
            for (int d = 0; d < DQK; d += 8) { float kf[8]; unpack8(*(const v4u*)(kp + d), kf); const f32x4 qa = *(const LAS f32x4*)(qf + d), qb = *(const LAS f32x4*)(qf + d + 4);
                s += (kf[0] * qa[0] + kf[1] * qa[1]) + (kf[2] * qa[2] + kf[3] * qa[3]) + (kf[4] * qb[0] + kf[5] * qb[1]) + (kf[6] * qb[2] + kf[7] * qb[3]); }
            s = kj <= i ? s * scale : -__builtin_inff();
            const float mn = fmaxf(m, wave_max(s)), alpha = __expf(m - mn), pj = __expf(s - mn);
            l = l * alpha + wave_sum(pj); o0 *= alpha; o1 *= alpha; m = mn;
            pb[lane] = pj; LDS_WAIT(); asm volatile("" ::: "memory");
            const bf16* vp = V + ((size_t)bh * SEQ + 64 * c) * DV + lane;
#pragma unroll 8
            for (int j = 0; j < 64; ++j) { const float pw = pb[j]; o0 = fmaf(pw, bf2f(vp[j * DV]), o0); o1 = fmaf(pw, bf2f(vp[j * DV + 64]), o1); }
            LDS_WAIT(); asm volatile("" ::: "memory");
        }
        const float il = 1.0f / l; bf16* op = OA + ((size_t)(b * SEQ + i)) * 1024 + h * DV;
        op[lane] = (bf16)f2bf(o0 * il); op[64 + lane] = (bf16)f2bf(o1 * il);
    }
}

__device__ __forceinline__ void phase_mix_norm(const Args& args, int gw, int NGW, int lane) {
    unsigned char* ws = args.ws;
    for (int r = gw; r < M; r += NGW) {
#pragma unroll
        for (int part = 0; part < 2; ++part) {
            const bf16* src = (const bf16*)(ws + (part ? WS_OS : WS_OA)) + (size_t)r * 1024 + lane * 8;
            float a[8], c[8]; unpack8(*(const v4u*)src, a); unpack8(*(const v4u*)(src + 512), c);
            float s = 0.f;
#pragma unroll
            for (int j = 0; j < 8; ++j) s += a[j] * a[j] + c[j] * c[j];
            const float rs = 1.0f / sqrtf(wave_sum(s) * (1.0f / 1024.0f) + EPS);
            bf16* dst = (bf16*)(ws + WS_Z) + (size_t)r * 2048 + part * 1024 + lane * 8;
            v4u w0, w1; w0.x = pk2(a[0] * rs, a[1] * rs); w0.y = pk2(a[2] * rs, a[3] * rs); w0.z = pk2(a[4] * rs, a[5] * rs); w0.w = pk2(a[6] * rs, a[7] * rs);
            w1.x = pk2(c[0] * rs, c[1] * rs); w1.y = pk2(c[2] * rs, c[3] * rs); w1.z = pk2(c[4] * rs, c[5] * rs); w1.w = pk2(c[6] * rs, c[7] * rs);
            *(v4u*)dst = w0; *(v4u*)(dst + 512) = w1;
        }
    }
}

template <class Epi> __device__ __forceinline__ void run_gemm(LAS unsigned char* lds, const bf16* A, int lda, const bf16* Bt, int ldb, int N, int K, const Epi& E) {
    pg8::Gemm g{A, Bt, M, N, K, lda, ldb}; pg8::StaticOrder S; S.init(M, N, (int)gridDim.x, (int)blockIdx.x);
    pg8::gemm_phase<Epi, pg8::StaticOrder, PG8_ALIGN, PG8_SP2>(lds, g, S, E);
}

__global__ void __launch_bounds__(NWAVES * 64, 2) mega_fwd(Args args) {
    extern __shared__ __attribute__((aligned(16))) unsigned char lds_raw[];
    LAS unsigned char* lds = (LAS unsigned char*)lds_raw;
    volatile LAS unsigned* MISC = (volatile LAS unsigned*)(lds + MISC_OFF);
    const int tid = threadIdx.x, lane = tid & 63, wave = __builtin_amdgcn_readfirstlane(tid >> 6);
    const int G = gridDim.x; const int bx = blockIdx.x; const int vcu = (G % 8 == 0) ? (bx % 8) * (G / 8) + bx / 8 : bx;
    const int gw = vcu * NWAVES + wave, NGW = G * NWAVES;
    unsigned char* ws = args.ws;
    for (int u = tid; u < (LDS_BYTES - 139264) / 4; u += NWAVES * 64) ((LAS unsigned*)(lds + 139264))[u] = 0u;
    __syncthreads();
    const int lo = args.ph_lo, hi = args.ph_hi;
    XcdBarrier bar; bar.bar = (unsigned*)(ws + WS_CTL) + CW_BAR; bar.x = 0; bar.st = nullptr;
    if (hi - lo > 1) bar = xcd_barrier_post((unsigned*)(ws + WS_CTL) + CW_BAR, MISC + 8);
#define IN(k) (lo <= (k) && (k) < hi)
#define SEAM(k) do { if (IN(k) && IN((k) + 1)) xcd_barrier(bar); } while (0)
    float* sqq = (float*)(ws + SQ_Q); float* sqkv = (float*)(ws + SQ_KV); float* sqx1 = (float*)(ws + SQ_X1); float* sqx2 = (float*)(ws + SQ_X2);

    if (IN(0)) { phase_prologue(args, lds, gw, NGW, wave, lane); __syncthreads(); }
    SEAM(0);
    if (IN(1)) { EpiZ E{(bf16*)(ws + WS_Z), sqq, sqkv}; run_gemm(lds, (const bf16*)(ws + WS_HN), D, (const bf16*)(ws + WS_WIN), D, 2048, D, E); }
    SEAM(1);
    if (IN(2)) {
        { EpiScale E{(bf16*)(ws + WS_QRAW), 1536, sqq, 1.0f / QL}; run_gemm(lds, (const bf16*)(ws + WS_Z) + ZC_Q, ZLD, (const bf16*)(ws + WS_WUQ), QL, 1536, QL, E); }
        { EpiScale E{(bf16*)(ws + WS_KVRAW), 2048, sqkv, 1.0f / KVL}; run_gemm(lds, (const bf16*)(ws + WS_Z) + ZC_KV, ZLD, (const bf16*)(ws + WS_WUKV), KVL, 2048, KVL, E); }
    }
    SEAM(2);
    if (IN(3)) { phase_qkv_finalize(args, gw, NGW, lane); phase_s5_naive(args, lds, gw, NGW, wave, lane); __syncthreads(); }
    SEAM(3);
    if (IN(4)) {
        phase_attn_naive(args, lds, gw, NGW, wave, lane); __syncthreads();
        { EpiGlu E{(const bf16*)(ws + WS_YG), INF(20), (bf16*)(ws + WS_OS)}; run_gemm(lds, (const bf16*)(ws + WS_YG), SSMW, (const bf16*)(ws + WS_WGLU), SSMW, SSMW, SSMW, E); }
    }
    SEAM(4);
    if (IN(5)) { phase_mix_norm(args, gw, NGW, lane); }
    SEAM(5);
    if (IN(6)) { EpiResid E{INF(0), args.out, (bf16*)(ws + WS_HN), sqx1}; run_gemm(lds, (const bf16*)(ws + WS_Z), D, (const bf16*)(ws + WS_WO), D, D, D, E); }
    SEAM(6);
    if (IN(7)) {
        { EpiGateUp E{(bf16*)(ws + WS_H), sqx1}; run_gemm(lds, (const bf16*)(ws + WS_HN), D, (const bf16*)(ws + WS_WGU), D, 2 * FF, D, E); }
        { EpiPlain E{(bf16*)(ws + WS_PP), D}; run_gemm(lds, (const bf16*)(ws + WS_PB), PLE, (const bf16*)(ws + WS_WPP), PLE, D, PLE, E); }
    }
    SEAM(7);
    if (IN(8)) { EpiResid E{args.out, args.out, (bf16*)(ws + WS_HN), sqx2}; run_gemm(lds, (const bf16*)(ws + WS_H), FF, (const bf16*)(ws + WS_WDN), FF, D, FF, E); }
    SEAM(8);
    if (IN(9)) { EpiPle E{args.out, (const bf16*)(ws + WS_PP), sqx2}; run_gemm(lds, (const bf16*)(ws + WS_HN), D, (const bf16*)(ws + WS_WPG), D, D, D, E); }
#undef IN
#undef SEAM
}

extern "C" void kernel_launch(void* const* d_in, const int* in_sizes, int n_in, void* d_out, int out_size, void* d_ws, size_t ws_size, hipStream_t stream) {
    static int grid = 0;
    if (grid == 0) {
        if (n_in != 31 || out_size != M * D || ws_size < WS_END) { fprintf(stderr, "kernel_launch: unexpected shapes (n_in %d, out %d, ws %zu)\n", n_in, out_size, ws_size); grid = -1; return; }
        int dev = 0, cus = 0;
        if (hipGetDevice(&dev) != hipSuccess || hipDeviceGetAttribute(&cus, hipDeviceAttributeMultiprocessorCount, dev) != hipSuccess) { grid = -1; return; }
        if (hipFuncSetAttribute((const void*)mega_fwd, hipFuncAttributeMaxDynamicSharedMemorySize, LDS_BYTES) != hipSuccess) { fprintf(stderr, "kernel_launch: hipFuncSetAttribute failed\n"); grid = -1; return; }
        int per_cu = 0;
        if (hipOccupancyMaxActiveBlocksPerMultiprocessor(&per_cu, (const void*)mega_fwd, NWAVES * 64, LDS_BYTES) != hipSuccess || per_cu < 1) fprintf(stderr, "kernel_launch: occupancy query says %d blocks/CU\n", per_cu);
        (void)hipGetLastError();
        grid = cus > 0 ? cus : 256;
    }
    if (grid < 0) return;
    (void)hipMemsetAsync((char*)d_ws + WS_CTL, 0, CTL_ZERO_BYTES, stream);
    Args a{};
    for (int i = 0; i < 31; ++i) a.in[i] = d_in[i];
    a.out = (float*)d_out; a.ws = (unsigned char*)d_ws;
    constexpr int NL = MK_N_LAUNCHES;
    for (int li = 0; li < NL; ++li) {
        a.ph_lo = (NL == 1) ? 0 : li; a.ph_hi = (NL == 1) ? NPHASES : li + 1;
        hipLaunchKernelGGL(mega_fwd, dim3(grid), dim3(NWAVES * 64), LDS_BYTES, stream, a);
    }
}
```

```cpp
#include <hip/hip_runtime.h>
#include <cstdio>
#include <cstdint>
namespace pg8 {
#define PG8_LAS __attribute__((address_space(3)))
typedef unsigned short bf16_t;
typedef short bf16x8 __attribute__((ext_vector_type(8)));
typedef float f32x4 __attribute__((ext_vector_type(4)));
typedef unsigned u32x4 __attribute__((ext_vector_type(4)));
constexpr int BM = 256, BK = 64, HALF = 128, HTB = HALF * BK * 2  , STAGE_BYTES = 8 * HTB, NXCD = 8, WGM = 8;

__host__ __device__ __forceinline__ int lds_byte(int r, int c) { const int st = (r >> 4) * 2 + (c >> 5), rr = r & 15, cc = c & 31, ob = rr * 64 + cc * 2; return st * 1024 + (ob ^ (((ob >> 9) & 1) << 5)); }
__host__ __device__ __forceinline__ void stage_rc(int b, int& R, int& C) { const int st = b / 1024, sb = b % 1024, swz = sb ^ (((sb >> 9) & 1) << 5); R = (st >> 1) * 16 + swz / 64; C = (st & 1) * 32 + (swz % 64) / 2; }
__host__ __device__ __forceinline__ int perm32(int rho) { const int n = rho >> 4, i = rho & 15; return 8 * (i >> 2) + 4 * n + (i & 3); }

struct Unit { int pm, pn; };
struct Gemm { const bf16_t* A; const bf16_t* Bt; int M, N, K, lda, ldb; };

struct StaticOrder {
    int nM, nN, nwg, G, c;
    __host__ __device__ void init(int M, int N, int G_, int c_) { nM = M / BM; nN = N / BM; nwg = nM * nN; G = G_; c = c_; }
    __host__ __device__ bool next(int i, Unit& u) const {
        const long L = (long)i * G + c; if (L >= nwg) return false;
        int wgid = (int)L; { const int q = nwg / NXCD, r = nwg % NXCD, xcd = wgid % NXCD, off = wgid / NXCD; wgid = (xcd < r ? xcd * (q + 1) : r * (q + 1) + (xcd - r) * q) + off; }
        const int nig = WGM * nN, gid = wgid / nig, fm = gid * WGM, gsz = (nM - fm) < WGM ? (nM - fm) : WGM;
        u.pm = fm + ((wgid % nig) % gsz); u.pn = (wgid % nig) / gsz; return true;
    }
    __device__ __forceinline__ void a_ready(const Unit&) const {}
    __device__ __forceinline__ void done(const Unit&) const {}
};

__device__ __forceinline__ unsigned cvt_pk_bf16(float lo, float hi) { unsigned r; asm volatile("v_cvt_pk_bf16_f32 %0, %1, %2" : "=v"(r) : "v"(lo), "v"(hi)); return r; }
typedef float f32x2 __attribute__((ext_vector_type(2)));
template <class Epi, class Sched, bool ALIGN_EPI = false, bool SP2 = false>
__device__ __forceinline__ void gemm_phase(PG8_LAS unsigned char* lds, const Gemm g, const Sched& S, const Epi& E) {
    const int tid = threadIdx.x, wid = __builtin_amdgcn_readfirstlane(tid >> 6), lane = tid & 63, wr = wid >> 2, wc = wid & 3, fr = lane & 15, fq = lane >> 4;
    const int K = g.K, nt = K / BK;
    unsigned voffA[2], voffB[2];
#pragma unroll
    for (int i = 0; i < 2; ++i) { int R, C; stage_rc(tid * 16 + i * 8192, R, C); const int Rb = Epi::PERM ? ((R & ~31) + perm32(R & 31)) : R;
        voffA[i] = (unsigned)(R * g.lda + C) * 2u; voffB[i] = (unsigned)(Rb * g.ldb + C) * 2u; }
    const size_t kstep = (size_t)(BK * 2);
    const size_t hstepA = (size_t)HALF * g.lda * 2, hstepB = (size_t)HALF * g.ldb * 2;
    const size_t tstepA = 2 * hstepA, tstepB = 2 * hstepB;
    const unsigned ldsw = (unsigned)wid * 1024u;
    const int aoff = lds_byte(wr * 64 + fr, fq * 8), boff = lds_byte(wc * 32 + fr, fq * 8);
#define PG8_SA(b, h) (((b) * 2 + (h)) * HTB)
#define PG8_SB(b, h) ((4 + (b) * 2 + (h)) * HTB)
#define PG8_STAGE(bufoff, gbase, voff) do { _Pragma("unroll") for (int _i = 0; _i < 2; ++_i) \
        __builtin_amdgcn_global_load_lds((const unsigned*)((const char*)(gbase) + (voff)[_i]), (PG8_LAS unsigned*)(lds + (bufoff) + ldsw + _i * 8192), 16, 0, 0); } while (0)
#define PG8_LDA(dst, b, h) do { _Pragma("unroll") for (int m = 0; m < 4; ++m) _Pragma("unroll") for (int k = 0; k < 2; ++k) dst[m][k] = *(const PG8_LAS bf16x8*)(lds + PG8_SA(b, h) + aoff + m * 2048 + k * 1024); } while (0)
#define PG8_LDB(dst, b, h) do { _Pragma("unroll") for (int n = 0; n < 2; ++n) _Pragma("unroll") for (int k = 0; k < 2; ++k) dst[n][k] = *(const PG8_LAS bf16x8*)(lds + PG8_SB(b, h) + boff + n * 2048 + k * 1024); } while (0)
#define PG8_MMA(ai, bj, At, Bt) do { __builtin_amdgcn_s_setprio(1); _Pragma("unroll") for (int m = 0; m < 4; ++m) _Pragma("unroll") for (int n = 0; n < 2; ++n) _Pragma("unroll") for (int k = 0; k < 2; ++k) \
        acc[ai][bj][m][n] = __builtin_amdgcn_mfma_f32_16x16x32_bf16(Bt[n][k], At[m][k], acc[ai][bj][m][n], 0, 0, 0); __builtin_amdgcn_s_setprio(0); } while (0)
#define PG8_WAIT_V(n) asm volatile("s_waitcnt vmcnt(" #n ")" ::: "memory")
#define PG8_WAIT_L(n) asm volatile("s_waitcnt lgkmcnt(" #n ")" ::: "memory")
#define PG8_BAR __builtin_amdgcn_s_barrier()
#define PG8_SCHED __builtin_amdgcn_sched_barrier(0)
    Unit cur, nxt; int ui = 0;
    if (!S.next(0, cur)) return;
    f32x4 acc[2][2][4][2];
#pragma unroll
    for (int a = 0; a < 2; ++a)
#pragma unroll
        for (int b = 0; b < 2; ++b)
#pragma unroll
            for (int m = 0; m < 4; ++m)
#pragma unroll
                for (int n = 0; n < 2; ++n) acc[a][b][m][n] = (f32x4){0.f, 0.f, 0.f, 0.f};
    bf16x8 At[4][2], B0[2][2], B1[2][2];
    const char* cA = (const char*)g.A + (size_t)cur.pm * tstepA; const char* cB = (const char*)g.Bt + (size_t)cur.pn * tstepB;
    S.a_ready(cur);
    if constexpr (SP2) {
        PG8_STAGE(PG8_SB(0, 0), cB, voffB); PG8_STAGE(PG8_SB(0, 1), cB + hstepB, voffB); PG8_STAGE(PG8_SA(0, 0), cA, voffA); PG8_STAGE(PG8_SA(0, 1), cA + hstepA, voffA);
        if (wr == 1) PG8_BAR;
        PG8_WAIT_V(2); PG8_BAR;
        PG8_STAGE(PG8_SB(1, 0), cB + kstep, voffB); PG8_STAGE(PG8_SA(1, 0), cA + kstep, voffA); PG8_STAGE(PG8_SB(1, 1), cB + hstepB + kstep, voffB);
        PG8_WAIT_V(6); PG8_BAR;
    } else {
        PG8_STAGE(PG8_SB(0, 0), cB, voffB); PG8_STAGE(PG8_SA(0, 0), cA, voffA); PG8_STAGE(PG8_SB(0, 1), cB + hstepB, voffB); PG8_STAGE(PG8_SA(0, 1), cA + hstepA, voffA);
        if (wr == 1) PG8_BAR;
        PG8_WAIT_V(4); PG8_BAR;
        PG8_STAGE(PG8_SB(1, 0), cB + kstep, voffB); PG8_STAGE(PG8_SA(1, 0), cA + kstep, voffA); PG8_STAGE(PG8_SB(1, 1), cB + hstepB + kstep, voffB);
        PG8_WAIT_V(6); PG8_BAR;
    }
    for (;;) {
        const bool has_next = S.next(ui + 1, nxt);
        const char* nA = has_next ? (const char*)g.A + (size_t)nxt.pm * tstepA : cA; const char* nB = has_next ? (const char*)g.Bt + (size_t)nxt.pn * tstepB : cB;
        for (int t = 0; t < nt; t += 2) {
            const bool last = (t == nt - 2);
            const char* a1 = cA + (size_t)(t + 1) * kstep;
            const char* a2 = last ? nA : cA + (size_t)(t + 2) * kstep; const char* b2 = last ? nB : cB + (size_t)(t + 2) * kstep;
            const char* a3 = a2 + kstep; const char* b3 = b2 + kstep;
            if (last && has_next) S.a_ready(nxt);
            if constexpr (SP2) {
            PG8_LDB(B0, 0, 0); PG8_LDB(B1, 0, 1); PG8_SCHED; PG8_LDA(At, 0, 0); PG8_STAGE(PG8_SA(1, 1), a1 + hstepA, voffA);
            PG8_WAIT_V(8); PG8_WAIT_L(0); PG8_BAR; PG8_MMA(0, 0, At, B0); PG8_MMA(0, 1, At, B1); PG8_BAR; PG8_SCHED;
            PG8_LDA(At, 0, 1); PG8_STAGE(PG8_SB(0, 0), b2, voffB); PG8_STAGE(PG8_SB(0, 1), b2 + hstepB, voffB); PG8_STAGE(PG8_SA(0, 0), a2, voffA);
            PG8_WAIT_V(8); PG8_WAIT_L(0); PG8_BAR; PG8_MMA(1, 0, At, B0); PG8_MMA(1, 1, At, B1); PG8_BAR; PG8_SCHED;
            PG8_LDB(B0, 1, 0); PG8_LDB(B1, 1, 1); PG8_SCHED; PG8_LDA(At, 1, 0); PG8_STAGE(PG8_SA(0, 1), a2 + hstepA, voffA);
            PG8_WAIT_V(8); PG8_WAIT_L(0); PG8_BAR; PG8_MMA(0, 0, At, B0); PG8_MMA(0, 1, At, B1); PG8_BAR; PG8_SCHED;
            PG8_LDA(At, 1, 1); PG8_STAGE(PG8_SB(1, 0), b3, voffB); PG8_STAGE(PG8_SB(1, 1), b3 + hstepB, voffB); PG8_STAGE(PG8_SA(1, 0), a3, voffA);
            PG8_WAIT_V(8); PG8_WAIT_L(0); PG8_BAR; PG8_MMA(1, 0, At, B0); PG8_MMA(1, 1, At, B1); PG8_BAR; PG8_SCHED;
            } else {
            PG8_LDB(B0, 0, 0); PG8_SCHED; PG8_LDA(At, 0, 0); PG8_STAGE(PG8_SA(1, 1), a1 + hstepA, voffA);
            PG8_WAIT_L(8); PG8_BAR; PG8_WAIT_L(0); PG8_MMA(0, 0, At, B0); PG8_BAR; PG8_SCHED;
            PG8_LDB(B1, 0, 1); PG8_STAGE(PG8_SB(0, 0), b2, voffB);
            PG8_BAR; PG8_WAIT_L(0); PG8_MMA(0, 1, At, B1); PG8_BAR;
            PG8_LDA(At, 0, 1); PG8_STAGE(PG8_SA(0, 0), a2, voffA);
            PG8_BAR; PG8_WAIT_L(0); PG8_MMA(1, 0, At, B0); PG8_BAR; PG8_SCHED;
            PG8_STAGE(PG8_SB(0, 1), b2 + hstepB, voffB);
            PG8_WAIT_V(6); PG8_BAR; PG8_MMA(1, 1, At, B1); PG8_BAR;
            PG8_LDB(B0, 1, 0); PG8_SCHED; PG8_LDA(At, 1, 0); PG8_STAGE(PG8_SA(0, 1), a2 + hstepA, voffA);
            PG8_WAIT_L(8); PG8_BAR; PG8_WAIT_L(0); PG8_MMA(0, 0, At, B0); PG8_BAR; PG8_SCHED;
            PG8_LDB(B1, 1, 1); PG8_STAGE(PG8_SB(1, 0), b3, voffB);
            PG8_BAR; PG8_WAIT_L(0); PG8_MMA(0, 1, At, B1); PG8_BAR;
            PG8_LDA(At, 1, 1); PG8_STAGE(PG8_SA(1, 0), a3, voffA);
            PG8_BAR; PG8_WAIT_L(0); PG8_MMA(1, 0, At, B0); PG8_BAR; PG8_SCHED;
            PG8_STAGE(PG8_SB(1, 1), b3 + hstepB, voffB);
            PG8_WAIT_V(6); PG8_BAR; PG8_MMA(1, 1, At, B1); PG8_BAR;
            }
        }
        if constexpr (ALIGN_EPI) { if (wr == 0) PG8_BAR; }
        if constexpr (!Epi::AFTER_DRAIN) { E(acc, cur, wr, wc, fr, fq); S.done(cur); }
        if (!has_next) break;
#pragma unroll
        for (int a = 0; a < 2; ++a)
#pragma unroll
            for (int b = 0; b < 2; ++b)
#pragma unroll
                for (int m = 0; m < 4; ++m)
#pragma unroll
                    for (int n = 0; n < 2; ++n) acc[a][b][m][n] = (f32x4){0.f, 0.f, 0.f, 0.f};
        cur = nxt; cA = nA; cB = nB; ++ui;
        if constexpr (ALIGN_EPI) { if (wr == 1) PG8_BAR; }
    }
    PG8_WAIT_V(0);
    if constexpr (!ALIGN_EPI) { if (wr == 0) PG8_BAR; }
    PG8_BAR;
    if constexpr (Epi::AFTER_DRAIN) { E.fused(acc, cur, wr, wc, fr, fq, lds, wid, lane); S.done(cur); }
#undef PG8_SA
#undef PG8_SB
#undef PG8_STAGE
#undef PG8_LDA
#undef PG8_LDB
#undef PG8_MMA
#undef PG8_WAIT_V
#undef PG8_WAIT_L
#undef PG8_BAR
#undef PG8_SCHED
}
}

#ifndef PG8_SP2
#define PG8_SP2 true
#endif
#ifndef PG8_ALIGN
#define PG8_ALIGN true
#endif
#ifndef MK_N_LAUNCHES
#define MK_N_LAUNCHES 1
#endif

constexpr int M = 16384, SEQ = 2048, NB = 8, D = 2048, NH = 8, DQK = 192, DV = 128;
constexpr int QL = 512, KVL = 256, NG = 64, GH = 16, NP = 64, FF = 5632, PLE = 256, SSMW = 1024;
constexpr float EPS = 1e-6f;
constexpr int ZC_Q = 0, ZC_KV = 512, ZC_U = 768, ZC_KR = 1792, ZLD = 2048;
constexpr int NPHASES = 10;

constexpr size_t MiB = 1u << 20;
constexpr size_t WS_CTL = 0, CTL_ZERO_BYTES = 1 * MiB;
constexpr int CW_BAR = 4096;
constexpr size_t SQ_Q = 65536 * 1, SQ_KV = 65536 * 2, SQ_X1 = 65536 * 3, SQ_X2 = 65536 * 4;
constexpr size_t WS_ABAR = 1 * MiB, WS_BBR = 1 * MiB + 65536, WS_BBI = 1 * MiB + 65536 + 262144;
constexpr size_t WS_WIN = 2 * MiB, WS_WUQ = 10 * MiB, WS_WUKV = 12 * MiB, WS_WGLU = 13 * MiB, WS_WO = 15 * MiB, WS_WGU = 23 * MiB, WS_WDN = 67 * MiB, WS_WPG = 89 * MiB, WS_WPP = 97 * MiB;
constexpr size_t WS_HN = 100 * MiB;
constexpr size_t WS_Z = 164 * MiB;
constexpr size_t WS_QRAW = 228 * MiB, WS_KVRAW = 276 * MiB;
constexpr size_t WS_Q = 340 * MiB, WS_K = 388 * MiB, WS_V = 436 * MiB;
constexpr size_t WS_YG = 468 * MiB, WS_PB = 500 * MiB;
constexpr size_t WS_OA = 228 * MiB, WS_OS = 260 * MiB;
constexpr size_t WS_H = 228 * MiB, WS_PP = 404 * MiB, WS_END = 508 * MiB;

constexpr int RING_BYTES = 131072, MISC_OFF = 139264 + 320, LDS_BYTES = 147456;
constexpr int NWAVES = 8;

#define GAS __attribute__((address_space(1)))
#define LAS __attribute__((address_space(3)))
typedef unsigned short bf16;
typedef unsigned v4u __attribute__((ext_vector_type(4)));
typedef unsigned v2u __attribute__((ext_vector_type(2)));
typedef float f32x4 __attribute__((ext_vector_type(4)));
typedef GAS unsigned gu32;
#define LDS_WAIT() asm volatile("s_waitcnt lgkmcnt(0)" ::: "memory")
__device__ __forceinline__ unsigned f2bf(float f) { unsigned u = __builtin_bit_cast(unsigned, f); return (u + 0x7fffu + ((u >> 16) & 1u)) >> 16; }
__device__ __forceinline__ unsigned pk2(float lo, float hi) { return f2bf(lo) | (f2bf(hi) << 16); }
__device__ __forceinline__ float bf2f(unsigned h) { return __builtin_bit_cast(float, h << 16); }
__device__ __forceinline__ float bflo(unsigned w) { return __builtin_bit_cast(float, w << 16); }
__device__ __forceinline__ float bfhi(unsigned w) { return __builtin_bit_cast(float, w & 0xffff0000u); }
__device__ __forceinline__ float wave_sum(float v) {
#pragma unroll
    for (int o = 1; o < 64; o <<= 1) v += __shfl_xor(v, o);
    return v;
}
__device__ __forceinline__ float wave_max(float v) {
#pragma unroll
    for (int o = 1; o < 64; o <<= 1) v = fmaxf(v, __shfl_xor(v, o));
    return v;
}
__device__ __forceinline__ float sigmoid_f(float v) { return __builtin_amdgcn_rcpf(1.0f + __builtin_amdgcn_exp2f(-1.4426950408889634f * v)); }
__device__ __forceinline__ float gelu_tanh(float v) {
    const float z = 0.7978845608028654f * (v + 0.044715f * v * v * v);
    const float e = __builtin_amdgcn_exp2f(2.0f * 1.4426950408889634f * z);
    const float th = 1.0f - 2.0f * __builtin_amdgcn_rcpf(e + 1.0f);
    return 0.5f * v * (1.0f + th);
}

#define XB_TMO      128
#define XB_XCNT(j)  (256  + 64 * (j))
#define XB_XSUB(j)  (1280 + 64 * (j))
#define XB_XGEN(j)  (2304 + 64 * (j))
#define XB_TOP      3328
#define XB_TOPGEN   3392
#define XCD_BAR_WORDS 3456
#define XB_SPIN_CAP (1u << 18)
__device__ __forceinline__ unsigned xb_ld(unsigned* p)              { return __hip_atomic_load(p, __ATOMIC_RELAXED, __HIP_MEMORY_SCOPE_AGENT); }
__device__ __forceinline__ unsigned xb_add(unsigned* p, unsigned v) { return __hip_atomic_fetch_add(p, v, __ATOMIC_RELAXED, __HIP_MEMORY_SCOPE_AGENT); }
__device__ __forceinline__ unsigned xb_xcc_id() { return (unsigned)__builtin_amdgcn_s_getreg((3 << 11) | 20) & 0xFu; }
#define XB_SPIN(cond, bar) do { unsigned _sp = 0; while (cond) { __builtin_amdgcn_s_sleep(1); \
    if ((++_sp & 255u) == 0u) { if (xb_ld(&(bar)[XB_TMO])) break; if (_sp > XB_SPIN_CAP) { atomicAdd(&(bar)[XB_TMO], 1u); break; } } } } while (0)
struct XcdBarrier { unsigned* bar; unsigned x; volatile LAS unsigned* st; };
__device__ __forceinline__ XcdBarrier xcd_barrier_post(unsigned* bar, volatile LAS unsigned* st) {
    XcdBarrier b; b.bar = bar; b.x = xb_xcc_id(); b.st = st;
    if (threadIdx.x == 0) (void)xb_add(&bar[XB_XCNT(b.x)], 1u);
    return b;
}
__device__ __forceinline__ void xcd_barrier_complete(unsigned* bar, unsigned x, unsigned& nloc, unsigned& nx) {
    const unsigned G = gridDim.x * gridDim.y * gridDim.z;
    unsigned sum, cnt, mine, sp = 0u;
    for (;;) {
        sum = 0u; cnt = 0u; mine = 0u;
#pragma unroll
        for (unsigned j = 0; j < 16; ++j) { const unsigned c = xb_ld(&bar[XB_XCNT(j)]); sum += c; cnt += (c > 0u) ? 1u : 0u; mine = (j == x) ? c : mine; }
        if (sum == G) break;
        __builtin_amdgcn_s_sleep(1);
        if ((++sp & 255u) == 0u) { if (xb_ld(&bar[XB_TMO])) break; if (sp > XB_SPIN_CAP) { atomicAdd(&bar[XB_TMO], 1u); break; } }
    }
    nloc = mine > 0u ? mine : 1u; nx = cnt > 0u ? cnt : 1u;
}
__device__ __forceinline__ void xcd_barrier(const XcdBarrier& b) {
    asm volatile("s_waitcnt vmcnt(0)" ::: "memory");
    __syncthreads();
    if (threadIdx.x == 0) {
        unsigned* bar = b.bar;
        __builtin_amdgcn_s_waitcnt(0);
        unsigned nloc = b.st[0], nx = b.st[1];
        if (nloc == 0u) { xcd_barrier_complete(bar, b.x, nloc, nx); b.st[0] = nloc; b.st[1] = nx; }
        const unsigned old = xb_add(&bar[XB_XSUB(b.x)], 1u);
        const unsigned gen = old / nloc;
        if (old + 1u == (gen + 1u) * nloc) {
            __builtin_amdgcn_fence(__ATOMIC_RELEASE, "agent");
            asm volatile("s_waitcnt vmcnt(0)" ::: "memory");
            const unsigned og = xb_add(&bar[XB_TOP], 1u);
            const unsigned tg = og / nx;
            if (og + 1u == (tg + 1u) * nx) xb_add(&bar[XB_TOPGEN], 1u);
            else XB_SPIN(xb_ld(&bar[XB_TOPGEN]) == tg, bar);
            __builtin_amdgcn_fence(__ATOMIC_ACQUIRE, "agent");
            xb_add(&bar[XB_XGEN(b.x)], 1u);
            asm volatile("s_waitcnt vmcnt(0)" ::: "memory");
        } else {
            XB_SPIN(xb_ld(&bar[XB_XGEN(b.x)]) == gen, bar);
            __builtin_amdgcn_fence(__ATOMIC_ACQUIRE, "agent");
            asm volatile("s_waitcnt vmcnt(0)" ::: "memory");
        }
    }
    __syncthreads();
}

using pg8::Unit; using pg8::cvt_pk_bf16;
#define EPI_LOOP_AM _Pragma("unroll") for (int ai = 0; ai < 2; ++ai) _Pragma("unroll") for (int m = 0; m < 4; ++m)
__device__ __forceinline__ float sq8(const f32x4& a, const f32x4& b) { return (a[0] * a[0] + a[1] * a[1]) + (a[2] * a[2] + a[3] * a[3]) + (b[0] * b[0] + b[1] * b[1]) + (b[2] * b[2] + b[3] * b[3]); }
__device__ __forceinline__ v4u pack8(const f32x4& a, const f32x4& b) { v4u w; w.x = cvt_pk_bf16(a[0], a[1]); w.y = cvt_pk_bf16(a[2], a[3]); w.z = cvt_pk_bf16(b[0], b[1]); w.w = cvt_pk_bf16(b[2], b[3]); return w; }

struct EpiZ {
    static constexpr bool PERM = true, AFTER_DRAIN = false;
    bf16* Z; float* sqq; float* sqkv;
    __device__ __forceinline__ void operator()(const f32x4 (&acc)[2][2][4][2], const Unit& u, int wr, int wc, int fr, int fq) const {
        const int row0 = u.pm * 256 + wr * 64 + fr, col0 = u.pn * 256 + wc * 32 + 8 * fq;
        float* sq = u.pn < 2 ? sqq : (u.pn == 2 ? sqkv : nullptr);
        EPI_LOOP_AM { const int row = row0 + ai * 128 + m * 16; bf16* rowp = Z + (size_t)row * ZLD + col0; float s = 0.f;
#pragma unroll
            for (int bj = 0; bj < 2; ++bj) { *(v4u*)(rowp + bj * 128) = pack8(acc[ai][bj][m][0], acc[ai][bj][m][1]); s += sq8(acc[ai][bj][m][0], acc[ai][bj][m][1]); }
            if (sq) { s += __shfl_xor(s, 16); s += __shfl_xor(s, 32); if (fq == 0) atomicAdd(sq + row, s); } }
    }
};
struct EpiScale {
    static constexpr bool PERM = true, AFTER_DRAIN = false;
    bf16* O; int ldc; const float* sq; float invk;
    __device__ __forceinline__ void operator()(const f32x4 (&acc)[2][2][4][2], const Unit& u, int wr, int wc, int fr, int fq) const {
        const int row0 = u.pm * 256 + wr * 64 + fr, col0 = u.pn * 256 + wc * 32 + 8 * fq;
        EPI_LOOP_AM { const int row = row0 + ai * 128 + m * 16; bf16* rowp = O + (size_t)row * ldc + col0; const float rs = __builtin_amdgcn_rsqf(sq[row] * invk + EPS);
#pragma unroll
            for (int bj = 0; bj < 2; ++bj) *(v4u*)(rowp + bj * 128) = pack8(acc[ai][bj][m][0] * rs, acc[ai][bj][m][1] * rs); }
    }
};
struct EpiPlain {
    static constexpr bool PERM = true, AFTER_DRAIN = false;
    bf16* O; int ldc;
    __device__ __forceinline__ void operator()(const f32x4 (&acc)[2][2][4][2], const Unit& u, int wr, int wc, int fr, int fq) const {
        const int row0 = u.pm * 256 + wr * 64 + fr, col0 = u.pn * 256 + wc * 32 + 8 * fq;
        EPI_LOOP_AM { bf16* rowp = O + (size_t)(row0 + ai * 128 + m * 16) * ldc + col0;
#pragma unroll
            for (int bj = 0; bj < 2; ++bj) *(v4u*)(rowp + bj * 128) = pack8(acc[ai][bj][m][0], acc[ai][bj][m][1]); }
    }
};
__device__ __forceinline__ void unpack8(const v4u w, float (&f)[8]) { f[0] = bflo(w.x); f[1] = bfhi(w.x); f[2] = bflo(w.y); f[3] = bfhi(w.y); f[4] = bflo(w.z); f[5] = bfhi(w.z); f[6] = bflo(w.w); f[7] = bfhi(w.w); }
struct EpiGlu {
    static constexpr bool PERM = true, AFTER_DRAIN = false;
    const bf16* YG; const float* bias; bf16* O;
    __device__ __forceinline__ void operator()(const f32x4 (&acc)[2][2][4][2], const Unit& u, int wr, int wc, int fr, int fq) const {
        const int row0 = u.pm * 256 + wr * 64 + fr, col0 = u.pn * 256 + wc * 32 + 8 * fq;
        f32x4 bv[2][2];
#pragma unroll
        for (int bj = 0; bj < 2; ++bj) { bv[bj][0] = *(const f32x4*)(bias + col0 + bj * 128); bv[bj][1] = *(const f32x4*)(bias + col0 + bj * 128 + 4); }
        EPI_LOOP_AM { const size_t off = (size_t)(row0 + ai * 128 + m * 16) * SSMW + col0;
#pragma unroll
            for (int bj = 0; bj < 2; ++bj) { float y[8]; unpack8(*(const v4u*)(YG + off + bj * 128), y);
                f32x4 a = acc[ai][bj][m][0] + bv[bj][0], b = acc[ai][bj][m][1] + bv[bj][1];
#pragma unroll
                for (int j = 0; j < 4; ++j) { a[j] = y[j] * sigmoid_f(a[j]); b[j] = y[4 + j] * sigmoid_f(b[j]); }
                *(v4u*)(O + off + bj * 128) = pack8(a, b); } }
    }
};
struct EpiResid {
    static constexpr bool PERM = true, AFTER_DRAIN = false;
    const float* xin; float* xout; bf16* xb; float* sq;
    __device__ __forceinline__ void operator()(const f32x4 (&acc)[2][2][4][2], const Unit& u, int wr, int wc, int fr, int fq) const {
        const int row0 = u.pm * 256 + wr * 64 + fr, col0 = u.pn * 256 + wc * 32 + 8 * fq;
        EPI_LOOP_AM { const int row = row0 + ai * 128 + m * 16; const size_t off = (size_t)row * D + col0; float s = 0.f;
#pragma unroll
            for (int bj = 0; bj < 2; ++bj) { const f32x4 a = *(const f32x4*)(xin + off + bj * 128) + acc[ai][bj][m][0], b = *(const f32x4*)(xin + off + bj * 128 + 4) + acc[ai][bj][m][1];
                *(f32x4*)(xout + off + bj * 128) = a; *(f32x4*)(xout + off + bj * 128 + 4) = b; *(v4u*)(xb + off + bj * 128) = pack8(a, b); s += sq8(a, b); }
            s += __shfl_xor(s, 16); s += __shfl_xor(s, 32); if (fq == 0) atomicAdd(sq + row, s); }
    }
};
struct EpiGateUp {
    static constexpr bool PERM = true, AFTER_DRAIN = false;
    bf16* H; const float* sq;
    __device__ __forceinline__ void operator()(const f32x4 (&acc)[2][2][4][2], const Unit& u, int wr, int wc, int fr, int fq) const {
        const int row0 = u.pm * 256 + wr * 64 + fr, col0 = u.pn * 128 + wc * 32 + 8 * fq;
        EPI_LOOP_AM { const int row = row0 + ai * 128 + m * 16; const float rs = __builtin_amdgcn_rsqf(sq[row] * (1.0f / D) + EPS);
            f32x4 a, b;
#pragma unroll
            for (int j = 0; j < 4; ++j) { const float g0 = acc[ai][0][m][0][j] * rs, u0 = acc[ai][1][m][0][j] * rs, g1 = acc[ai][0][m][1][j] * rs, u1 = acc[ai][1][m][1][j] * rs;
                a[j] = g0 * sigmoid_f(g0) * u0; b[j] = g1 * sigmoid_f(g1) * u1; }
            *(v4u*)(H + (size_t)row * FF + col0) = pack8(a, b); }
    }
};
struct EpiPle {
    static constexpr bool PERM = true, AFTER_DRAIN = false;
    float* xio; const bf16* PP; const float* sq;
    __device__ __forceinline__ void operator()(const f32x4 (&acc)[2][2][4][2], const Unit& u, int wr, int wc, int fr, int fq) const {
        const int row0 = u.pm * 256 + wr * 64 + fr, col0 = u.pn * 256 + wc * 32 + 8 * fq;
        EPI_LOOP_AM { const int row = row0 + ai * 128 + m * 16; const size_t off = (size_t)row * D + col0; const float rs = __builtin_amdgcn_rsqf(sq[row] * (1.0f / D) + EPS);
#pragma unroll
            for (int bj = 0; bj < 2; ++bj) { float pp[8]; unpack8(*(const v4u*)(PP + off + bj * 128), pp);
                f32x4 a = *(const f32x4*)(xio + off + bj * 128), b = *(const f32x4*)(xio + off + bj * 128 + 4);
#pragma unroll
                for (int j = 0; j < 4; ++j) { a[j] += sigmoid_f(acc[ai][bj][m][0][j] * rs) * pp[j]; b[j] += sigmoid_f(acc[ai][bj][m][1][j] * rs) * pp[4 + j]; }
                *(f32x4*)(xio + off + bj * 128) = a; *(f32x4*)(xio + off + bj * 128 + 4) = b; } }
    }
};

__device__ __forceinline__ int dest_row(int mode, int n) {
    if (mode == 0) return n;
    if (mode == 1) return n < 768 ? n : (n < 832 ? n + 1024 : n - 64);
    if (mode == 2) return 256 * (n >> 7) + (n & 127);
    return 256 * (n >> 7) + 128 + (n & 127);
}
__device__ __forceinline__ void transpose_item(const float* W, int Nsrc, bf16* WT, int ldwt, const float* gain, int mode, LAS float* scr, int item, int lane) {
    const int nblk = Nsrc / 32, kb = item / nblk, nb = item % nblk, k0 = 64 * kb, n0 = 32 * nb;
#pragma unroll 8
    for (int i = 0; i < 32; ++i) { const int kk = 2 * i + (lane >> 5); float v = W[(size_t)(k0 + kk) * Nsrc + n0 + (lane & 31)]; if (gain) v *= gain[k0 + kk]; scr[kk * 33 + (lane & 31)] = v; }
    LDS_WAIT(); asm volatile("" ::: "memory");
    const int c = lane & 7; const int r0 = dest_row(mode, n0);
#pragma unroll
    for (int j = 0; j < 4; ++j) { const int n = (lane >> 3) + 8 * j; const LAS float* s = scr + (8 * c) * 33 + n;
        v4u o; o.x = pk2(s[0 * 33], s[1 * 33]); o.y = pk2(s[2 * 33], s[3 * 33]); o.z = pk2(s[4 * 33], s[5 * 33]); o.w = pk2(s[6 * 33], s[7 * 33]);
        *(GAS v4u*)(WT + (size_t)(r0 + n) * ldwt + k0 + 8 * c) = o; }
    LDS_WAIT(); asm volatile("" ::: "memory");
}
struct Args { const void* in[31]; float* out; unsigned char* ws; int ph_lo, ph_hi; };
#define INF(i) ((const float*)args.in[i])

__device__ __forceinline__ void phase_prologue(const Args& args, LAS unsigned char* lds, int gw, int NGW, int wave, int lane) {
    unsigned char* ws = args.ws;
    LAS float* scr = (LAS float*)(lds + wave * 16384);
    constexpr int I0 = 32 * 58, I1 = 8 * 48, I2 = 4 * 64, I3 = 16 * 32, I4 = 16 * 64, I5 = 16 * 64, I6 = 32 * 176, I7 = 32 * 176, I8 = 88 * 64, I9 = 32 * 64, I10 = 4 * 64;
    constexpr int NITEMS = I0 + I1 + I2 + I3 + I4 + I5 + I6 + I7 + I8 + I9 + I10;
    for (int it = gw; it < NITEMS; it += NGW) {
        int r = it;
        if (r < I0) { transpose_item(INF(4), 1856, (bf16*)(ws + WS_WIN), 2048, INF(3), 1, scr, r, lane); continue; } r -= I0;
        if (r < I1) { transpose_item(INF(6), 1536, (bf16*)(ws + WS_WUQ), 512, INF(5), 0, scr, r, lane); continue; } r -= I1;
        if (r < I2) { transpose_item(INF(8), 2048, (bf16*)(ws + WS_WUKV), 256, INF(7), 0, scr, r, lane); continue; } r -= I2;
        if (r < I3) { transpose_item(INF(19), 1024, (bf16*)(ws + WS_WGLU), 1024, nullptr, 0, scr, r, lane); continue; } r -= I3;
        if (r < I4) { transpose_item(INF(23), 2048, (bf16*)(ws + WS_WO), 2048, INF(21), 0, scr, r, lane); continue; } r -= I4;
        if (r < I5) { transpose_item(INF(23) + (size_t)1024 * 2048, 2048, (bf16*)(ws + WS_WO) + 1024, 2048, INF(22), 0, scr, r, lane); continue; } r -= I5;
        if (r < I6) { transpose_item(INF(25), FF, (bf16*)(ws + WS_WGU), 2048, INF(24), 2, scr, r, lane); continue; } r -= I6;
        if (r < I7) { transpose_item(INF(26), FF, (bf16*)(ws + WS_WGU), 2048, INF(24), 3, scr, r, lane); continue; } r -= I7;
        if (r < I8) { transpose_item(INF(27), 2048, (bf16*)(ws + WS_WDN), FF, nullptr, 0, scr, r, lane); continue; } r -= I8;
        if (r < I9) { transpose_item(INF(29), 2048, (bf16*)(ws + WS_WPG), 2048, INF(28), 0, scr, r, lane); continue; } r -= I9;
        transpose_item(INF(30), 2048, (bf16*)(ws + WS_WPP), 256, nullptr, 0, scr, r, lane);
    }
    { GAS v4u* z = (GAS v4u*)(ws + WS_WIN + (size_t)1856 * 2048 * 2); const int n16 = 192 * 2048 * 2 / 16;
      for (int i = gw * 64 + lane; i < n16; i += NGW * 64) z[i] = (v4u){0u, 0u, 0u, 0u}; }
    for (int r = gw; r < M; r += NGW) {
        const GAS f32x4* xr = (const GAS f32x4*)(INF(0) + (size_t)r * D) + lane;
        f32x4 v[8]; float s = 0.f;
#pragma unroll
        for (int j = 0; j < 8; ++j) { v[j] = xr[64 * j]; s += (v[j][0] * v[j][0] + v[j][1] * v[j][1]) + (v[j][2] * v[j][2] + v[j][3] * v[j][3]); }
        const float rs = 1.0f / sqrtf(wave_sum(s) * (1.0f / D) + EPS);
        GAS v2u* o = (GAS v2u*)((bf16*)(ws + WS_HN) + (size_t)r * D) + lane;
#pragma unroll
        for (int j = 0; j < 8; ++j) { v2u w; w.x = pk2(v[j][0] * rs, v[j][1] * rs); w.y = pk2(v[j][2] * rs, v[j][3] * rs); o[64 * j] = w; }
    }
    { const GAS f32x4* p4 = (const GAS f32x4*)INF(1); GAS v2u* o = (GAS v2u*)(ws + WS_PB); const int n4 = M * PLE / 4;
      for (int i = gw * 64 + lane; i < n4; i += NGW * 64) { const f32x4 v = p4[i]; v2u w; w.x = pk2(v[0], v[1]); w.y = pk2(v[2], v[3]); o[i] = w; } }
    for (int i = gw * 64 + lane; i < NG * NP; i += NGW * 64) {
        const int g = i / NP;
        const double lr = fmin((double)INF(11)[i], -1e-4), li = (double)INF(12)[i], dt = exp((double)INF(13)[g]);
        const double mag = exp(lr * dt), are = mag * cos(li * dt), aim = mag * sin(li * dt), den = lr * lr + li * li;
        const double nre = are - 1.0, nim = aim, cre = (nre * lr + nim * li) / den, cim = (nim * lr - nre * li) / den;
        float* ab = (float*)(ws + WS_ABAR); ab[2 * i] = (float)are; ab[2 * i + 1] = (float)aim;
        float* bbr = (float*)(ws + WS_BBR) + (size_t)i * GH; float* bbi = (float*)(ws + WS_BBI) + (size_t)i * GH;
        for (int h = 0; h < GH; ++h) { const double br = INF(14)[(size_t)i * GH + h], bi = INF(15)[(size_t)i * GH + h]; bbr[h] = (float)(cre * br - cim * bi); bbi[h] = (float)(cre * bi + cim * br); }
    }
}

__device__ __forceinline__ void phase_s5_naive(const Args& args, LAS unsigned char* lds, int gw, int NGW, int wave, int lane) {
    unsigned char* ws = args.ws;
    LAS float* SR = (LAS float*)(lds + wave * 16384); LAS float* SI = SR + 32 * 64;
    const bf16* Z = (const bf16*)(ws + WS_Z); bf16* YG = (bf16*)(ws + WS_YG);
    for (int unit = gw; unit < NB * NG; unit += NGW) {
        const int b = unit / NG, g = unit % NG, p = lane;
        const float are = ((const float*)(ws + WS_ABAR))[2 * (g * NP + p)], aim = ((const float*)(ws + WS_ABAR))[2 * (g * NP + p) + 1];
        float bbr[GH], bbi[GH];
#pragma unroll
        for (int h = 0; h < GH; ++h) { bbr[h] = ((const float*)(ws + WS_BBR))[(size_t)(g * NP + p) * GH + h]; bbi[h] = ((const float*)(ws + WS_BBI))[(size_t)(g * NP + p) * GH + h]; }
        const int hB = lane & 15, pq = lane >> 4;
        float cr[16], ci[16];
#pragma unroll
        for (int i = 0; i < 16; ++i) { cr[i] = INF(16)[(size_t)(g * GH + hB) * NP + 16 * pq + i]; ci[i] = INF(17)[(size_t)(g * GH + hB) * NP + 16 * pq + i]; }
        const float dsk = INF(18)[g * GH + hB];
        float sre = 0.f, sim = 0.f;
        for (int t0 = 0; t0 < SEQ; t0 += 32) {
            for (int tt = 0; tt < 32; ++tt) {
                const bf16* up = Z + (size_t)(b * SEQ + t0 + tt) * ZLD + ZC_U + GH * g;
                float uf[16]; { float a8[8], b8[8]; unpack8(*(const v4u*)up, a8); unpack8(*(const v4u*)(up + 8), b8);
#pragma unroll
                    for (int h = 0; h < 8; ++h) { uf[h] = a8[h]; uf[8 + h] = b8[h]; } }
                float bur = 0.f, bui = 0.f;
#pragma unroll
                for (int h = 0; h < GH; ++h) { bur = fmaf(bbr[h], uf[h], bur); bui = fmaf(bbi[h], uf[h], bui); }
                const float nr = are * sre - aim * sim + bur, ni = are * sim + aim * sre + bui; sre = nr; sim = ni;
                SR[tt * 64 + p] = sre; SI[tt * 64 + p] = sim;
            }
            LDS_WAIT(); asm volatile("" ::: "memory");
            for (int tt = 0; tt < 32; ++tt) {
                float a = 0.f;
#pragma unroll
                for (int i = 0; i < 16; ++i) { a = fmaf(SR[tt * 64 + 16 * pq + i], cr[i], a); a = fmaf(-SI[tt * 64 + 16 * pq + i], ci[i], a); }
                a += __shfl_xor(a, 16); a += __shfl_xor(a, 32);
                if (pq == 0) { const size_t tok = (size_t)(b * SEQ + t0 + tt); const float uh = bf2f(Z[tok * ZLD + ZC_U + GH * g + hB]);
                    YG[tok * SSMW + GH * g + hB] = (bf16)f2bf(gelu_tanh(a + dsk * uh)); }
            }
            LDS_WAIT(); asm volatile("" ::: "memory");
        }
    }
}

__device__ __forceinline__ void phase_qkv_finalize(const Args& args, int gw, int NGW, int lane) {
    unsigned char* ws = args.ws;
    const bf16* QRAW = (const bf16*)(ws + WS_QRAW); const bf16* KVRAW = (const bf16*)(ws + WS_KVRAW); const bf16* Z = (const bf16*)(ws + WS_Z);
    bf16* Q = (bf16*)(ws + WS_Q); bf16* K = (bf16*)(ws + WS_K); bf16* V = (bf16*)(ws + WS_V);
    const float* gq = INF(9); const float* gk = INF(10); const int* pos = (const int*)args.in[2];
    const float gq0 = gq[lane], gq1 = gq[64 + lane], gq2 = gq[128 + lane], gk0 = gk[lane], gk1 = gk[64 + lane], gk2 = gk[128 + lane];
    const float invf = exp2f(-(float)(lane & 31) * (13.287712379549449f / 32.0f));
    for (int task = gw; task < M * NH; task += NGW) {
        const int tok = task >> 3, h = task & 7, b = tok / SEQ, t = tok % SEQ;
        const float ang = (float)pos[tok] * invf; float sn, cs; sincosf(ang, &sn, &cs);
        const size_t orow = (size_t)((b * NH + h) * SEQ + t);
        { const bf16* qp = QRAW + (size_t)tok * 1536 + h * DQK;
          float v0 = bf2f(qp[lane]), v1 = bf2f(qp[64 + lane]), v2 = bf2f(qp[128 + lane]);
          const float rs = 1.0f / sqrtf(wave_sum(v0 * v0 + v1 * v1 + v2 * v2) * (1.0f / DQK) + EPS);
          v0 *= rs * gq0; v1 *= rs * gq1; v2 *= rs * gq2;
          const float pr = __shfl_xor(v2, 32); const float r2 = lane < 32 ? v2 * cs - pr * sn : v2 * cs + pr * sn;
          bf16* o = Q + orow * DQK; o[lane] = (bf16)f2bf(v0); o[64 + lane] = (bf16)f2bf(v1); o[128 + lane] = (bf16)f2bf(r2); }
        { const bf16* kp = KVRAW + (size_t)tok * 2048 + h * 256;
          float v0 = bf2f(kp[lane]), v1 = bf2f(kp[64 + lane]), v2 = bf2f(Z[(size_t)tok * ZLD + ZC_KR + lane]);
          const float rs = 1.0f / sqrtf(wave_sum(v0 * v0 + v1 * v1 + v2 * v2) * (1.0f / DQK) + EPS);
          v0 *= rs * gk0; v1 *= rs * gk1; v2 *= rs * gk2;
          const float pr = __shfl_xor(v2, 32); const float r2 = lane < 32 ? v2 * cs - pr * sn : v2 * cs + pr * sn;
          bf16* o = K + orow * DQK; o[lane] = (bf16)f2bf(v0); o[64 + lane] = (bf16)f2bf(v1); o[128 + lane] = (bf16)f2bf(r2);
          bf16* vo = V + orow * DV; vo[lane] = kp[128 + lane]; vo[64 + lane] = kp[192 + lane]; }
    }
}

__device__ __forceinline__ void phase_attn_naive(const Args& args, LAS unsigned char* lds, int gw, int NGW, int wave, int lane) {
    unsigned char* ws = args.ws;
    const bf16* Q = (const bf16*)(ws + WS_Q); const bf16* K = (const bf16*)(ws + WS_K); const bf16* V = (const bf16*)(ws + WS_V); bf16* OA = (bf16*)(ws + WS_OA);
    LAS float* qf = (LAS float*)(lds + wave * 2048); LAS float* pb = qf + 192;
    const float scale = 0.07216878364870322f;
    for (int idx = gw; idx < NB * NH * SEQ; idx += NGW) {
        const int bh = idx / SEQ, i0 = idx % SEQ, i = (bh & 1) ? SEQ - 1 - i0 : i0, b = bh / NH, h = bh % NH;
        const bf16* qp = Q + ((size_t)bh * SEQ + i) * DQK;
        qf[lane] = bf2f(qp[lane]); qf[64 + lane] = bf2f(qp[64 + lane]); qf[128 + lane] = bf2f(qp[128 + lane]);
        LDS_WAIT(); asm volatile("" ::: "memory");
        float m = -1e30f, l = 0.f, o0 = 0.f, o1 = 0.f;
        const int nch = i / 64 + 1;
        for (int c = 0; c < nch; ++c) {
            const int kj = 64 * c + lane; const bf16* kp = K + ((size_t)bh * SEQ + kj) * DQK;
            float s = 0.f;
#pragma unroll 4
            for (int d = 0; d < DQK; d += 8) { float kf[8]; unpack8(*(const v4u*)(kp + d), kf); const f32x4 qa = *(const LAS f32x4*)(qf + d), qb = *(const LAS f32x4*)(qf + d + 4);
                s += (kf[0] * qa[0] + kf[1] * qa[1]) + (kf[2] * qa[2] + kf[3] * qa[3]) + (kf[4] * qb[0] + kf[5] * qb[1]) + (kf[6] * qb[2] + kf[7] * qb[3]); }
            s = kj <= i ? s * scale : -__builtin_inff();
            const float mn = fmaxf(m, wave_max(s)), alpha = __expf(m - mn), pj = __expf(s - mn);
            l = l * alpha + wave_sum(pj); o0 *= alpha; o1 *= alpha; m = mn;
            pb[lane] = pj; LDS_WAIT(); asm volatile("" ::: "memory");
            const bf16* vp = V + ((size_t)bh * SEQ + 64 * c) * DV + lane;
#pragma unroll 8
            for (int j = 0; j < 64; ++j) { const float pw = pb[j]; o0 = fmaf(pw, bf2f(vp[j * DV]), o0); o1 = fmaf(pw, bf2f(vp[j * DV + 64]), o1); }
            LDS_WAIT(); asm volatile("" ::: "memory");
        }
        const float il = 1.0f / l; bf16* op = OA + ((size_t)(b * SEQ + i)) * 1024 + h * DV;
        op[lane] = (bf16)f2bf(o0 * il); op[64 + lane] = (bf16)f2bf(o1 * il);
    }
}

__device__ __forceinline__ void phase_mix_norm(const Args& args, int gw, int NGW, int lane) {
    unsigned char* ws = args.ws;
    for (int r = gw; r < M; r += NGW) {
#pragma unroll
        for (int part = 0; part < 2; ++part) {
            const bf16* src = (const bf16*)(ws + (part ? WS_OS : WS_OA)) + (size_t)r * 1024 + lane * 8;
            float a[8], c[8]; unpack8(*(const v4u*)src, a); unpack8(*(const v4u*)(src + 512), c);
            float s = 0.f;
#pragma unroll
            for (int j = 0; j < 8; ++j) s += a[j] * a[j] + c[j] * c[j];
            const float rs = 1.0f / sqrtf(wave_sum(s) * (1.0f / 1024.0f) + EPS);
            bf16* dst = (bf16*)(ws + WS_Z) + (size_t)r * 2048 + part * 1024 + lane * 8;
            v4u w0, w1; w0.x = pk2(a[0] * rs, a[1] * rs); w0.y = pk2(a[2] * rs, a[3] * rs); w0.z = pk2(a[4] * rs, a[5] * rs); w0.w = pk2(a[6] * rs, a[7] * rs);
            w1.x = pk2(c[0] * rs, c[1] * rs); w1.y = pk2(c[2] * rs, c[3] * rs); w1.z = pk2(c[4] * rs, c[5] * rs); w1.w = pk2(c[6] * rs, c[7] * rs);
            *(v4u*)dst = w0; *(v4u*)(dst + 512) = w1;
        }
    }
}

template <class Epi> __device__ __forceinline__ void run_gemm(LAS unsigned char* lds, const bf16* A, int lda, const bf16* Bt, int ldb, int N, int K, const Epi& E) {
    pg8::Gemm g{A, Bt, M, N, K, lda, ldb}; pg8::StaticOrder S; S.init(M, N, (int)gridDim.x, (int)blockIdx.x);
    pg8::gemm_phase<Epi, pg8::StaticOrder, PG8_ALIGN, PG8_SP2>(lds, g, S, E);
}

__global__ void __launch_bounds__(NWAVES * 64, 2) mega_fwd(Args args) {
    extern __shared__ __attribute__((aligned(16))) unsigned char lds_raw[];
    LAS unsigned char* lds = (LAS unsigned char*)lds_raw;
    volatile LAS unsigned* MISC = (volatile LAS unsigned*)(lds + MISC_OFF);
    const int tid = threadIdx.x, lane = tid & 63, wave = __builtin_amdgcn_readfirstlane(tid >> 6);
    const int G = gridDim.x; const int bx = blockIdx.x; const int vcu = (G % 8 == 0) ? (bx % 8) * (G / 8) + bx / 8 : bx;
    const int gw = vcu * NWAVES + wave, NGW = G * NWAVES;
    unsigned char* ws = args.ws;
    for (int u = tid; u < (LDS_BYTES - 139264) / 4; u += NWAVES * 64) ((LAS unsigned*)(lds + 139264))[u] = 0u;
    __syncthreads();
    const int lo = args.ph_lo, hi = args.ph_hi;
    XcdBarrier bar; bar.bar = (unsigned*)(ws + WS_CTL) + CW_BAR; bar.x = 0; bar.st = nullptr;
    if (hi - lo > 1) bar = xcd_barrier_post((unsigned*)(ws + WS_CTL) + CW_BAR, MISC + 8);
#define IN(k) (lo <= (k) && (k) < hi)
#define SEAM(k) do { if (IN(k) && IN((k) + 1)) xcd_barrier(bar); } while (0)
    float* sqq = (float*)(ws + SQ_Q); float* sqkv = (float*)(ws + SQ_KV); float* sqx1 = (float*)(ws + SQ_X1); float* sqx2 = (float*)(ws + SQ_X2);

    if (IN(0)) { phase_prologue(args, lds, gw, NGW, wave, lane); __syncthreads(); }
    SEAM(0);
    if (IN(1)) { EpiZ E{(bf16*)(ws + WS_Z), sqq, sqkv}; run_gemm(lds, (const bf16*)(ws + WS_HN), D, (const bf16*)(ws + WS_WIN), D, 2048, D, E); }
    SEAM(1);
    if (IN(2)) {
        { EpiScale E{(bf16*)(ws + WS_QRAW), 1536, sqq, 1.0f / QL}; run_gemm(lds, (const bf16*)(ws + WS_Z) + ZC_Q, ZLD, (const bf16*)(ws + WS_WUQ), QL, 1536, QL, E); }
        { EpiScale E{(bf16*)(ws + WS_KVRAW), 2048, sqkv, 1.0f / KVL}; run_gemm(lds, (const bf16*)(ws + WS_Z) + ZC_KV, ZLD, (const bf16*)(ws + WS_WUKV), KVL, 2048, KVL, E); }
    }
    SEAM(2);
    if (IN(3)) { phase_qkv_finalize(args, gw, NGW, lane); phase_s5_naive(args, lds, gw, NGW, wave, lane); __syncthreads(); }
    SEAM(3);
    if (IN(4)) {
        phase_attn_naive(args, lds, gw, NGW, wave, lane); __syncthreads();
        { EpiGlu E{(const bf16*)(ws + WS_YG), INF(20), (bf16*)(ws + WS_OS)}; run_gemm(lds, (const bf16*)(ws + WS_YG), SSMW, (const bf16*)(ws + WS_WGLU), SSMW, SSMW, SSMW, E); }
    }
    SEAM(4);
    if (IN(5)) { phase_mix_norm(args, gw, NGW, lane); }
    SEAM(5);
    if (IN(6)) { EpiResid E{INF(0), args.out, (bf16*)(ws + WS_HN), sqx1}; run_gemm(lds, (const bf16*)(ws + WS_Z), D, (const bf16*)(ws + WS_WO), D, D, D, E); }
    SEAM(6);
    if (IN(7)) {
        { EpiGateUp E{(bf16*)(ws + WS_H), sqx1}; run_gemm(lds, (const bf16*)(ws + WS_HN), D, (const bf16*)(ws + WS_WGU), D, 2 * FF, D, E); }
        { EpiPlain E{(bf16*)(ws + WS_PP), D}; run_gemm(lds, (const bf16*)(ws + WS_PB), PLE, (const bf16*)(ws + WS_WPP), PLE, D, PLE, E); }
    }
    SEAM(7);
    if (IN(8)) { EpiResid E{args.out, args.out, (bf16*)(ws + WS_HN), sqx2}; run_gemm(lds, (const bf16*)(ws + WS_H), FF, (const bf16*)(ws + WS_WDN), FF, D, FF, E); }
    SEAM(8);
    if (IN(9)) { EpiPle E{args.out, (const bf16*)(ws + WS_PP), sqx2}; run_gemm(lds, (const bf16*)(ws + WS_HN), D, (const bf16*)(ws + WS_WPG), D, D, D, E); }
#undef IN
#undef SEAM
}

extern "C" void kernel_launch(void* const* d_in, const int* in_sizes, int n_in, void* d_out, int out_size, void* d_ws, size_t ws_size, hipStream_t stream) {
    static int grid = 0;
    if (grid == 0) {
        if (n_in != 31 || out_size != M * D || ws_size < WS_END) { fprintf(stderr, "kernel_launch: unexpected shapes (n_in %d, out %d, ws %zu)\n", n_in, out_size, ws_size); grid = -1; return; }
        int dev = 0, cus = 0;
        if (hipGetDevice(&dev) != hipSuccess || hipDeviceGetAttribute(&cus, hipDeviceAttributeMultiprocessorCount, dev) != hipSuccess) { grid = -1; return; }
        if (hipFuncSetAttribute((const void*)mega_fwd, hipFuncAttributeMaxDynamicSharedMemorySize, LDS_BYTES) != hipSuccess) { fprintf(stderr, "kernel_launch: hipFuncSetAttribute failed\n"); grid = -1; return; }
        int per_cu = 0;
        if (hipOccupancyMaxActiveBlocksPerMultiprocessor(&per_cu, (const void*)mega_fwd, NWAVES * 64, LDS_BYTES) != hipSuccess || per_cu < 1) fprintf(stderr, "kernel_launch: occupancy query says %d blocks/CU\n", per_cu);
        (void)hipGetLastError();
        grid = cus > 0 ? cus : 256;
    }
    if (grid < 0) return;
    (void)hipMemsetAsync((char*)d_ws + WS_CTL, 0, CTL_ZERO_BYTES, stream);
    Args a{};
    for (int i = 0; i < 31; ++i) a.in[i] = d_in[i];
    a.out = (float*)d_out; a.ws = (unsigned char*)d_ws;
    constexpr int NL = MK_N_LAUNCHES;
    for (int li = 0; li < NL; ++li) {
        a.ph_lo = (NL == 1) ? 0 : li; a.ph_hi = (NL == 1) ? NPHASES : li + 1;
        hipLaunchKernelGGL(mega_fwd, dim3(grid), dim3(NWAVES * 64), LDS_BYTES, stream, a);
    }
}
```

```cpp
#include <hip/hip_runtime.h>
#include <cstdio>
#include <cstdint>
namespace pg8 {
#define PG8_LAS __attribute__((address_space(3)))
typedef unsigned short bf16_t;
typedef short bf16x8 __attribute__((ext_vector_type(8)));
typedef float f32x4 __attribute__((ext_vector_type(4)));
typedef unsigned u32x4 __attribute__((ext_vector_type(4)));
constexpr int BM = 256, BK = 64, HALF = 128, HTB = HALF * BK * 2  , STAGE_BYTES = 8 * HTB, NXCD = 8, WGM = 8;

__host__ __device__ __forceinline__ int lds_byte(int r, int c) { const int st = (r >> 4) * 2 + (c >> 5), rr = r & 15, cc = c & 31, ob = rr * 64 + cc * 2; return st * 1024 + (ob ^ (((ob >> 9) & 1) << 5)); }
__host__ __device__ __forceinline__ void stage_rc(int b, int& R, int& C) { const int st = b / 1024, sb = b % 1024, swz = sb ^ (((sb >> 9) & 1) << 5); R = (st >> 1) * 16 + swz / 64; C = (st & 1) * 32 + (swz % 64) / 2; }
__host__ __device__ __forceinline__ int perm32(int rho) { const int n = rho >> 4, i = rho & 15; return 8 * (i >> 2) + 4 * n + (i & 3); }

struct Unit { int pm, pn; };
struct Gemm { const bf16_t* A; const bf16_t* Bt; int M, N, K, lda, ldb; };

struct StaticOrder {
    int nM, nN, nwg, G, c;
    __host__ __device__ void init(int M, int N, int G_, int c_) { nM = M / BM; nN = N / BM; nwg = nM * nN; G = G_; c = c_; }
    __host__ __device__ bool next(int i, Unit& u) const {
        const long L = (long)i * G + c; if (L >= nwg) return false;
        int wgid = (int)L; { const int q = nwg / NXCD, r = nwg % NXCD, xcd = wgid % NXCD, off = wgid / NXCD; wgid = (xcd < r ? xcd * (q + 1) : r * (q + 1) + (xcd - r) * q) + off; }
        const int nig = WGM * nN, gid = wgid / nig, fm = gid * WGM, gsz = (nM - fm) < WGM ? (nM - fm) : WGM;
        u.pm = fm + ((wgid % nig) % gsz); u.pn = (wgid % nig) / gsz; return true;
    }
    __device__ __forceinline__ void a_ready(const Unit&) const {}
    __device__ __forceinline__ void done(const Unit&) const {}
};

__device__ __forceinline__ unsigned cvt_pk_bf16(float lo, float hi) { unsigned r; asm volatile("v_cvt_pk_bf16_f32 %0, %1, %2" : "=v"(r) : "v"(lo), "v"(hi)); return r; }
typedef float f32x2 __attribute__((ext_vector_type(2)));
template <class Epi, class Sched, bool ALIGN_EPI = false, bool SP2 = false>
__device__ __forceinline__ void gemm_phase(PG8_LAS unsigned char* lds, const Gemm g, const Sched& S, const Epi& E) {
    const int tid = threadIdx.x, wid = __builtin_amdgcn_readfirstlane(tid >> 6), lane = tid & 63, wr = wid >> 2, wc = wid & 3, fr = lane & 15, fq = lane >> 4;
    const int K = g.K, nt = K / BK;
    unsigned voffA[2], voffB[2];
#pragma unroll
    for (int i = 0; i < 2; ++i) { int R, C; stage_rc(tid * 16 + i * 8192, R, C); const int Rb = Epi::PERM ? ((R & ~31) + perm32(R & 31)) : R;
        voffA[i] = (unsigned)(R * g.lda + C) * 2u; voffB[i] = (unsigned)(Rb * g.ldb + C) * 2u; }
    const size_t kstep = (size_t)(BK * 2);
    const size_t hstepA = (size_t)HALF * g.lda * 2, hstepB = (size_t)HALF * g.ldb * 2;
    const size_t tstepA = 2 * hstepA, tstepB = 2 * hstepB;
    const unsigned ldsw = (unsigned)wid * 1024u;
    const int aoff = lds_byte(wr * 64 + fr, fq * 8), boff = lds_byte(wc * 32 + fr, fq * 8);
#define PG8_SA(b, h) (((b) * 2 + (h)) * HTB)
#define PG8_SB(b, h) ((4 + (b) * 2 + (h)) * HTB)
#define PG8_STAGE(bufoff, gbase, voff) do { _Pragma("unroll") for (int _i = 0; _i < 2; ++_i) \
        __builtin_amdgcn_global_load_lds((const unsigned*)((const char*)(gbase) + (voff)[_i]), (PG8_LAS unsigned*)(lds + (bufoff) + ldsw + _i * 8192), 16, 0, 0); } while (0)
#define PG8_LDA(dst, b, h) do { _Pragma("unroll") for (int m = 0; m < 4; ++m) _Pragma("unroll") for (int k = 0; k < 2; ++k) dst[m][k] = *(const PG8_LAS bf16x8*)(lds + PG8_SA(b, h) + aoff + m * 2048 + k * 1024); } while (0)
#define PG8_LDB(dst, b, h) do { _Pragma("unroll") for (int n = 0; n < 2; ++n) _Pragma("unroll") for (int k = 0; k < 2; ++k) dst[n][k] = *(const PG8_LAS bf16x8*)(lds + PG8_SB(b, h) + boff + n * 2048 + k * 1024); } while (0)
#define PG8_MMA(ai, bj, At, Bt) do { __builtin_amdgcn_s_setprio(1); _Pragma("unroll") for (int m = 0; m < 4; ++m) _Pragma("unroll") for (int n = 0; n < 2; ++n) _Pragma("unroll") for (int k = 0; k < 2; ++k) \
        acc[ai][bj][m][n] = __builtin_amdgcn_mfma_f32_16x16x32_bf16(Bt[n][k], At[m][k], acc[ai][bj][m][n], 0, 0, 0); __builtin_amdgcn_s_setprio(0); } while (0)
#define PG8_WAIT_V(n) asm volatile("s_waitcnt vmcnt(" #n ")" ::: "memory")
#define PG8_WAIT_L(n) asm volatile("s_waitcnt lgkmcnt(" #n ")" ::: "memory")
#define PG8_BAR __builtin_amdgcn_s_barrier()
#define PG8_SCHED __builtin_amdgcn_sched_barrier(0)
    Unit cur, nxt; int ui = 0;
    if (!S.next(0, cur)) return;
    f32x4 acc[2][2][4][2];
#pragma unroll
    for (int a = 0; a < 2; ++a)
#pragma unroll
        for (int b = 0; b < 2; ++b)
#pragma unroll
            for (int m = 0; m < 4; ++m)
#pragma unroll
                for (int n = 0; n < 2; ++n) acc[a][b][m][n] = (f32x4){0.f, 0.f, 0.f, 0.f};
    bf16x8 At[4][2], B0[2][2], B1[2][2];
    const char* cA = (const char*)g.A + (size_t)cur.pm * tstepA; const char* cB = (const char*)g.Bt + (size_t)cur.pn * tstepB;
    S.a_ready(cur);
    if constexpr (SP2) {
        PG8_STAGE(PG8_SB(0, 0), cB, voffB); PG8_STAGE(PG8_SB(0, 1), cB + hstepB, voffB); PG8_STAGE(PG8_SA(0, 0), cA, voffA); PG8_STAGE(PG8_SA(0, 1), cA + hstepA, voffA);
        if (wr == 1) PG8_BAR;
        PG8_WAIT_V(2); PG8_BAR;
        PG8_STAGE(PG8_SB(1, 0), cB + kstep, voffB); PG8_STAGE(PG8_SA(1, 0), cA + kstep, voffA); PG8_STAGE(PG8_SB(1, 1), cB + hstepB + kstep, voffB);
        PG8_WAIT_V(6); PG8_BAR;
    } else {
        PG8_STAGE(PG8_SB(0, 0), cB, voffB); PG8_STAGE(PG8_SA(0, 0), cA, voffA); PG8_STAGE(PG8_SB(0, 1), cB + hstepB, voffB); PG8_STAGE(PG8_SA(0, 1), cA + hstepA, voffA);
        if (wr == 1) PG8_BAR;
        PG8_WAIT_V(4); PG8_BAR;
        PG8_STAGE(PG8_SB(1, 0), cB + kstep, voffB); PG8_STAGE(PG8_SA(1, 0), cA + kstep, voffA); PG8_STAGE(PG8_SB(1, 1), cB + hstepB + kstep, voffB);
        PG8_WAIT_V(6); PG8_BAR;
    }
    for (;;) {
        const bool has_next = S.next(ui + 1, nxt);
        const char* nA = has_next ? (const char*)g.A + (size_t)nxt.pm * tstepA : cA; const char* nB = has_next ? (const char*)g.Bt + (size_t)nxt.pn * tstepB : cB;
        for (int t = 0; t < nt; t += 2) {
            const bool last = (t == nt - 2);
            const char* a1 = cA + (size_t)(t + 1) * kstep;
            const char* a2 = last ? nA : cA + (size_t)(t + 2) * kstep; const char* b2 = last ? nB : cB + (size_t)(t + 2) * kstep;
            const char* a3 = a2 + kstep; const char* b3 = b2 + kstep;
            if (last && has_next) S.a_ready(nxt);
            if constexpr (SP2) {
            PG8_LDB(B0, 0, 0); PG8_LDB(B1, 0, 1); PG8_SCHED; PG8_LDA(At, 0, 0); PG8_STAGE(PG8_SA(1, 1), a1 + hstepA, voffA);
            PG8_WAIT_V(8); PG8_WAIT_L(0); PG8_BAR; PG8_MMA(0, 0, At, B0); PG8_MMA(0, 1, At, B1); PG8_BAR; PG8_SCHED;
            PG8_LDA(At, 0, 1); PG8_STAGE(PG8_SB(0, 0), b2, voffB); PG8_STAGE(PG8_SB(0, 1), b2 + hstepB, voffB); PG8_STAGE(PG8_SA(0, 0), a2, voffA);
            PG8_WAIT_V(8); PG8_WAIT_L(0); PG8_BAR; PG8_MMA(1, 0, At, B0); PG8_MMA(1, 1, At, B1); PG8_BAR; PG8_SCHED;
            PG8_LDB(B0, 1, 0); PG8_LDB(B1, 1, 1); PG8_SCHED; PG8_LDA(At, 1, 0); PG8_STAGE(PG8_SA(0, 1), a2 + hstepA, voffA);
            PG8_WAIT_V(8); PG8_WAIT_L(0); PG8_BAR; PG8_MMA(0, 0, At, B0); PG8_MMA(0, 1, At, B1); PG8_BAR; PG8_SCHED;
            PG8_LDA(At, 1, 1); PG8_STAGE(PG8_SB(1, 0), b3, voffB); PG8_STAGE(PG8_SB(1, 1), b3 + hstepB, voffB); PG8_STAGE(PG8_SA(1, 0), a3, voffA);
            PG8_WAIT_V(8); PG8_WAIT_L(0); PG8_BAR; PG8_MMA(1, 0, At, B0); PG8_MMA(1, 1, At, B1); PG8_BAR; PG8_SCHED;
            } else {
            PG8_LDB(B0, 0, 0); PG8_SCHED; PG8_LDA(At, 0, 0); PG8_STAGE(PG8_SA(1, 1), a1 + hstepA, voffA);
            PG8_WAIT_L(8); PG8_BAR; PG8_WAIT_L(0); PG8_MMA(0, 0, At, B0); PG8_BAR; PG8_SCHED;
            PG8_LDB(B1, 0, 1); PG8_STAGE(PG8_SB(0, 0), b2, voffB);
            PG8_BAR; PG8_WAIT_L(0); PG8_MMA(0, 1, At, B1); PG8_BAR;
            PG8_LDA(At, 0, 1); PG8_STAGE(PG8_SA(0, 0), a2, voffA);
            PG8_BAR; PG8_WAIT_L(0); PG8_MMA(1, 0, At, B0); PG8_BAR; PG8_SCHED;
            PG8_STAGE(PG8_SB(0, 1), b2 + hstepB, voffB);
            PG8_WAIT_V(6); PG8_BAR; PG8_MMA(1, 1, At, B1); PG8_BAR;
            PG8_LDB(B0, 1, 0); PG8_SCHED; PG8_LDA(At, 1, 0); PG8_STAGE(PG8_SA(0, 1), a2 + hstepA, voffA);
            PG8_WAIT_L(8); PG8_BAR; PG8_WAIT_L(0); PG8_MMA(0, 0, At, B0); PG8_BAR; PG8_SCHED;
            PG8_LDB(B1, 1, 1); PG8_STAGE(PG8_SB(1, 0), b3, voffB);
            PG8_BAR; PG8_WAIT_L(0); PG8_MMA(0, 1, At, B1); PG8_BAR;
            PG8_LDA(At, 1, 1); PG8_STAGE(PG8_SA(1, 0), a3, voffA);
            PG8_BAR; PG8_WAIT_L(0); PG8_MMA(1, 0, At, B0); PG8_BAR; PG8_SCHED;
            PG8_STAGE(PG8_SB(1, 1), b3 + hstepB, voffB);
            PG8_WAIT_V(6); PG8_BAR; PG8_MMA(1, 1, At, B1); PG8_BAR;
            }
        }
        if constexpr (ALIGN_EPI) { if (wr == 0) PG8_BAR; }
        if constexpr (!Epi::AFTER_DRAIN) { E(acc, cur, wr, wc, fr, fq); S.done(cur); }
        if (!has_next) break;
#pragma unroll
        for (int a = 0; a < 2; ++a)
#pragma unroll
            for (int b = 0; b < 2; ++b)
#pragma unroll
                for (int m = 0; m < 4; ++m)
#pragma unroll
                    for (int n = 0; n < 2; ++n) acc[a][b][m][n] = (f32x4){0.f, 0.f, 0.f, 0.f};
        cur = nxt; cA = nA; cB = nB; ++ui;
        if constexpr (ALIGN_EPI) { if (wr == 1) PG8_BAR; }
    }
    PG8_WAIT_V(0);
    if constexpr (!ALIGN_EPI) { if (wr == 0) PG8_BAR; }
    PG8_BAR;
    if constexpr (Epi::AFTER_DRAIN) { E.fused(acc, cur, wr, wc, fr, fq, lds, wid, lane); S.done(cur); }
#undef PG8_SA
#undef PG8_SB
#undef PG8_STAGE
#undef PG8_LDA
#undef PG8_LDB
#undef PG8_MMA
#undef PG8_WAIT_V
#undef PG8_WAIT_L
#undef PG8_BAR
#undef PG8_SCHED
}
}

namespace att {
typedef short bf16x8 __attribute__((ext_vector_type(8)));
typedef short s16x4 __attribute__((ext_vector_type(4)));
typedef float f32x16 __attribute__((ext_vector_type(16)));
typedef unsigned u32x4 __attribute__((ext_vector_type(4)));
typedef unsigned short bf16;
constexpr int DQK = 192, DV = 128, KROW = 384, SHM_K = 64 * KROW, SHM_V = 64 * DV * 2;
constexpr int V_OFF = 0, K_OFF = 2 * SHM_V, WS_OFF = 2 * SHM_V + 2 * SHM_K, ATT_LDS = WS_OFF + 8 * 64 * 4;
constexpr float SCALE = 0.07216878364870322f, THR = 8.f;
#define ATT_KSWZ(row, colB) ((row) * 384 + ((colB) ^ (((row) & 7) << 4)))
#define ATT_SBAR() __builtin_amdgcn_sched_barrier(0)
__device__ __forceinline__ int v_st(int k, int c) { const int kk = (k & ~0xC) | ((k & 4) << 1) | ((k & 8) >> 1); return ((kk >> 3) * 4 + (c >> 5)) * 512 + ((kk & 7) * 32 + (c & 31)) * 2; }
__device__ __forceinline__ int v_rd_base(int lane) { return ((lane & 3) << 3) | (((lane >> 2) & 3) << 6) | (((lane >> 4) & 1) << 5) | (((lane >> 5) & 1) << 8); }
constexpr int v_rd_off(int d0, int ks, int half) { return d0 * 512 + ks * 4096 + half * 2048; }
__device__ __forceinline__ int crow(int r, int hi) { return (r & 3) + 8 * (r >> 2) + 4 * hi; }
__device__ __forceinline__ unsigned cvtpk(float lo, float hi) { unsigned r; asm volatile("v_cvt_pk_bf16_f32 %0, %1, %2" : "=v"(r) : "v"(lo), "v"(hi)); return r; }
__device__ __forceinline__ void mask_tile(f32x16& p0, f32x16& p1, int dq) {
    const float NEG = -__builtin_inff();
#pragma unroll
    for (int r = 0; r < 16; ++r) { const int c = (r & 3) + 8 * (r >> 2); if (dq - c < 0) p0[r] = NEG; if (dq - c - 32 < 0) p1[r] = NEG; }
}
__device__ __forceinline__ void partialSM(f32x16& p0, f32x16& p1, float& m_reg, float& mn, float& alpha) {
    float pmax = p0[0];
#pragma unroll
    for (int r = 1; r < 16; ++r) pmax = fmaxf(pmax, p0[r]);
#pragma unroll
    for (int r = 0; r < 16; ++r) pmax = fmaxf(pmax, p1[r]);
    { auto rr = __builtin_amdgcn_permlane32_swap(__float_as_uint(pmax), __float_as_uint(pmax), false, false);
      pmax = fmaxf(__uint_as_float(rr[0]), __uint_as_float(rr[1])); }
    constexpr float C2 = 1.4426950408889634f * SCALE;
    if (__builtin_expect(__all((pmax - m_reg) * SCALE <= THR), 1)) { mn = m_reg; alpha = 1.f; }
    else { mn = fmaxf(m_reg, pmax); alpha = __builtin_amdgcn_exp2f((m_reg - mn) * C2); m_reg = mn; }
    const float mnL = -mn * C2;
#pragma unroll
    for (int r = 0; r < 16; ++r) p0[r] = fmaf(p0[r], C2, mnL);
#pragma unroll
    for (int r = 0; r < 16; ++r) p1[r] = fmaf(p1[r], C2, mnL);
#pragma unroll
    for (int r = 0; r < 16; ++r) p0[r] = __builtin_amdgcn_exp2f(p0[r]);
}
__device__ __forceinline__ void finishSM(f32x16& p0, f32x16& p1, float alpha, float& l_reg, bf16x8& pa0, bf16x8& pa1, bf16x8& pa2, bf16x8& pa3) {
#pragma unroll
    for (int r = 0; r < 16; ++r) p1[r] = __builtin_amdgcn_exp2f(p1[r]);
    float ps = 0;
#pragma unroll
    for (int r = 0; r < 16; ++r) ps += p0[r];
#pragma unroll
    for (int r = 0; r < 16; ++r) ps += p1[r];
    { auto rr = __builtin_amdgcn_permlane32_swap(__float_as_uint(ps), __float_as_uint(ps), false, false);
      ps = __uint_as_float(rr[0]) + __uint_as_float(rr[1]); }
    l_reg = l_reg * alpha + ps;
#define ATT_PK4(P, B_, OUT) do { unsigned a0 = cvtpk(P[B_+0], P[B_+1]), a1 = cvtpk(P[B_+2], P[B_+3]);                          \
        unsigned b0 = cvtpk(P[B_+4], P[B_+5]), b1 = cvtpk(P[B_+6], P[B_+7]);                                             \
        auto r0 = __builtin_amdgcn_permlane32_swap(a0, b0, false, false); auto r1 = __builtin_amdgcn_permlane32_swap(a1, b1, false, false); \
        u32x4 w = {r0[0], r1[0], r0[1], r1[1]}; OUT = *reinterpret_cast<bf16x8*>(&w); } while (0)
    ATT_PK4(p0, 0, pa0); ATT_PK4(p0, 8, pa1); ATT_PK4(p1, 0, pa2); ATT_PK4(p1, 8, pa3);
#undef ATT_PK4
}
template <int KB>
__device__ __forceinline__ void qkt(f32x16& p0, f32x16& p1, const char* K_lds, int r32, int hi, const bf16x8* qr) {
    p0 = f32x16{}; p1 = f32x16{};
    const char* kb[4];
#pragma unroll
    for (int dd = 0; dd < 4; ++dd) kb[dd] = K_lds + KB * SHM_K + ATT_KSWZ(r32, (dd * 16 + hi * 8) * 2);
#pragma unroll
    for (int d0 = 0; d0 < 12; ++d0) { const char* a = kb[d0 & 3] + (d0 >> 2) * 128;
        bf16x8 b0 = *reinterpret_cast<const bf16x8*>(a);
        bf16x8 b1 = *reinterpret_cast<const bf16x8*>(a + 32 * KROW);
        p0 = __builtin_amdgcn_mfma_f32_32x32x16_bf16(b0, qr[d0], p0, 0, 0, 0);
        p1 = __builtin_amdgcn_mfma_f32_32x32x16_bf16(b1, qr[d0], p1, 0, 0, 0); }
}
template <int VB>
__device__ __forceinline__ void pv_tile(f32x16* o, int vb0, bf16x8 pa0, bf16x8 pa1, bf16x8 pa2, bf16x8 pa3) {
#define ATT_TRRD(dst, off) asm volatile("ds_read_b64_tr_b16 %0, %1 offset:%2" : "=&v"(dst) : "v"(vb0), "i"(off) : "memory")
#define ATT_PV_D0(d0) do { s16x4 l0, l1, l2, l3, h0, h1, h2, h3; constexpr int b_ = V_OFF + VB * SHM_V + v_rd_off(d0, 0, 0); \
        ATT_TRRD(l0, b_); ATT_TRRD(h0, b_ + 2048); ATT_TRRD(l1, b_ + 4096); ATT_TRRD(h1, b_ + 6144); ATT_TRRD(l2, b_ + 8192); ATT_TRRD(h2, b_ + 10240); ATT_TRRD(l3, b_ + 12288); ATT_TRRD(h3, b_ + 14336); \
        asm volatile("s_waitcnt lgkmcnt(0)" ::: "memory"); ATT_SBAR();   \
        o[d0] = __builtin_amdgcn_mfma_f32_32x32x16_bf16(pa0, (bf16x8){l0[0], l0[1], l0[2], l0[3], h0[0], h0[1], h0[2], h0[3]}, o[d0], 0, 0, 0);   \
        o[d0] = __builtin_amdgcn_mfma_f32_32x32x16_bf16(pa1, (bf16x8){l1[0], l1[1], l1[2], l1[3], h1[0], h1[1], h1[2], h1[3]}, o[d0], 0, 0, 0);   \
        o[d0] = __builtin_amdgcn_mfma_f32_32x32x16_bf16(pa2, (bf16x8){l2[0], l2[1], l2[2], l2[3], h2[0], h2[1], h2[2], h2[3]}, o[d0], 0, 0, 0);   \
        o[d0] = __builtin_amdgcn_mfma_f32_32x32x16_bf16(pa3, (bf16x8){l3[0], l3[1], l3[2], l3[3], h3[0], h3[1], h3[2], h3[3]}, o[d0], 0, 0, 0); } while (0)
    ATT_PV_D0(0); ATT_PV_D0(1); ATT_PV_D0(2); ATT_PV_D0(3);
#undef ATT_PV_D0
#undef ATT_TRRD
}

__device__ __forceinline__ void attn_block(const bf16* Qb, const bf16* Kh, const bf16* Vh, bf16* Ob, int ldo, int P0, char* lds) {
    const int tid = threadIdx.x, wid = __builtin_amdgcn_readfirstlane(tid >> 6), lane = tid & 63, r32 = lane & 31, hi = lane >> 5;
    const int NT = (P0 + 256) / 64;
    const int qlo = P0 + wid * 32, qm = qlo + r32 - 4 * hi;
    char* V_lds = lds + V_OFF; char* K_lds = lds + K_OFF;
    float* wsf = (float*)(lds + WS_OFF) + wid * 64; float* li_l = wsf; float* al_l = wsf + 32;
    float m_reg = -1e30f, l_reg = 0.f; f32x16 o[4] = {};
    bf16x8 qr[12];
#pragma unroll
    for (int d0 = 0; d0 < 12; ++d0) qr[d0] = *reinterpret_cast<const bf16x8*>(Qb + (size_t)(wid * 32 + r32) * DQK + d0 * 16 + hi * 8);
    int kws0, kws1, kws2;
    { const int c0 = tid, c1 = tid + 512, c2 = tid + 1024;
      kws0 = ATT_KSWZ(c0 / 24, (c0 % 24) * 16); kws1 = ATT_KSWZ(c1 / 24, (c1 % 24) * 16); kws2 = ATT_KSWZ(c2 / 24, (c2 % 24) * 16); }
    const int sr = tid >> 4, sc = (tid & 15) * 8, vst0 = v_st(sr, sc), vst1 = v_st(32 + sr, sc);
    const int vb0 = (int)(uintptr_t)V_lds + v_rd_base(lane);
    bf16x8 st_k0, st_k1, st_k2, st_v0, st_v1;
#define ATT_SLOAD(t) do { const bf16* kp_ = Kh + (size_t)(t) * 64 * DQK + tid * 8; const bf16* vp_ = Vh + (size_t)((t) * 64 + sr) * DV + sc; \
        st_k0 = *reinterpret_cast<const bf16x8*>(kp_); st_k1 = *reinterpret_cast<const bf16x8*>(kp_ + 4096); st_k2 = *reinterpret_cast<const bf16x8*>(kp_ + 8192); \
        st_v0 = *reinterpret_cast<const bf16x8*>(vp_); st_v1 = *reinterpret_cast<const bf16x8*>(vp_ + 32 * DV); } while (0)
#define ATT_SWRITE(bf) do { *(bf16x8*)(K_lds + (bf) * SHM_K + kws0) = st_k0; *(bf16x8*)(K_lds + (bf) * SHM_K + kws1) = st_k1; *(bf16x8*)(K_lds + (bf) * SHM_K + kws2) = st_k2; \
        *(bf16x8*)(V_lds + (bf) * SHM_V + vst0) = st_v0; *(bf16x8*)(V_lds + (bf) * SHM_V + vst1) = st_v1; } while (0)
#define ATT_RESC(a) do { if (__any((a) < 1.f)) { if (hi == 0) al_l[r32] = (a); asm volatile("s_waitcnt lgkmcnt(0)" ::: "memory");              \
        _Pragma("unroll") for (int d_ = 0; d_ < 4; ++d_) _Pragma("unroll") for (int r = 0; r < 16; ++r) o[d_][r] *= al_l[crow(r, hi)]; } } while (0)
    ATT_SLOAD(0); ATT_SWRITE(0);
    __syncthreads();
    f32x16 p0, p1; float mn, alpha; bf16x8 pa0, pa1, pa2, pa3;
#define ATT_STEP(BF, t) do { \
        if ((t) + 1 < NT) ATT_SLOAD((t) + 1); \
        ATT_SBAR(); qkt<BF>(p0, p1, K_lds, r32, hi, qr); \
        { const int kb_ = (t) * 64; if (kb_ + 63 > qlo) mask_tile(p0, p1, qm - kb_); } \
        partialSM(p0, p1, m_reg, mn, alpha); ATT_RESC(alpha); \
        finishSM(p0, p1, alpha, l_reg, pa0, pa1, pa2, pa3); ATT_SBAR(); \
        pv_tile<BF>(o, vb0, pa0, pa1, pa2, pa3); \
        if ((t) + 1 < NT) ATT_SWRITE((BF) ^ 1); \
        __syncthreads(); } while (0)
    for (int t = 0; t < NT; t += 2) { ATT_STEP(0, t); ATT_STEP(1, t + 1); }
    if (hi == 0) li_l[r32] = l_reg; asm volatile("s_waitcnt lgkmcnt(0)" ::: "memory");
    float rli[16];
#pragma unroll
    for (int r = 0; r < 16; ++r) rli[r] = __builtin_amdgcn_rcpf(li_l[crow(r, hi)]);
    bf16* Ow = Ob + (size_t)(wid * 32) * ldo;
#pragma unroll
    for (int r = 0; r < 16; ++r) { const int orow = crow(r, hi);
#pragma unroll
        for (int d0 = 0; d0 < 4; ++d0) { const float v = o[d0][r] * rli[r]; const float vn = __shfl_xor(v, 1);
            if ((r32 & 1) == 0) *(unsigned*)(Ow + (size_t)orow * ldo + d0 * 32 + r32) = cvtpk(v, vn); } }
    __syncthreads();
#undef ATT_SLOAD
#undef ATT_SWRITE
#undef ATT_RESC
#undef ATT_STEP
}
}

#ifndef PG8_SP2
#define PG8_SP2 true
#endif
#ifndef PG8_ALIGN
#define PG8_ALIGN true
#endif
#ifndef MK_N_LAUNCHES
#define MK_N_LAUNCHES 1
#endif

constexpr int M = 16384, SEQ = 2048, NB = 8, D = 2048, NH = 8, DQK = 192, DV = 128;
constexpr int QL = 512, KVL = 256, NG = 64, GH = 16, NP = 64, FF = 5632, PLE = 256, SSMW = 1024;
constexpr float EPS = 1e-6f;
constexpr int ZC_Q = 0, ZC_KV = 512, ZC_U = 768, ZC_KR = 1792, ZLD = 2048;
constexpr int NPHASES = 10;

constexpr size_t MiB = 1u << 20;
constexpr size_t WS_CTL = 0, CTL_ZERO_BYTES = 1 * MiB;
constexpr int CW_BAR = 4096;
constexpr size_t SQ_Q = 65536 * 1, SQ_KV = 65536 * 2, SQ_X1 = 65536 * 3, SQ_X2 = 65536 * 4;
constexpr size_t WS_ABAR = 1 * MiB, WS_BBR = 1 * MiB + 65536, WS_BBI = 1 * MiB + 65536 + 262144;
constexpr size_t WS_WIN = 2 * MiB, WS_WUQ = 10 * MiB, WS_WUKV = 12 * MiB, WS_WGLU = 13 * MiB, WS_WO = 15 * MiB, WS_WGU = 23 * MiB, WS_WDN = 67 * MiB, WS_WPG = 89 * MiB, WS_WPP = 97 * MiB;
constexpr size_t WS_HN = 100 * MiB;
constexpr size_t WS_Z = 164 * MiB;
constexpr size_t WS_QRAW = 228 * MiB, WS_KVRAW = 276 * MiB;
constexpr size_t WS_Q = 340 * MiB, WS_K = 388 * MiB, WS_V = 436 * MiB;
constexpr size_t WS_YG = 468 * MiB, WS_PB = 500 * MiB;
constexpr size_t WS_OA = 228 * MiB, WS_OS = 260 * MiB;
constexpr size_t WS_H = 228 * MiB, WS_PP = 404 * MiB, WS_END = 508 * MiB;

constexpr int RING_BYTES = 131072, MISC_OFF = 139264 + 320, LDS_BYTES = 147456;
constexpr int NWAVES = 8;

#define GAS __attribute__((address_space(1)))
#define LAS __attribute__((address_space(3)))
typedef unsigned short bf16;
typedef unsigned v4u __attribute__((ext_vector_type(4)));
typedef unsigned v2u __attribute__((ext_vector_type(2)));
typedef float f32x4 __attribute__((ext_vector_type(4)));
typedef GAS unsigned gu32;
#define LDS_WAIT() asm volatile("s_waitcnt lgkmcnt(0)" ::: "memory")
__device__ __forceinline__ unsigned f2bf(float f) { unsigned u = __builtin_bit_cast(unsigned, f); return (u + 0x7fffu + ((u >> 16) & 1u)) >> 16; }
__device__ __forceinline__ unsigned pk2(float lo, float hi) { return f2bf(lo) | (f2bf(hi) << 16); }
__device__ __forceinline__ float bf2f(unsigned h) { return __builtin_bit_cast(float, h << 16); }
__device__ __forceinline__ float bflo(unsigned w) { return __builtin_bit_cast(float, w << 16); }
__device__ __forceinline__ float bfhi(unsigned w) { return __builtin_bit_cast(float, w & 0xffff0000u); }
__device__ __forceinline__ float wave_sum(float v) {
#pragma unroll
    for (int o = 1; o < 64; o <<= 1) v += __shfl_xor(v, o);
    return v;
}
__device__ __forceinline__ float wave_max(float v) {
#pragma unroll
    for (int o = 1; o < 64; o <<= 1) v = fmaxf(v, __shfl_xor(v, o));
    return v;
}
__device__ __forceinline__ float sigmoid_f(float v) { return __builtin_amdgcn_rcpf(1.0f + __builtin_amdgcn_exp2f(-1.4426950408889634f * v)); }
__device__ __forceinline__ float gelu_tanh(float v) {
    const float z = 0.7978845608028654f * (v + 0.044715f * v * v * v);
    const float e = __builtin_amdgcn_exp2f(2.0f * 1.4426950408889634f * z);
    const float th = 1.0f - 2.0f * __builtin_amdgcn_rcpf(e + 1.0f);
    return 0.5f * v * (1.0f + th);
}

#define XB_TMO      128
#define XB_XCNT(j)  (256  + 64 * (j))
#define XB_XSUB(j)  (1280 + 64 * (j))
#define XB_XGEN(j)  (2304 + 64 * (j))
#define XB_TOP      3328
#define XB_TOPGEN   3392
#define XCD_BAR_WORDS 3456
#define XB_SPIN_CAP (1u << 18)
__device__ __forceinline__ unsigned xb_ld(unsigned* p)              { return __hip_atomic_load(p, __ATOMIC_RELAXED, __HIP_MEMORY_SCOPE_AGENT); }
__device__ __forceinline__ unsigned xb_add(unsigned* p, unsigned v) { return __hip_atomic_fetch_add(p, v, __ATOMIC_RELAXED, __HIP_MEMORY_SCOPE_AGENT); }
__device__ __forceinline__ unsigned xb_xcc_id() { return (unsigned)__builtin_amdgcn_s_getreg((3 << 11) | 20) & 0xFu; }
#define XB_SPIN(cond, bar) do { unsigned _sp = 0; while (cond) { __builtin_amdgcn_s_sleep(1); \
    if ((++_sp & 255u) == 0u) { if (xb_ld(&(bar)[XB_TMO])) break; if (_sp > XB_SPIN_CAP) { atomicAdd(&(bar)[XB_TMO], 1u); break; } } } } while (0)
struct XcdBarrier { unsigned* bar; unsigned x; volatile LAS unsigned* st; };
__device__ __forceinline__ XcdBarrier xcd_barrier_post(unsigned* bar, volatile LAS unsigned* st) {
    XcdBarrier b; b.bar = bar; b.x = xb_xcc_id(); b.st = st;
    if (threadIdx.x == 0) (void)xb_add(&bar[XB_XCNT(b.x)], 1u);
    return b;
}
__device__ __forceinline__ void xcd_barrier_complete(unsigned* bar, unsigned x, unsigned& nloc, unsigned& nx) {
    const unsigned G = gridDim.x * gridDim.y * gridDim.z;
    unsigned sum, cnt, mine, sp = 0u;
    for (;;) {
        sum = 0u; cnt = 0u; mine = 0u;
#pragma unroll
        for (unsigned j = 0; j < 16; ++j) { const unsigned c = xb_ld(&bar[XB_XCNT(j)]); sum += c; cnt += (c > 0u) ? 1u : 0u; mine = (j == x) ? c : mine; }
        if (sum == G) break;
        __builtin_amdgcn_s_sleep(1);
        if ((++sp & 255u) == 0u) { if (xb_ld(&bar[XB_TMO])) break; if (sp > XB_SPIN_CAP) { atomicAdd(&bar[XB_TMO], 1u); break; } }
    }
    nloc = mine > 0u ? mine : 1u; nx = cnt > 0u ? cnt : 1u;
}
__device__ __forceinline__ void xcd_barrier(const XcdBarrier& b) {
    asm volatile("s_waitcnt vmcnt(0)" ::: "memory");
    __syncthreads();
    if (threadIdx.x == 0) {
        unsigned* bar = b.bar;
        __builtin_amdgcn_s_waitcnt(0);
        unsigned nloc = b.st[0], nx = b.st[1];
        if (nloc == 0u) { xcd_barrier_complete(bar, b.x, nloc, nx); b.st[0] = nloc; b.st[1] = nx; }
        const unsigned old = xb_add(&bar[XB_XSUB(b.x)], 1u);
        const unsigned gen = old / nloc;
        if (old + 1u == (gen + 1u) * nloc) {
            __builtin_amdgcn_fence(__ATOMIC_RELEASE, "agent");
            asm volatile("s_waitcnt vmcnt(0)" ::: "memory");
            const unsigned og = xb_add(&bar[XB_TOP], 1u);
            const unsigned tg = og / nx;
            if (og + 1u == (tg + 1u) * nx) xb_add(&bar[XB_TOPGEN], 1u);
            else XB_SPIN(xb_ld(&bar[XB_TOPGEN]) == tg, bar);
            __builtin_amdgcn_fence(__ATOMIC_ACQUIRE, "agent");
            xb_add(&bar[XB_XGEN(b.x)], 1u);
            asm volatile("s_waitcnt vmcnt(0)" ::: "memory");
        } else {
            XB_SPIN(xb_ld(&bar[XB_XGEN(b.x)]) == gen, bar);
            __builtin_amdgcn_fence(__ATOMIC_ACQUIRE, "agent");
            asm volatile("s_waitcnt vmcnt(0)" ::: "memory");
        }
    }
    __syncthreads();
}

using pg8::Unit; using pg8::cvt_pk_bf16;
#define EPI_LOOP_AM _Pragma("unroll") for (int ai = 0; ai < 2; ++ai) _Pragma("unroll") for (int m = 0; m < 4; ++m)
__device__ __forceinline__ float sq8(const f32x4& a, const f32x4& b) { return (a[0] * a[0] + a[1] * a[1]) + (a[2] * a[2] + a[3] * a[3]) + (b[0] * b[0] + b[1] * b[1]) + (b[2] * b[2] + b[3] * b[3]); }
__device__ __forceinline__ v4u pack8(const f32x4& a, const f32x4& b) { v4u w; w.x = cvt_pk_bf16(a[0], a[1]); w.y = cvt_pk_bf16(a[2], a[3]); w.z = cvt_pk_bf16(b[0], b[1]); w.w = cvt_pk_bf16(b[2], b[3]); return w; }

struct EpiZ {
    static constexpr bool PERM = true, AFTER_DRAIN = false;
    bf16* Z; float* sqq; float* sqkv;
    __device__ __forceinline__ void operator()(const f32x4 (&acc)[2][2][4][2], const Unit& u, int wr, int wc, int fr, int fq) const {
        const int row0 = u.pm * 256 + wr * 64 + fr, col0 = u.pn * 256 + wc * 32 + 8 * fq;
        float* sq = u.pn < 2 ? sqq : (u.pn == 2 ? sqkv : nullptr);
        EPI_LOOP_AM { const int row = row0 + ai * 128 + m * 16; bf16* rowp = Z + (size_t)row * ZLD + col0; float s = 0.f;
#pragma unroll
            for (int bj = 0; bj < 2; ++bj) { *(v4u*)(rowp + bj * 128) = pack8(acc[ai][bj][m][0], acc[ai][bj][m][1]); s += sq8(acc[ai][bj][m][0], acc[ai][bj][m][1]); }
            if (sq) { s += __shfl_xor(s, 16); s += __shfl_xor(s, 32); if (fq == 0) atomicAdd(sq + row, s); } }
    }
};
struct EpiScale {
    static constexpr bool PERM = true, AFTER_DRAIN = false;
    bf16* O; int ldc; const float* sq; float invk;
    __device__ __forceinline__ void operator()(const f32x4 (&acc)[2][2][4][2], const Unit& u, int wr, int wc, int fr, int fq) const {
        const int row0 = u.pm * 256 + wr * 64 + fr, col0 = u.pn * 256 + wc * 32 + 8 * fq;
        EPI_LOOP_AM { const int row = row0 + ai * 128 + m * 16; bf16* rowp = O + (size_t)row * ldc + col0; const float rs = __builtin_amdgcn_rsqf(sq[row] * invk + EPS);
#pragma unroll
            for (int bj = 0; bj < 2; ++bj) *(v4u*)(rowp + bj * 128) = pack8(acc[ai][bj][m][0] * rs, acc[ai][bj][m][1] * rs); }
    }
};
struct EpiPlain {
    static constexpr bool PERM = true, AFTER_DRAIN = false;
    bf16* O; int ldc;
    __device__ __forceinline__ void operator()(const f32x4 (&acc)[2][2][4][2], const Unit& u, int wr, int wc, int fr, int fq) const {
        const int row0 = u.pm * 256 + wr * 64 + fr, col0 = u.pn * 256 + wc * 32 + 8 * fq;
        EPI_LOOP_AM { bf16* rowp = O + (size_t)(row0 + ai * 128 + m * 16) * ldc + col0;
#pragma unroll
            for (int bj = 0; bj < 2; ++bj) *(v4u*)(rowp + bj * 128) = pack8(acc[ai][bj][m][0], acc[ai][bj][m][1]); }
    }
};
__device__ __forceinline__ void unpack8(const v4u w, float (&f)[8]) { f[0] = bflo(w.x); f[1] = bfhi(w.x); f[2] = bflo(w.y); f[3] = bfhi(w.y); f[4] = bflo(w.z); f[5] = bfhi(w.z); f[6] = bflo(w.w); f[7] = bfhi(w.w); }
struct EpiGlu {
    static constexpr bool PERM = true, AFTER_DRAIN = false;
    const bf16* YG; const float* bias; bf16* O;
    __device__ __forceinline__ void operator()(const f32x4 (&acc)[2][2][4][2], const Unit& u, int wr, int wc, int fr, int fq) const {
        const int row0 = u.pm * 256 + wr * 64 + fr, col0 = u.pn * 256 + wc * 32 + 8 * fq;
        f32x4 bv[2][2];
#pragma unroll
        for (int bj = 0; bj < 2; ++bj) { bv[bj][0] = *(const f32x4*)(bias + col0 + bj * 128); bv[bj][1] = *(const f32x4*)(bias + col0 + bj * 128 + 4); }
        EPI_LOOP_AM { const size_t off = (size_t)(row0 + ai * 128 + m * 16) * SSMW + col0;
#pragma unroll
            for (int bj = 0; bj < 2; ++bj) { float y[8]; unpack8(*(const v4u*)(YG + off + bj * 128), y);
                f32x4 a = acc[ai][bj][m][0] + bv[bj][0], b = acc[ai][bj][m][1] + bv[bj][1];
#pragma unroll
                for (int j = 0; j < 4; ++j) { a[j] = y[j] * sigmoid_f(a[j]); b[j] = y[4 + j] * sigmoid_f(b[j]); }
                *(v4u*)(O + off + bj * 128) = pack8(a, b); } }
    }
};
struct EpiResid {
    static constexpr bool PERM = true, AFTER_DRAIN = false;
    const float* xin; float* xout; bf16* xb; float* sq;
    __device__ __forceinline__ void operator()(const f32x4 (&acc)[2][2][4][2], const Unit& u, int wr, int wc, int fr, int fq) const {
        const int row0 = u.pm * 256 + wr * 64 + fr, col0 = u.pn * 256 + wc * 32 + 8 * fq;
        EPI_LOOP_AM { const int row = row0 + ai * 128 + m * 16; const size_t off = (size_t)row * D + col0; float s = 0.f;
#pragma unroll
            for (int bj = 0; bj < 2; ++bj) { const f32x4 a = *(const f32x4*)(xin + off + bj * 128) + acc[ai][bj][m][0], b = *(const f32x4*)(xin + off + bj * 128 + 4) + acc[ai][bj][m][1];
                *(f32x4*)(xout + off + bj * 128) = a; *(f32x4*)(xout + off + bj * 128 + 4) = b; *(v4u*)(xb + off + bj * 128) = pack8(a, b); s += sq8(a, b); }
            s += __shfl_xor(s, 16); s += __shfl_xor(s, 32); if (fq == 0) atomicAdd(sq + row, s); }
    }
};
struct EpiGateUp {
    static constexpr bool PERM = true, AFTER_DRAIN = false;
    bf16* H; const float* sq;
    __device__ __forceinline__ void operator()(const f32x4 (&acc)[2][2][4][2], const Unit& u, int wr, int wc, int fr, int fq) const {
        const int row0 = u.pm * 256 + wr * 64 + fr, col0 = u.pn * 128 + wc * 32 + 8 * fq;
        EPI_LOOP_AM { const int row = row0 + ai * 128 + m * 16; const float rs = __builtin_amdgcn_rsqf(sq[row] * (1.0f / D) + EPS);
            f32x4 a, b;
#pragma unroll
            for (int j = 0; j < 4; ++j) { const float g0 = acc[ai][0][m][0][j] * rs, u0 = acc[ai][1][m][0][j] * rs, g1 = acc[ai][0][m][1][j] * rs, u1 = acc[ai][1][m][1][j] * rs;
                a[j] = g0 * sigmoid_f(g0) * u0; b[j] = g1 * sigmoid_f(g1) * u1; }
            *(v4u*)(H + (size_t)row * FF + col0) = pack8(a, b); }
    }
};
struct EpiPle {
    static constexpr bool PERM = true, AFTER_DRAIN = false;
    float* xio; const bf16* PP; const float* sq;
    __device__ __forceinline__ void operator()(const f32x4 (&acc)[2][2][4][2], const Unit& u, int wr, int wc, int fr, int fq) const {
        const int row0 = u.pm * 256 + wr * 64 + fr, col0 = u.pn * 256 + wc * 32 + 8 * fq;
        EPI_LOOP_AM { const int row = row0 + ai * 128 + m * 16; const size_t off = (size_t)row * D + col0; const float rs = __builtin_amdgcn_rsqf(sq[row] * (1.0f / D) + EPS);
#pragma unroll
            for (int bj = 0; bj < 2; ++bj) { float pp[8]; unpack8(*(const v4u*)(PP + off + bj * 128), pp);
                f32x4 a = *(const f32x4*)(xio + off + bj * 128), b = *(const f32x4*)(xio + off + bj * 128 + 4);
#pragma unroll
                for (int j = 0; j < 4; ++j) { a[j] += sigmoid_f(acc[ai][bj][m][0][j] * rs) * pp[j]; b[j] += sigmoid_f(acc[ai][bj][m][1][j] * rs) * pp[4 + j]; }
                *(f32x4*)(xio + off + bj * 128) = a; *(f32x4*)(xio + off + bj * 128 + 4) = b; } }
    }
};

__device__ __forceinline__ int dest_row(int mode, int n) {
    if (mode == 0) return n;
    if (mode == 1) return n < 768 ? n : (n < 832 ? n + 1024 : n - 64);
    if (mode == 2) return 256 * (n >> 7) + (n & 127);
    return 256 * (n >> 7) + 128 + (n & 127);
}
__device__ __forceinline__ void transpose_item(const float* W, int Nsrc, bf16* WT, int ldwt, const float* gain, int mode, LAS float* scr, int item, int lane) {
    const int nblk = Nsrc / 32, kb = item / nblk, nb = item % nblk, k0 = 64 * kb, n0 = 32 * nb;
#pragma unroll 8
    for (int i = 0; i < 32; ++i) { const int kk = 2 * i + (lane >> 5); float v = W[(size_t)(k0 + kk) * Nsrc + n0 + (lane & 31)]; if (gain) v *= gain[k0 + kk]; scr[kk * 33 + (lane & 31)] = v; }
    LDS_WAIT(); asm volatile("" ::: "memory");
    const int c = lane & 7; const int r0 = dest_row(mode, n0);
#pragma unroll
    for (int j = 0; j < 4; ++j) { const int n = (lane >> 3) + 8 * j; const LAS float* s = scr + (8 * c) * 33 + n;
        v4u o; o.x = pk2(s[0 * 33], s[1 * 33]); o.y = pk2(s[2 * 33], s[3 * 33]); o.z = pk2(s[4 * 33], s[5 * 33]); o.w = pk2(s[6 * 33], s[7 * 33]);
        *(GAS v4u*)(WT + (size_t)(r0 + n) * ldwt + k0 + 8 * c) = o; }
    LDS_WAIT(); asm volatile("" ::: "memory");
}
struct Args { const void* in[31]; float* out; unsigned char* ws; int ph_lo, ph_hi; };
#define INF(i) ((const float*)args.in[i])

__device__ __forceinline__ void phase_prologue(const Args& args, LAS unsigned char* lds, int gw, int NGW, int wave, int lane) {
    unsigned char* ws = args.ws;
    LAS float* scr = (LAS float*)(lds + wave * 16384);
    constexpr int I0 = 32 * 58, I1 = 8 * 48, I2 = 4 * 64, I3 = 16 * 32, I4 = 16 * 64, I5 = 16 * 64, I6 = 32 * 176, I7 = 32 * 176, I8 = 88 * 64, I9 = 32 * 64, I10 = 4 * 64;
    constexpr int NITEMS = I0 + I1 + I2 + I3 + I4 + I5 + I6 + I7 + I8 + I9 + I10;
    for (int it = gw; it < NITEMS; it += NGW) {
        int r = it;
        if (r < I0) { transpose_item(INF(4), 1856, (bf16*)(ws + WS_WIN), 2048, INF(3), 1, scr, r, lane); continue; } r -= I0;
        if (r < I1) { transpose_item(INF(6), 1536, (bf16*)(ws + WS_WUQ), 512, INF(5), 0, scr, r, lane); continue; } r -= I1;
        if (r < I2) { transpose_item(INF(8), 2048, (bf16*)(ws + WS_WUKV), 256, INF(7), 0, scr, r, lane); continue; } r -= I2;
        if (r < I3) { transpose_item(INF(19), 1024, (bf16*)(ws + WS_WGLU), 1024, nullptr, 0, scr, r, lane); continue; } r -= I3;
        if (r < I4) { transpose_item(INF(23), 2048, (bf16*)(ws + WS_WO), 2048, INF(21), 0, scr, r, lane); continue; } r -= I4;
        if (r < I5) { transpose_item(INF(23) + (size_t)1024 * 2048, 2048, (bf16*)(ws + WS_WO) + 1024, 2048, INF(22), 0, scr, r, lane); continue; } r -= I5;
        if (r < I6) { transpose_item(INF(25), FF, (bf16*)(ws + WS_WGU), 2048, INF(24), 2, scr, r, lane); continue; } r -= I6;
        if (r < I7) { transpose_item(INF(26), FF, (bf16*)(ws + WS_WGU), 2048, INF(24), 3, scr, r, lane); continue; } r -= I7;
        if (r < I8) { transpose_item(INF(27), 2048, (bf16*)(ws + WS_WDN), FF, nullptr, 0, scr, r, lane); continue; } r -= I8;
        if (r < I9) { transpose_item(INF(29), 2048, (bf16*)(ws + WS_WPG), 2048, INF(28), 0, scr, r, lane); continue; } r -= I9;
        transpose_item(INF(30), 2048, (bf16*)(ws + WS_WPP), 256, nullptr, 0, scr, r, lane);
    }
    { GAS v4u* z = (GAS v4u*)(ws + WS_WIN + (size_t)1856 * 2048 * 2); const int n16 = 192 * 2048 * 2 / 16;
      for (int i = gw * 64 + lane; i < n16; i += NGW * 64) z[i] = (v4u){0u, 0u, 0u, 0u}; }
    for (int r = gw; r < M; r += NGW) {
        const GAS f32x4* xr = (const GAS f32x4*)(INF(0) + (size_t)r * D) + lane;
        f32x4 v[8]; float s = 0.f;
#pragma unroll
        for (int j = 0; j < 8; ++j) { v[j] = xr[64 * j]; s += (v[j][0] * v[j][0] + v[j][1] * v[j][1]) + (v[j][2] * v[j][2] + v[j][3] * v[j][3]); }
        const float rs = 1.0f / sqrtf(wave_sum(s) * (1.0f / D) + EPS);
        GAS v2u* o = (GAS v2u*)((bf16*)(ws + WS_HN) + (size_t)r * D) + lane;
#pragma unroll
        for (int j = 0; j < 8; ++j) { v2u w; w.x = pk2(v[j][0] * rs, v[j][1] * rs); w.y = pk2(v[j][2] * rs, v[j][3] * rs); o[64 * j] = w; }
    }
    { const GAS f32x4* p4 = (const GAS f32x4*)INF(1); GAS v2u* o = (GAS v2u*)(ws + WS_PB); const int n4 = M * PLE / 4;
      for (int i = gw * 64 + lane; i < n4; i += NGW * 64) { const f32x4 v = p4[i]; v2u w; w.x = pk2(v[0], v[1]); w.y = pk2(v[2], v[3]); o[i] = w; } }
    for (int i = gw * 64 + lane; i < NG * NP; i += NGW * 64) {
        const int g = i / NP;
        const double lr = fmin((double)INF(11)[i], -1e-4), li = (double)INF(12)[i], dt = exp((double)INF(13)[g]);
        const double mag = exp(lr * dt), are = mag * cos(li * dt), aim = mag * sin(li * dt), den = lr * lr + li * li;
        const double nre = are - 1.0, nim = aim, cre = (nre * lr + nim * li) / den, cim = (nim * lr - nre * li) / den;
        float* ab = (float*)(ws + WS_ABAR); ab[2 * i] = (float)are; ab[2 * i + 1] = (float)aim;
        float* bbr = (float*)(ws + WS_BBR) + (size_t)i * GH; float* bbi = (float*)(ws + WS_BBI) + (size_t)i * GH;
        for (int h = 0; h < GH; ++h) { const double br = INF(14)[(size_t)i * GH + h], bi = INF(15)[(size_t)i * GH + h]; bbr[h] = (float)(cre * br - cim * bi); bbi[h] = (float)(cre * bi + cim * br); }
    }
}

__device__ __forceinline__ void phase_s5_naive(const Args& args, LAS unsigned char* lds, int gw, int NGW, int wave, int lane) {
    unsigned char* ws = args.ws;
    LAS float* SR = (LAS float*)(lds + wave * 16384); LAS float* SI = SR + 32 * 64;
    const bf16* Z = (const bf16*)(ws + WS_Z); bf16* YG = (bf16*)(ws + WS_YG);
    for (int unit = gw; unit < NB * NG; unit += NGW) {
        const int b = unit / NG, g = unit % NG, p = lane;
        const float are = ((const float*)(ws + WS_ABAR))[2 * (g * NP + p)], aim = ((const float*)(ws + WS_ABAR))[2 * (g * NP + p) + 1];
        float bbr[GH], bbi[GH];
#pragma unroll
        for (int h = 0; h < GH; ++h) { bbr[h] = ((const float*)(ws + WS_BBR))[(size_t)(g * NP + p) * GH + h]; bbi[h] = ((const float*)(ws + WS_BBI))[(size_t)(g * NP + p) * GH + h]; }
        const int hB = lane & 15, pq = lane >> 4;
        float cr[16], ci[16];
#pragma unroll
        for (int i = 0; i < 16; ++i) { cr[i] = INF(16)[(size_t)(g * GH + hB) * NP + 16 * pq + i]; ci[i] = INF(17)[(size_t)(g * GH + hB) * NP + 16 * pq + i]; }
        const float dsk = INF(18)[g * GH + hB];
        float sre = 0.f, sim = 0.f;
        for (int t0 = 0; t0 < SEQ; t0 += 32) {
            for (int tt = 0; tt < 32; ++tt) {
                const bf16* up = Z + (size_t)(b * SEQ + t0 + tt) * ZLD + ZC_U + GH * g;
                float uf[16]; { float a8[8], b8[8]; unpack8(*(const v4u*)up, a8); unpack8(*(const v4u*)(up + 8), b8);
#pragma unroll
                    for (int h = 0; h < 8; ++h) { uf[h] = a8[h]; uf[8 + h] = b8[h]; } }
                float bur = 0.f, bui = 0.f;
#pragma unroll
                for (int h = 0; h < GH; ++h) { bur = fmaf(bbr[h], uf[h], bur); bui = fmaf(bbi[h], uf[h], bui); }
                const float nr = are * sre - aim * sim + bur, ni = are * sim + aim * sre + bui; sre = nr; sim = ni;
                SR[tt * 64 + p] = sre; SI[tt * 64 + p] = sim;
            }
            LDS_WAIT(); asm volatile("" ::: "memory");
            for (int tt = 0; tt < 32; ++tt) {
                float a = 0.f;
#pragma unroll
                for (int i = 0; i < 16; ++i) { a = fmaf(SR[tt * 64 + 16 * pq + i], cr[i], a); a = fmaf(-SI[tt * 64 + 16 * pq + i], ci[i], a); }
                a += __shfl_xor(a, 16); a += __shfl_xor(a, 32);
                if (pq == 0) { const size_t tok = (size_t)(b * SEQ + t0 + tt); const float uh = bf2f(Z[tok * ZLD + ZC_U + GH * g + hB]);
                    YG[tok * SSMW + GH * g + hB] = (bf16)f2bf(gelu_tanh(a + dsk * uh)); }
            }
            LDS_WAIT(); asm volatile("" ::: "memory");
        }
    }
}

__device__ __forceinline__ void phase_qkv_finalize(const Args& args, int gw, int NGW, int lane) {
    unsigned char* ws = args.ws;
    const bf16* QRAW = (const bf16*)(ws + WS_QRAW); const bf16* KVRAW = (const bf16*)(ws + WS_KVRAW); const bf16* Z = (const bf16*)(ws + WS_Z);
    bf16* Q = (bf16*)(ws + WS_Q); bf16* K = (bf16*)(ws + WS_K); bf16* V = (bf16*)(ws + WS_V);
    const float* gq = INF(9); const float* gk = INF(10); const int* pos = (const int*)args.in[2];
    const float gq0 = gq[lane], gq1 = gq[64 + lane], gq2 = gq[128 + lane], gk0 = gk[lane], gk1 = gk[64 + lane], gk2 = gk[128 + lane];
    const float invf = exp2f(-(float)(lane & 31) * (13.287712379549449f / 32.0f));
    for (int task = gw; task < M * NH; task += NGW) {
        const int tok = task >> 3, h = task & 7, b = tok / SEQ, t = tok % SEQ;
        const float ang = (float)pos[tok] * invf; float sn, cs; sincosf(ang, &sn, &cs);
        const size_t orow = (size_t)((b * NH + h) * SEQ + t);
        { const bf16* qp = QRAW + (size_t)tok * 1536 + h * DQK;
          float v0 = bf2f(qp[lane]), v1 = bf2f(qp[64 + lane]), v2 = bf2f(qp[128 + lane]);
          const float rs = 1.0f / sqrtf(wave_sum(v0 * v0 + v1 * v1 + v2 * v2) * (1.0f / DQK) + EPS);
          v0 *= rs * gq0; v1 *= rs * gq1; v2 *= rs * gq2;
          const float pr = __shfl_xor(v2, 32); const float r2 = lane < 32 ? v2 * cs - pr * sn : v2 * cs + pr * sn;
          bf16* o = Q + orow * DQK; o[lane] = (bf16)f2bf(v0); o[64 + lane] = (bf16)f2bf(v1); o[128 + lane] = (bf16)f2bf(r2); }
        { const bf16* kp = KVRAW + (size_t)tok * 2048 + h * 256;
          float v0 = bf2f(kp[lane]), v1 = bf2f(kp[64 + lane]), v2 = bf2f(Z[(size_t)tok * ZLD + ZC_KR + lane]);
          const float rs = 1.0f / sqrtf(wave_sum(v0 * v0 + v1 * v1 + v2 * v2) * (1.0f / DQK) + EPS);
          v0 *= rs * gk0; v1 *= rs * gk1; v2 *= rs * gk2;
          const float pr = __shfl_xor(v2, 32); const float r2 = lane < 32 ? v2 * cs - pr * sn : v2 * cs + pr * sn;
          bf16* o = K + orow * DQK; o[lane] = (bf16)f2bf(v0); o[64 + lane] = (bf16)f2bf(v1); o[128 + lane] = (bf16)f2bf(r2);
          bf16* vo = V + orow * DV; vo[lane] = kp[128 + lane]; vo[64 + lane] = kp[192 + lane]; }
    }
}

__device__ __forceinline__ void phase_attn(const Args& args, char* lds) {
    unsigned char* ws = args.ws;
    const bf16* Q = (const bf16*)(ws + WS_Q); const bf16* K = (const bf16*)(ws + WS_K); const bf16* V = (const bf16*)(ws + WS_V); bf16* OA = (bf16*)(ws + WS_OA);
    for (int L = blockIdx.x; L < NB * NH * 4; L += gridDim.x) {
        const int bh = (L & 7) + 8 * (L >> 5), y = (L >> 3) & 3, b = bh / NH, h = bh % NH;
        for (int pass = 0; pass < 2; ++pass) { const int qb = pass ? 7 - y : y;
            att::attn_block(Q + ((size_t)bh * SEQ + qb * 256) * DQK, K + (size_t)bh * SEQ * DQK, V + (size_t)bh * SEQ * DV,
                            OA + ((size_t)(b * SEQ + qb * 256)) * 1024 + h * DV, 1024, qb * 256, lds); }
    }
}

__device__ __forceinline__ void phase_mix_norm(const Args& args, int gw, int NGW, int lane) {
    unsigned char* ws = args.ws;
    for (int r = gw; r < M; r += NGW) {
#pragma unroll
        for (int part = 0; part < 2; ++part) {
            const bf16* src = (const bf16*)(ws + (part ? WS_OS : WS_OA)) + (size_t)r * 1024 + lane * 8;
            float a[8], c[8]; unpack8(*(const v4u*)src, a); unpack8(*(const v4u*)(src + 512), c);
            float s = 0.f;
#pragma unroll
            for (int j = 0; j < 8; ++j) s += a[j] * a[j] + c[j] * c[j];
            const float rs = 1.0f / sqrtf(wave_sum(s) * (1.0f / 1024.0f) + EPS);
            bf16* dst = (bf16*)(ws + WS_Z) + (size_t)r * 2048 + part * 1024 + lane * 8;
            v4u w0, w1; w0.x = pk2(a[0] * rs, a[1] * rs); w0.y = pk2(a[2] * rs, a[3] * rs); w0.z = pk2(a[4] * rs, a[5] * rs); w0.w = pk2(a[6] * rs, a[7] * rs);
            w1.x = pk2(c[0] * rs, c[1] * rs); w1.y = pk2(c[2] * rs, c[3] * rs); w1.z = pk2(c[4] * rs, c[5] * rs); w1.w = pk2(c[6] * rs, c[7] * rs);
            *(v4u*)dst = w0; *(v4u*)(dst + 512) = w1;
        }
    }
}

template <class Epi> __device__ __forceinline__ void run_gemm(LAS unsigned char* lds, const bf16* A, int lda, const bf16* Bt, int ldb, int N, int K, const Epi& E) {
    pg8::Gemm g{A, Bt, M, N, K, lda, ldb}; pg8::StaticOrder S; S.init(M, N, (int)gridDim.x, (int)blockIdx.x);
    pg8::gemm_phase<Epi, pg8::StaticOrder, PG8_ALIGN, PG8_SP2>(lds, g, S, E);
}

__global__ void __launch_bounds__(NWAVES * 64, 2) mega_fwd(Args args) {
    extern __shared__ __attribute__((aligned(16))) unsigned char lds_raw[];
    LAS unsigned char* lds = (LAS unsigned char*)lds_raw;
    volatile LAS unsigned* MISC = (volatile LAS unsigned*)(lds + MISC_OFF);
    const int tid = threadIdx.x, lane = tid & 63, wave = __builtin_amdgcn_readfirstlane(tid >> 6);
    const int G = gridDim.x; const int bx = blockIdx.x; const int vcu = (G % 8 == 0) ? (bx % 8) * (G / 8) + bx / 8 : bx;
    const int gw = vcu * NWAVES + wave, NGW = G * NWAVES;
    unsigned char* ws = args.ws;
    for (int u = tid; u < (LDS_BYTES - 139264) / 4; u += NWAVES * 64) ((LAS unsigned*)(lds + 139264))[u] = 0u;
    __syncthreads();
    const int lo = args.ph_lo, hi = args.ph_hi;
    XcdBarrier bar; bar.bar = (unsigned*)(ws + WS_CTL) + CW_BAR; bar.x = 0; bar.st = nullptr;
    if (hi - lo > 1) bar = xcd_barrier_post((unsigned*)(ws + WS_CTL) + CW_BAR, MISC + 8);
#define IN(k) (lo <= (k) && (k) < hi)
#define SEAM(k) do { if (IN(k) && IN((k) + 1)) xcd_barrier(bar); } while (0)
    float* sqq = (float*)(ws + SQ_Q); float* sqkv = (float*)(ws + SQ_KV); float* sqx1 = (float*)(ws + SQ_X1); float* sqx2 = (float*)(ws + SQ_X2);

    if (IN(0)) { phase_prologue(args, lds, gw, NGW, wave, lane); __syncthreads(); }
    SEAM(0);
    if (IN(1)) { EpiZ E{(bf16*)(ws + WS_Z), sqq, sqkv}; run_gemm(lds, (const bf16*)(ws + WS_HN), D, (const bf16*)(ws + WS_WIN), D, 2048, D, E); }
    SEAM(1);
    if (IN(2)) {
        { EpiScale E{(bf16*)(ws + WS_QRAW), 1536, sqq, 1.0f / QL}; run_gemm(lds, (const bf16*)(ws + WS_Z) + ZC_Q, ZLD, (const bf16*)(ws + WS_WUQ), QL, 1536, QL, E); }
        { EpiScale E{(bf16*)(ws + WS_KVRAW), 2048, sqkv, 1.0f / KVL}; run_gemm(lds, (const bf16*)(ws + WS_Z) + ZC_KV, ZLD, (const bf16*)(ws + WS_WUKV), KVL, 2048, KVL, E); }
    }
    SEAM(2);
    if (IN(3)) { phase_qkv_finalize(args, gw, NGW, lane); phase_s5_naive(args, lds, gw, NGW, wave, lane); __syncthreads(); }
    SEAM(3);
    if (IN(4)) {
        phase_attn(args, (char*)lds_raw); __syncthreads();
        { EpiGlu E{(const bf16*)(ws + WS_YG), INF(20), (bf16*)(ws + WS_OS)}; run_gemm(lds, (const bf16*)(ws + WS_YG), SSMW, (const bf16*)(ws + WS_WGLU), SSMW, SSMW, SSMW, E); }
    }
    SEAM(4);
    if (IN(5)) { phase_mix_norm(args, gw, NGW, lane); }
    SEAM(5);
    if (IN(6)) { EpiResid E{INF(0), args.out, (bf16*)(ws + WS_HN), sqx1}; run_gemm(lds, (const bf16*)(ws + WS_Z), D, (const bf16*)(ws + WS_WO), D, D, D, E); }
    SEAM(6);
    if (IN(7)) {
        { EpiGateUp E{(bf16*)(ws + WS_H), sqx1}; run_gemm(lds, (const bf16*)(ws + WS_HN), D, (const bf16*)(ws + WS_WGU), D, 2 * FF, D, E); }
        { EpiPlain E{(bf16*)(ws + WS_PP), D}; run_gemm(lds, (const bf16*)(ws + WS_PB), PLE, (const bf16*)(ws + WS_WPP), PLE, D, PLE, E); }
    }
    SEAM(7);
    if (IN(8)) { EpiResid E{args.out, args.out, (bf16*)(ws + WS_HN), sqx2}; run_gemm(lds, (const bf16*)(ws + WS_H), FF, (const bf16*)(ws + WS_WDN), FF, D, FF, E); }
    SEAM(8);
    if (IN(9)) { EpiPle E{args.out, (const bf16*)(ws + WS_PP), sqx2}; run_gemm(lds, (const bf16*)(ws + WS_HN), D, (const bf16*)(ws + WS_WPG), D, D, D, E); }
#undef IN
#undef SEAM
}

extern "C" void kernel_launch(void* const* d_in, const int* in_sizes, int n_in, void* d_out, int out_size, void* d_ws, size_t ws_size, hipStream_t stream) {
    static int grid = 0;
    if (grid == 0) {
        if (n_in != 31 || out_size != M * D || ws_size < WS_END) { fprintf(stderr, "kernel_launch: unexpected shapes (n_in %d, out %d, ws %zu)\n", n_in, out_size, ws_size); grid = -1; return; }
        int dev = 0, cus = 0;
        if (hipGetDevice(&dev) != hipSuccess || hipDeviceGetAttribute(&cus, hipDeviceAttributeMultiprocessorCount, dev) != hipSuccess) { grid = -1; return; }
        if (hipFuncSetAttribute((const void*)mega_fwd, hipFuncAttributeMaxDynamicSharedMemorySize, LDS_BYTES) != hipSuccess) { fprintf(stderr, "kernel_launch: hipFuncSetAttribute failed\n"); grid = -1; return; }
        int per_cu = 0;
        if (hipOccupancyMaxActiveBlocksPerMultiprocessor(&per_cu, (const void*)mega_fwd, NWAVES * 64, LDS_BYTES) != hipSuccess || per_cu < 1) fprintf(stderr, "kernel_launch: occupancy query says %d blocks/CU\n", per_cu);
        (void)hipGetLastError();
        grid = cus > 0 ? cus : 256;
    }
    if (grid < 0) return;
    (void)hipMemsetAsync((char*)d_ws + WS_CTL, 0, CTL_ZERO_BYTES, stream);
    Args a{};
    for (int i = 0; i < 31; ++i) a.in[i] = d_in[i];
    a.out = (float*)d_out; a.ws = (unsigned char*)d_ws;
    constexpr int NL = MK_N_LAUNCHES;
    for (int li = 0; li < NL; ++li) {
        a.ph_lo = (NL == 1) ? 0 : li; a.ph_hi = (NL == 1) ? NPHASES : li + 1;
        hipLaunchKernelGGL(mega_fwd, dim3(grid), dim3(NWAVES * 64), LDS_BYTES, stream, a);
    }
}
```

```cpp
#include <hip/hip_runtime.h>
#include <cstdio>
#include <cstdint>
namespace pg8 {
#define PG8_LAS __attribute__((address_space(3)))
typedef unsigned short bf16_t;
typedef short bf16x8 __attribute__((ext_vector_type(8)));
typedef float f32x4 __attribute__((ext_vector_type(4)));
typedef unsigned u32x4 __attribute__((ext_vector_type(4)));
constexpr int BM = 256, BK = 64, HALF = 128, HTB = HALF * BK * 2  , STAGE_BYTES = 8 * HTB, NXCD = 8, WGM = 8;

__host__ __device__ __forceinline__ int lds_byte(int r, int c) { const int st = (r >> 4) * 2 + (c >> 5), rr = r & 15, cc = c & 31, ob = rr * 64 + cc * 2; return st * 1024 + (ob ^ (((ob >> 9) & 1) << 5)); }
__host__ __device__ __forceinline__ void stage_rc(int b, int& R, int& C) { const int st = b / 1024, sb = b % 1024, swz = sb ^ (((sb >> 9) & 1) << 5); R = (st >> 1) * 16 + swz / 64; C = (st & 1) * 32 + (swz % 64) / 2; }
__host__ __device__ __forceinline__ int perm32(int rho) { const int n = rho >> 4, i = rho & 15; return 8 * (i >> 2) + 4 * n + (i & 3); }

struct Unit { int pm, pn; };
struct Gemm { const bf16_t* A; const bf16_t* Bt; int M, N, K, lda, ldb; };

struct StaticOrder {
    int nM, nN, nwg, G, c;
    __host__ __device__ void init(int M, int N, int G_, int c_) { nM = M / BM; nN = N / BM; nwg = nM * nN; G = G_; c = c_; }
    __host__ __device__ bool next(int i, Unit& u) const {
        const long L = (long)i * G + c; if (L >= nwg) return false;
        int wgid = (int)L; { const int q = nwg / NXCD, r = nwg % NXCD, xcd = wgid % NXCD, off = wgid / NXCD; wgid = (xcd < r ? xcd * (q + 1) : r * (q + 1) + (xcd - r) * q) + off; }
        const int nig = WGM * nN, gid = wgid / nig, fm = gid * WGM, gsz = (nM - fm) < WGM ? (nM - fm) : WGM;
        u.pm = fm + ((wgid % nig) % gsz); u.pn = (wgid % nig) / gsz; return true;
    }
    __device__ __forceinline__ void a_ready(const Unit&) const {}
    __device__ __forceinline__ void done(const Unit&) const {}
};

__device__ __forceinline__ unsigned cvt_pk_bf16(float lo, float hi) { unsigned r; asm volatile("v_cvt_pk_bf16_f32 %0, %1, %2" : "=v"(r) : "v"(lo), "v"(hi)); return r; }
typedef float f32x2 __attribute__((ext_vector_type(2)));
template <class Epi, class Sched, bool ALIGN_EPI = false, bool SP2 = false>
__device__ __forceinline__ void gemm_phase(PG8_LAS unsigned char* lds, const Gemm g, const Sched& S, const Epi& E) {
    const int tid = threadIdx.x, wid = __builtin_amdgcn_readfirstlane(tid >> 6), lane = tid & 63, wr = wid >> 2, wc = wid & 3, fr = lane & 15, fq = lane >> 4;
    const int K = g.K, nt = K / BK;
    unsigned voffA[2], voffB[2];
#pragma unroll
    for (int i = 0; i < 2; ++i) { int R, C; stage_rc(tid * 16 + i * 8192, R, C); const int Rb = Epi::PERM ? ((R & ~31) + perm32(R & 31)) : R;
        voffA[i] = (unsigned)(R * g.lda + C) * 2u; voffB[i] = (unsigned)(Rb * g.ldb + C) * 2u; }
    const size_t kstep = (size_t)(BK * 2);
    const size_t hstepA = (size_t)HALF * g.lda * 2, hstepB = (size_t)HALF * g.ldb * 2;
    const size_t tstepA = 2 * hstepA, tstepB = 2 * hstepB;
    const unsigned ldsw = (unsigned)wid * 1024u;
    const int aoff = lds_byte(wr * 64 + fr, fq * 8), boff = lds_byte(wc * 32 + fr, fq * 8);
#define PG8_SA(b, h) (((b) * 2 + (h)) * HTB)
#define PG8_SB(b, h) ((4 + (b) * 2 + (h)) * HTB)
#define PG8_STAGE(bufoff, gbase, voff) do { _Pragma("unroll") for (int _i = 0; _i < 2; ++_i) \
        __builtin_amdgcn_global_load_lds((const unsigned*)((const char*)(gbase) + (voff)[_i]), (PG8_LAS unsigned*)(lds + (bufoff) + ldsw + _i * 8192), 16, 0, 0); } while (0)
#define PG8_LDA(dst, b, h) do { _Pragma("unroll") for (int m = 0; m < 4; ++m) _Pragma("unroll") for (int k = 0; k < 2; ++k) dst[m][k] = *(const PG8_LAS bf16x8*)(lds + PG8_SA(b, h) + aoff + m * 2048 + k * 1024); } while (0)
#define PG8_LDB(dst, b, h) do { _Pragma("unroll") for (int n = 0; n < 2; ++n) _Pragma("unroll") for (int k = 0; k < 2; ++k) dst[n][k] = *(const PG8_LAS bf16x8*)(lds + PG8_SB(b, h) + boff + n * 2048 + k * 1024); } while (0)
#define PG8_MMA(ai, bj, At, Bt) do { __builtin_amdgcn_s_setprio(1); _Pragma("unroll") for (int m = 0; m < 4; ++m) _Pragma("unroll") for (int n = 0; n < 2; ++n) _Pragma("unroll") for (int k = 0; k < 2; ++k) \
        acc[ai][bj][m][n] = __builtin_amdgcn_mfma_f32_16x16x32_bf16(Bt[n][k], At[m][k], acc[ai][bj][m][n], 0, 0, 0); __builtin_amdgcn_s_setprio(0); } while (0)
#define PG8_WAIT_V(n) asm volatile("s_waitcnt vmcnt(" #n ")" ::: "memory")
#define PG8_WAIT_L(n) asm volatile("s_waitcnt lgkmcnt(" #n ")" ::: "memory")
#define PG8_BAR __builtin_amdgcn_s_barrier()
#define PG8_SCHED __builtin_amdgcn_sched_barrier(0)
    Unit cur, nxt; int ui = 0;
    if (!S.next(0, cur)) return;
    f32x4 acc[2][2][4][2];
#pragma unroll
    for (int a = 0; a < 2; ++a)
#pragma unroll
        for (int b = 0; b < 2; ++b)
#pragma unroll
            for (int m = 0; m < 4; ++m)
#pragma unroll
                for (int n = 0; n < 2; ++n) acc[a][b][m][n] = (f32x4){0.f, 0.f, 0.f, 0.f};
    bf16x8 At[4][2], B0[2][2], B1[2][2];
    const char* cA = (const char*)g.A + (size_t)cur.pm * tstepA; const char* cB = (const char*)g.Bt + (size_t)cur.pn * tstepB;
    S.a_ready(cur);
    if constexpr (SP2) {
        PG8_STAGE(PG8_SB(0, 0), cB, voffB); PG8_STAGE(PG8_SB(0, 1), cB + hstepB, voffB); PG8_STAGE(PG8_SA(0, 0), cA, voffA); PG8_STAGE(PG8_SA(0, 1), cA + hstepA, voffA);
        if (wr == 1) PG8_BAR;
        PG8_WAIT_V(2); PG8_BAR;
        PG8_STAGE(PG8_SB(1, 0), cB + kstep, voffB); PG8_STAGE(PG8_SA(1, 0), cA + kstep, voffA); PG8_STAGE(PG8_SB(1, 1), cB + hstepB + kstep, voffB);
        PG8_WAIT_V(6); PG8_BAR;
    } else {
        PG8_STAGE(PG8_SB(0, 0), cB, voffB); PG8_STAGE(PG8_SA(0, 0), cA, voffA); PG8_STAGE(PG8_SB(0, 1), cB + hstepB, voffB); PG8_STAGE(PG8_SA(0, 1), cA + hstepA, voffA);
        if (wr == 1) PG8_BAR;
        PG8_WAIT_V(4); PG8_BAR;
        PG8_STAGE(PG8_SB(1, 0), cB + kstep, voffB); PG8_STAGE(PG8_SA(1, 0), cA + kstep, voffA); PG8_STAGE(PG8_SB(1, 1), cB + hstepB + kstep, voffB);
        PG8_WAIT_V(6); PG8_BAR;
    }
    for (;;) {
        const bool has_next = S.next(ui + 1, nxt);
        const char* nA = has_next ? (const char*)g.A + (size_t)nxt.pm * tstepA : cA; const char* nB = has_next ? (const char*)g.Bt + (size_t)nxt.pn * tstepB : cB;
        for (int t = 0; t < nt; t += 2) {
            const bool last = (t == nt - 2);
            const char* a1 = cA + (size_t)(t + 1) * kstep;
            const char* a2 = last ? nA : cA + (size_t)(t + 2) * kstep; const char* b2 = last ? nB : cB + (size_t)(t + 2) * kstep;
            const char* a3 = a2 + kstep; const char* b3 = b2 + kstep;
            if (last && has_next) S.a_ready(nxt);
            if constexpr (SP2) {
            PG8_LDB(B0, 0, 0); PG8_LDB(B1, 0, 1); PG8_SCHED; PG8_LDA(At, 0, 0); PG8_STAGE(PG8_SA(1, 1), a1 + hstepA, voffA);
            PG8_WAIT_V(8); PG8_WAIT_L(0); PG8_BAR; PG8_MMA(0, 0, At, B0); PG8_MMA(0, 1, At, B1); PG8_BAR; PG8_SCHED;
            PG8_LDA(At, 0, 1); PG8_STAGE(PG8_SB(0, 0), b2, voffB); PG8_STAGE(PG8_SB(0, 1), b2 + hstepB, voffB); PG8_STAGE(PG8_SA(0, 0), a2, voffA);
            PG8_WAIT_V(8); PG8_WAIT_L(0); PG8_BAR; PG8_MMA(1, 0, At, B0); PG8_MMA(1, 1, At, B1); PG8_BAR; PG8_SCHED;
            PG8_LDB(B0, 1, 0); PG8_LDB(B1, 1, 1); PG8_SCHED; PG8_LDA(At, 1, 0); PG8_STAGE(PG8_SA(0, 1), a2 + hstepA, voffA);
            PG8_WAIT_V(8); PG8_WAIT_L(0); PG8_BAR; PG8_MMA(0, 0, At, B0); PG8_MMA(0, 1, At, B1); PG8_BAR; PG8_SCHED;
            PG8_LDA(At, 1, 1); PG8_STAGE(PG8_SB(1, 0), b3, voffB); PG8_STAGE(PG8_SB(1, 1), b3 + hstepB, voffB); PG8_STAGE(PG8_SA(1, 0), a3, voffA);
            PG8_WAIT_V(8); PG8_WAIT_L(0); PG8_BAR; PG8_MMA(1, 0, At, B0); PG8_MMA(1, 1, At, B1); PG8_BAR; PG8_SCHED;
            } else {
            PG8_LDB(B0, 0, 0); PG8_SCHED; PG8_LDA(At, 0, 0); PG8_STAGE(PG8_SA(1, 1), a1 + hstepA, voffA);
            PG8_WAIT_L(8); PG8_BAR; PG8_WAIT_L(0); PG8_MMA(0, 0, At, B0); PG8_BAR; PG8_SCHED;
            PG8_LDB(B1, 0, 1); PG8_STAGE(PG8_SB(0, 0), b2, voffB);
            PG8_BAR; PG8_WAIT_L(0); PG8_MMA(0, 1, At, B1); PG8_BAR;
            PG8_LDA(At, 0, 1); PG8_STAGE(PG8_SA(0, 0), a2, voffA);
            PG8_BAR; PG8_WAIT_L(0); PG8_MMA(1, 0, At, B0); PG8_BAR; PG8_SCHED;
            PG8_STAGE(PG8_SB(0, 1), b2 + hstepB, voffB);
            PG8_WAIT_V(6); PG8_BAR; PG8_MMA(1, 1, At, B1); PG8_BAR;
            PG8_LDB(B0, 1, 0); PG8_SCHED; PG8_LDA(At, 1, 0); PG8_STAGE(PG8_SA(0, 1), a2 + hstepA, voffA);
            PG8_WAIT_L(8); PG8_BAR; PG8_WAIT_L(0); PG8_MMA(0, 0, At, B0); PG8_BAR; PG8_SCHED;
            PG8_LDB(B1, 1, 1); PG8_STAGE(PG8_SB(1, 0), b3, voffB);
            PG8_BAR; PG8_WAIT_L(0); PG8_MMA(0, 1, At, B1); PG8_BAR;
            PG8_LDA(At, 1, 1); PG8_STAGE(PG8_SA(1, 0), a3, voffA);
            PG8_BAR; PG8_WAIT_L(0); PG8_MMA(1, 0, At, B0); PG8_BAR; PG8_SCHED;
            PG8_STAGE(PG8_SB(1, 1), b3 + hstepB, voffB);
            PG8_WAIT_V(6); PG8_BAR; PG8_MMA(1, 1, At, B1); PG8_BAR;
            }
        }
        if constexpr (ALIGN_EPI) { if (wr == 0) PG8_BAR; }
        if constexpr (!Epi::AFTER_DRAIN) { E(acc, cur, wr, wc, fr, fq); S.done(cur); }
        if (!has_next) break;
#pragma unroll
        for (int a = 0; a < 2; ++a)
#pragma unroll
            for (int b = 0; b < 2; ++b)
#pragma unroll
                for (int m = 0; m < 4; ++m)
#pragma unroll
                    for (int n = 0; n < 2; ++n) acc[a][b][m][n] = (f32x4){0.f, 0.f, 0.f, 0.f};
        cur = nxt; cA = nA; cB = nB; ++ui;
        if constexpr (ALIGN_EPI) { if (wr == 1) PG8_BAR; }
    }
    PG8_WAIT_V(0);
    if constexpr (!ALIGN_EPI) { if (wr == 0) PG8_BAR; }
    PG8_BAR;
    if constexpr (Epi::AFTER_DRAIN) { E.fused(acc, cur, wr, wc, fr, fq, lds, wid, lane); S.done(cur); }
#undef PG8_SA
#undef PG8_SB
#undef PG8_STAGE
#undef PG8_LDA
#undef PG8_LDB
#undef PG8_MMA
#undef PG8_WAIT_V
#undef PG8_WAIT_L
#undef PG8_BAR
#undef PG8_SCHED
}
}

namespace att {
typedef short bf16x8 __attribute__((ext_vector_type(8)));
typedef short s16x4 __attribute__((ext_vector_type(4)));
typedef float f32x16 __attribute__((ext_vector_type(16)));
typedef unsigned u32x4 __attribute__((ext_vector_type(4)));
typedef unsigned short bf16;
constexpr int DQK = 192, DV = 128, KROW = 384, SHM_K = 64 * KROW, SHM_V = 64 * DV * 2;
constexpr int V_OFF = 0, K_OFF = 2 * SHM_V, WS_OFF = 2 * SHM_V + 2 * SHM_K, ATT_LDS = WS_OFF + 8 * 64 * 4;
constexpr float SCALE = 0.07216878364870322f, THR = 8.f;
#define ATT_KSWZ(row, colB) ((row) * 384 + ((colB) ^ (((row) & 7) << 4)))
#define ATT_SBAR() __builtin_amdgcn_sched_barrier(0)
__device__ __forceinline__ int v_st(int k, int c) { const int kk = (k & ~0xC) | ((k & 4) << 1) | ((k & 8) >> 1); return ((kk >> 3) * 4 + (c >> 5)) * 512 + ((kk & 7) * 32 + (c & 31)) * 2; }
__device__ __forceinline__ int v_rd_base(int lane) { return ((lane & 3) << 3) | (((lane >> 2) & 3) << 6) | (((lane >> 4) & 1) << 5) | (((lane >> 5) & 1) << 8); }
constexpr int v_rd_off(int d0, int ks, int half) { return d0 * 512 + ks * 4096 + half * 2048; }
__device__ __forceinline__ int crow(int r, int hi) { return (r & 3) + 8 * (r >> 2) + 4 * hi; }
__device__ __forceinline__ unsigned cvtpk(float lo, float hi) { unsigned r; asm volatile("v_cvt_pk_bf16_f32 %0, %1, %2" : "=v"(r) : "v"(lo), "v"(hi)); return r; }
__device__ __forceinline__ void mask_tile(f32x16& p0, f32x16& p1, int dq) {
    const float NEG = -__builtin_inff();
#pragma unroll
    for (int r = 0; r < 16; ++r) { const int c = (r & 3) + 8 * (r >> 2); if (dq - c < 0) p0[r] = NEG; if (dq - c - 32 < 0) p1[r] = NEG; }
}
__device__ __forceinline__ void partialSM(f32x16& p0, f32x16& p1, float& m_reg, float& mn, float& alpha) {
    float pmax = p0[0];
#pragma unroll
    for (int r = 1; r < 16; ++r) pmax = fmaxf(pmax, p0[r]);
#pragma unroll
    for (int r = 0; r < 16; ++r) pmax = fmaxf(pmax, p1[r]);
    { auto rr = __builtin_amdgcn_permlane32_swap(__float_as_uint(pmax), __float_as_uint(pmax), false, false);
      pmax = fmaxf(__uint_as_float(rr[0]), __uint_as_float(rr[1])); }
    constexpr float C2 = 1.4426950408889634f * SCALE;
    if (__builtin_expect(__all((pmax - m_reg) * SCALE <= THR), 1)) { mn = m_reg; alpha = 1.f; }
    else { mn = fmaxf(m_reg, pmax); alpha = __builtin_amdgcn_exp2f((m_reg - mn) * C2); m_reg = mn; }
    const float mnL = -mn * C2;
#pragma unroll
    for (int r = 0; r < 16; ++r) p0[r] = fmaf(p0[r], C2, mnL);
#pragma unroll
    for (int r = 0; r < 16; ++r) p1[r] = fmaf(p1[r], C2, mnL);
#pragma unroll
    for (int r = 0; r < 16; ++r) p0[r] = __builtin_amdgcn_exp2f(p0[r]);
}
__device__ __forceinline__ void finishSM(f32x16& p0, f32x16& p1, float alpha, float& l_reg, bf16x8& pa0, bf16x8& pa1, bf16x8& pa2, bf16x8& pa3) {
#pragma unroll
    for (int r = 0; r < 16; ++r) p1[r] = __builtin_amdgcn_exp2f(p1[r]);
    float ps = 0;
#pragma unroll
    for (int r = 0; r < 16; ++r) ps += p0[r];
#pragma unroll
    for (int r = 0; r < 16; ++r) ps += p1[r];
    { auto rr = __builtin_amdgcn_permlane32_swap(__float_as_uint(ps), __float_as_uint(ps), false, false);
      ps = __uint_as_float(rr[0]) + __uint_as_float(rr[1]); }
    l_reg = l_reg * alpha + ps;
#define ATT_PK4(P, B_, OUT) do { unsigned a0 = cvtpk(P[B_+0], P[B_+1]), a1 = cvtpk(P[B_+2], P[B_+3]);                          \
        unsigned b0 = cvtpk(P[B_+4], P[B_+5]), b1 = cvtpk(P[B_+6], P[B_+7]);                                             \
        auto r0 = __builtin_amdgcn_permlane32_swap(a0, b0, false, false); auto r1 = __builtin_amdgcn_permlane32_swap(a1, b1, false, false); \
        u32x4 w = {r0[0], r1[0], r0[1], r1[1]}; OUT = *reinterpret_cast<bf16x8*>(&w); } while (0)
    ATT_PK4(p0, 0, pa0); ATT_PK4(p0, 8, pa1); ATT_PK4(p1, 0, pa2); ATT_PK4(p1, 8, pa3);
#undef ATT_PK4
}
template <int KB>
__device__ __forceinline__ void qkt(f32x16& p0, f32x16& p1, const char* K_lds, int r32, int hi, const bf16x8* qr) {
    p0 = f32x16{}; p1 = f32x16{};
    const char* kb[4];
#pragma unroll
    for (int dd = 0; dd < 4; ++dd) kb[dd] = K_lds + KB * SHM_K + ATT_KSWZ(r32, (dd * 16 + hi * 8) * 2);
#pragma unroll
    for (int d0 = 0; d0 < 12; ++d0) { const char* a = kb[d0 & 3] + (d0 >> 2) * 128;
        bf16x8 b0 = *reinterpret_cast<const bf16x8*>(a);
        bf16x8 b1 = *reinterpret_cast<const bf16x8*>(a + 32 * KROW);
        p0 = __builtin_amdgcn_mfma_f32_32x32x16_bf16(b0, qr[d0], p0, 0, 0, 0);
        p1 = __builtin_amdgcn_mfma_f32_32x32x16_bf16(b1, qr[d0], p1, 0, 0, 0); }
}
template <int VB>
__device__ __forceinline__ void pv_tile(f32x16* o, int vb0, bf16x8 pa0, bf16x8 pa1, bf16x8 pa2, bf16x8 pa3) {
#define ATT_TRRD(dst, off) asm volatile("ds_read_b64_tr_b16 %0, %1 offset:%2" : "=&v"(dst) : "v"(vb0), "i"(off) : "memory")
#define ATT_PV_D0(d0) do { s16x4 l0, l1, l2, l3, h0, h1, h2, h3; constexpr int b_ = V_OFF + VB * SHM_V + v_rd_off(d0, 0, 0); \
        ATT_TRRD(l0, b_); ATT_TRRD(h0, b_ + 2048); ATT_TRRD(l1, b_ + 4096); ATT_TRRD(h1, b_ + 6144); ATT_TRRD(l2, b_ + 8192); ATT_TRRD(h2, b_ + 10240); ATT_TRRD(l3, b_ + 12288); ATT_TRRD(h3, b_ + 14336); \
        asm volatile("s_waitcnt lgkmcnt(0)" ::: "memory"); ATT_SBAR();   \
        o[d0] = __builtin_amdgcn_mfma_f32_32x32x16_bf16(pa0, (bf16x8){l0[0], l0[1], l0[2], l0[3], h0[0], h0[1], h0[2], h0[3]}, o[d0], 0, 0, 0);   \
        o[d0] = __builtin_amdgcn_mfma_f32_32x32x16_bf16(pa1, (bf16x8){l1[0], l1[1], l1[2], l1[3], h1[0], h1[1], h1[2], h1[3]}, o[d0], 0, 0, 0);   \
        o[d0] = __builtin_amdgcn_mfma_f32_32x32x16_bf16(pa2, (bf16x8){l2[0], l2[1], l2[2], l2[3], h2[0], h2[1], h2[2], h2[3]}, o[d0], 0, 0, 0);   \
        o[d0] = __builtin_amdgcn_mfma_f32_32x32x16_bf16(pa3, (bf16x8){l3[0], l3[1], l3[2], l3[3], h3[0], h3[1], h3[2], h3[3]}, o[d0], 0, 0, 0); } while (0)
    ATT_PV_D0(0); ATT_PV_D0(1); ATT_PV_D0(2); ATT_PV_D0(3);
#undef ATT_PV_D0
#undef ATT_TRRD
}

__device__ __forceinline__ void attn_block(const bf16* Qb, const bf16* Kh, const bf16* Vh, bf16* Ob, int ldo, int P0, char* lds) {
    const int tid = threadIdx.x, wid = __builtin_amdgcn_readfirstlane(tid >> 6), lane = tid & 63, r32 = lane & 31, hi = lane >> 5;
    const int NT = (P0 + 256) / 64;
    const int qlo = P0 + wid * 32, qm = qlo + r32 - 4 * hi;
    char* V_lds = lds + V_OFF; char* K_lds = lds + K_OFF;
    float* wsf = (float*)(lds + WS_OFF) + wid * 64; float* li_l = wsf; float* al_l = wsf + 32;
    float m_reg = -1e30f, l_reg = 0.f; f32x16 o[4] = {};
    bf16x8 qr[12];
#pragma unroll
    for (int d0 = 0; d0 < 12; ++d0) qr[d0] = *reinterpret_cast<const bf16x8*>((const char*)Qb + (unsigned)(((wid * 32 + r32) * DQK + hi * 8) * 2) + d0 * 32);
    const int krow = tid >> 3, kws0 = ATT_KSWZ(krow, (tid & 7) * 16);
    const int sr = tid >> 4, sc = (tid & 15) * 8, vst0 = v_st(sr, sc);
    const int vb0 = (int)(uintptr_t)V_lds + v_rd_base(lane);
    bf16x8 st_k0, st_k1, st_k2, st_v0, st_v1;
    const unsigned kgo = (unsigned)(krow * KROW + (tid & 7) * 16), vgo = (unsigned)((sr * DV + sc) * 2);
#define ATT_SLOAD(t) do { const char* kp_ = (const char*)Kh + (size_t)(t) * (64 * KROW) + kgo; const char* vp_ = (const char*)Vh + (size_t)(t) * (64 * DV * 2) + vgo; \
        st_k0 = *reinterpret_cast<const bf16x8*>(kp_); st_k1 = *reinterpret_cast<const bf16x8*>(kp_ + 128); st_k2 = *reinterpret_cast<const bf16x8*>(kp_ + 256); \
        st_v0 = *reinterpret_cast<const bf16x8*>(vp_); st_v1 = *reinterpret_cast<const bf16x8*>(vp_ + 32 * DV * 2); } while (0)
#define ATT_SWRITE(bf) do { *(bf16x8*)(K_lds + (bf) * SHM_K + kws0) = st_k0; *(bf16x8*)(K_lds + (bf) * SHM_K + kws0 + 128) = st_k1; *(bf16x8*)(K_lds + (bf) * SHM_K + kws0 + 256) = st_k2; \
        *(bf16x8*)(V_lds + (bf) * SHM_V + vst0) = st_v0; *(bf16x8*)(V_lds + (bf) * SHM_V + vst0 + 8192) = st_v1; } while (0)
#define ATT_RESC(a) do { if (__any((a) < 1.f)) { if (hi == 0) al_l[r32] = (a); asm volatile("s_waitcnt lgkmcnt(0)" ::: "memory");              \
        _Pragma("unroll") for (int d_ = 0; d_ < 4; ++d_) _Pragma("unroll") for (int r = 0; r < 16; ++r) o[d_][r] *= al_l[crow(r, hi)]; } } while (0)
    ATT_SLOAD(0); ATT_SWRITE(0);
    __syncthreads();
    f32x16 p0, p1; float mn, alpha; bf16x8 pa0, pa1, pa2, pa3;
#define ATT_STEP(BF, t) do { \
        if ((t) + 1 < NT) ATT_SLOAD((t) + 1); \
        ATT_SBAR(); qkt<BF>(p0, p1, K_lds, r32, hi, qr); \
        { const int kb_ = (t) * 64; if (kb_ + 63 > qlo) mask_tile(p0, p1, qm - kb_); } \
        partialSM(p0, p1, m_reg, mn, alpha); ATT_RESC(alpha); \
        finishSM(p0, p1, alpha, l_reg, pa0, pa1, pa2, pa3); ATT_SBAR(); \
        pv_tile<BF>(o, vb0, pa0, pa1, pa2, pa3); \
        if ((t) + 1 < NT) ATT_SWRITE((BF) ^ 1); \
        __syncthreads(); } while (0)
    for (int t = 0; t < NT; t += 2) { ATT_STEP(0, t); ATT_STEP(1, t + 1); }
    if (hi == 0) li_l[r32] = l_reg; asm volatile("s_waitcnt lgkmcnt(0)" ::: "memory");
    float rli[16];
#pragma unroll
    for (int r = 0; r < 16; ++r) rli[r] = __builtin_amdgcn_rcpf(li_l[crow(r, hi)]);
    char* Ow = (char*)Ob + (size_t)(wid * 32) * ldo * 2; const unsigned olo = (unsigned)((4 * hi * ldo + r32) * 2);
#pragma unroll
    for (int r = 0; r < 16; ++r) { const int orow = (r & 3) + 8 * (r >> 2);
#pragma unroll
        for (int d0 = 0; d0 < 4; ++d0) { const float v = o[d0][r] * rli[r]; const float vn = __shfl_xor(v, 1);
            if ((r32 & 1) == 0) *(unsigned*)(Ow + olo + (unsigned)(orow * ldo * 2 + d0 * 64)) = cvtpk(v, vn); } }
    __syncthreads();
#undef ATT_SLOAD
#undef ATT_SWRITE
#undef ATT_RESC
#undef ATT_STEP
}
}

#ifndef PG8_SP2
#define PG8_SP2 true
#endif
#ifndef PG8_ALIGN
#define PG8_ALIGN true
#endif
#ifndef MK_N_LAUNCHES
#define MK_N_LAUNCHES 1
#endif

constexpr int M = 16384, SEQ = 2048, NB = 8, D = 2048, NH = 8, DQK = 192, DV = 128;
constexpr int QL = 512, KVL = 256, NG = 64, GH = 16, NP = 64, FF = 5632, PLE = 256, SSMW = 1024;
constexpr float EPS = 1e-6f;
constexpr int ZC_Q = 0, ZC_KV = 512, ZC_KR = 768, ZLD = 1024;
constexpr int TC = 16, NCH = SEQ / TC, ASLD = 384, SROWS = NB * NCH;
constexpr int NPHASES = 11;

constexpr size_t MiB = 1u << 20;
constexpr size_t WS_CTL = 0, CTL_ZERO_BYTES = 1 * MiB;
constexpr int CW_BAR = 4096;
constexpr size_t SQ_Q = 65536 * 1, SQ_KV = 65536 * 2, SQ_X1 = 65536 * 3, SQ_X2 = 65536 * 4;
constexpr size_t WS_A16 = 1 * MiB;
constexpr size_t WS_WIN = 2 * MiB, WS_WUQ = 10 * MiB, WS_WUKV = 12 * MiB, WS_WGLU = 13 * MiB, WS_WO = 15 * MiB, WS_WGU = 23 * MiB, WS_WDN = 67 * MiB, WS_WPG = 89 * MiB, WS_WPP = 97 * MiB;
constexpr size_t WS_MT = 98 * MiB;
constexpr size_t WS_HN = 100 * MiB;
constexpr size_t WS_E = 100 * MiB;
constexpr size_t WS_YG = 132 * MiB;
constexpr size_t WS_Z = 164 * MiB;
constexpr size_t WS_AS = 196 * MiB;
constexpr size_t WS_PALL = 244 * MiB;
constexpr size_t WS_WALL = 252 * MiB;
constexpr size_t WS_QRAW = 264 * MiB, WS_KVRAW = 312 * MiB;
constexpr size_t WS_Q = 376 * MiB, WS_K = 424 * MiB, WS_V = 472 * MiB;
constexpr size_t WS_OA = 264 * MiB, WS_OS = 296 * MiB;
constexpr size_t WS_H = 228 * MiB, WS_PP = 404 * MiB, WS_PB = 504 * MiB, WS_END = 512 * MiB;

constexpr int RING_BYTES = 131072, MISC_OFF = 139264 + 320, LDS_BYTES = 147456;
constexpr int NWAVES = 8;

#define GAS __attribute__((address_space(1)))
#define LAS __attribute__((address_space(3)))
typedef unsigned short bf16;
typedef unsigned v4u __attribute__((ext_vector_type(4)));
typedef unsigned v2u __attribute__((ext_vector_type(2)));
typedef float f32x4 __attribute__((ext_vector_type(4)));
typedef GAS unsigned gu32;
#define LDS_WAIT() asm volatile("s_waitcnt lgkmcnt(0)" ::: "memory")
__device__ __forceinline__ unsigned f2bf(float f) { unsigned u = __builtin_bit_cast(unsigned, f); return (u + 0x7fffu + ((u >> 16) & 1u)) >> 16; }
__device__ __forceinline__ unsigned pk2(float lo, float hi) { return f2bf(lo) | (f2bf(hi) << 16); }
__device__ __forceinline__ float bf2f(unsigned h) { return __builtin_bit_cast(float, h << 16); }
__device__ __forceinline__ float bflo(unsigned w) { return __builtin_bit_cast(float, w << 16); }
__device__ __forceinline__ float bfhi(unsigned w) { return __builtin_bit_cast(float, w & 0xffff0000u); }
__device__ __forceinline__ int fresh_tid() { int t = threadIdx.x; asm volatile("" : "+v"(t)); return t; }
__device__ __forceinline__ float wave_sum(float v) {
#pragma unroll
    for (int o = 1; o < 64; o <<= 1) v += __shfl_xor(v, o);
    return v;
}
__device__ __forceinline__ float wave_max(float v) {
#pragma unroll
    for (int o = 1; o < 64; o <<= 1) v = fmaxf(v, __shfl_xor(v, o));
    return v;
}
__device__ __forceinline__ float sigmoid_f(float v) { return __builtin_amdgcn_rcpf(1.0f + __builtin_amdgcn_exp2f(-1.4426950408889634f * v)); }
__device__ __forceinline__ float gelu_tanh(float v) {
    const float z = 0.7978845608028654f * (v + 0.044715f * v * v * v);
    const float e = __builtin_amdgcn_exp2f(2.0f * 1.4426950408889634f * z);
    const float th = 1.0f - 2.0f * __builtin_amdgcn_rcpf(e + 1.0f);
    return 0.5f * v * (1.0f + th);
}

#define XB_TMO      128
#define XB_XCNT(j)  (256  + 64 * (j))
#define XB_XSUB(j)  (1280 + 64 * (j))
#define XB_XGEN(j)  (2304 + 64 * (j))
#define XB_TOP      3328
#define XB_TOPGEN   3392
#define XCD_BAR_WORDS 3456
#define XB_SPIN_CAP (1u << 18)
__device__ __forceinline__ unsigned xb_ld(unsigned* p)              { return __hip_atomic_load(p, __ATOMIC_RELAXED, __HIP_MEMORY_SCOPE_AGENT); }
__device__ __forceinline__ unsigned xb_add(unsigned* p, unsigned v) { return __hip_atomic_fetch_add(p, v, __ATOMIC_RELAXED, __HIP_MEMORY_SCOPE_AGENT); }
__device__ __forceinline__ unsigned xb_xcc_id() { return (unsigned)__builtin_amdgcn_s_getreg((3 << 11) | 20) & 0xFu; }
#define XB_SPIN(cond, bar) do { unsigned _sp = 0; while (cond) { __builtin_amdgcn_s_sleep(1); \
    if ((++_sp & 255u) == 0u) { if (xb_ld(&(bar)[XB_TMO])) break; if (_sp > XB_SPIN_CAP) { atomicAdd(&(bar)[XB_TMO], 1u); break; } } } } while (0)
struct XcdBarrier { unsigned* bar; unsigned x; volatile LAS unsigned* st; };
__device__ __forceinline__ XcdBarrier xcd_barrier_post(unsigned* bar, volatile LAS unsigned* st) {
    XcdBarrier b; b.bar = bar; b.x = xb_xcc_id(); b.st = st;
    if (threadIdx.x == 0) (void)xb_add(&bar[XB_XCNT(b.x)], 1u);
    return b;
}
__device__ __forceinline__ void xcd_barrier_complete(unsigned* bar, unsigned x, unsigned& nloc, unsigned& nx) {
    const unsigned G = gridDim.x * gridDim.y * gridDim.z;
    unsigned sum, cnt, mine, sp = 0u;
    for (;;) {
        sum = 0u; cnt = 0u; mine = 0u;
#pragma unroll
        for (unsigned j = 0; j < 16; ++j) { const unsigned c = xb_ld(&bar[XB_XCNT(j)]); sum += c; cnt += (c > 0u) ? 1u : 0u; mine = (j == x) ? c : mine; }
        if (sum == G) break;
        __builtin_amdgcn_s_sleep(1);
        if ((++sp & 255u) == 0u) { if (xb_ld(&bar[XB_TMO])) break; if (sp > XB_SPIN_CAP) { atomicAdd(&bar[XB_TMO], 1u); break; } }
    }
    nloc = mine > 0u ? mine : 1u; nx = cnt > 0u ? cnt : 1u;
}
__device__ __forceinline__ void xcd_barrier(const XcdBarrier& b) {
    asm volatile("s_waitcnt vmcnt(0)" ::: "memory");
    __syncthreads();
    if (threadIdx.x == 0) {
        unsigned* bar = b.bar;
        __builtin_amdgcn_s_waitcnt(0);
        unsigned nloc = b.st[0], nx = b.st[1];
        if (nloc == 0u) { xcd_barrier_complete(bar, b.x, nloc, nx); b.st[0] = nloc; b.st[1] = nx; }
        const unsigned old = xb_add(&bar[XB_XSUB(b.x)], 1u);
        const unsigned gen = old / nloc;
        if (old + 1u == (gen + 1u) * nloc) {
            __builtin_amdgcn_fence(__ATOMIC_RELEASE, "agent");
            asm volatile("s_waitcnt vmcnt(0)" ::: "memory");
            const unsigned og = xb_add(&bar[XB_TOP], 1u);
            const unsigned tg = og / nx;
            if (og + 1u == (tg + 1u) * nx) xb_add(&bar[XB_TOPGEN], 1u);
            else XB_SPIN(xb_ld(&bar[XB_TOPGEN]) == tg, bar);
            __builtin_amdgcn_fence(__ATOMIC_ACQUIRE, "agent");
            xb_add(&bar[XB_XGEN(b.x)], 1u);
            asm volatile("s_waitcnt vmcnt(0)" ::: "memory");
        } else {
            XB_SPIN(xb_ld(&bar[XB_XGEN(b.x)]) == gen, bar);
            __builtin_amdgcn_fence(__ATOMIC_ACQUIRE, "agent");
            asm volatile("s_waitcnt vmcnt(0)" ::: "memory");
        }
    }
    __syncthreads();
}

using pg8::Unit; using pg8::cvt_pk_bf16;
#define EPI_LOOP_AM _Pragma("unroll") for (int ai = 0; ai < 2; ++ai) _Pragma("unroll") for (int m = 0; m < 4; ++m)
__device__ __forceinline__ float sq8(const f32x4& a, const f32x4& b) { return (a[0] * a[0] + a[1] * a[1]) + (a[2] * a[2] + a[3] * a[3]) + (b[0] * b[0] + b[1] * b[1]) + (b[2] * b[2] + b[3] * b[3]); }
__device__ __forceinline__ v4u pack8(const f32x4& a, const f32x4& b) { v4u w; w.x = cvt_pk_bf16(a[0], a[1]); w.y = cvt_pk_bf16(a[2], a[3]); w.z = cvt_pk_bf16(b[0], b[1]); w.w = cvt_pk_bf16(b[2], b[3]); return w; }

struct EpiZ {
    static constexpr bool PERM = true, AFTER_DRAIN = false;
    bf16* Z; bf16* AS; float* sqq; float* sqkv;
    __device__ __forceinline__ void operator()(const f32x4 (&acc)[2][2][4][2], const Unit& u, int wr, int wc, int fr, int fq) const {
        const int row0 = u.pm * 256 + wr * 64 + fr;
        if (u.pn < 4) {
            const int col0 = u.pn * 256 + wc * 32 + 8 * fq;
            float* sq = u.pn < 2 ? sqq : (u.pn == 2 ? sqkv : nullptr);
            EPI_LOOP_AM { const int row = row0 + ai * 128 + m * 16; bf16* rowp = Z + (size_t)row * ZLD + col0; float s = 0.f;
#pragma unroll
                for (int bj = 0; bj < 2; ++bj) { *(v4u*)(rowp + bj * 128) = pack8(acc[ai][bj][m][0], acc[ai][bj][m][1]); s += sq8(acc[ai][bj][m][0], acc[ai][bj][m][1]); }
                if (sq) { s += __shfl_xor(s, 16); s += __shfl_xor(s, 32); if (fq == 0) atomicAdd(sq + row, s); } }
        } else {
            const int ch0 = (u.pn - 4) * 256 + wc * 32 + 8 * fq;
            EPI_LOOP_AM { const int row = row0 + ai * 128 + m * 16;
#pragma unroll
                for (int bj = 0; bj < 2; ++bj) { const int ch = ch0 + bj * 128, g = ch >> 4, h0 = ch & 15;
                    *(v4u*)(AS + ((size_t)(g * SROWS + (row >> 4)) * ASLD + (row & 15) * 16 + h0)) = pack8(acc[ai][bj][m][0], acc[ai][bj][m][1]); } }
        }
    }
};
struct EpiE {
    static constexpr bool PERM = true, AFTER_DRAIN = false;
    float* E;
    __device__ __forceinline__ void operator()(const f32x4 (&acc)[2][2][4][2], const Unit& u, int wr, int wc, int fr, int fq) const {
        const int row0 = u.pm * 256 + wr * 64 + fr, col0 = wc * 32 + 8 * fq;
        EPI_LOOP_AM { float* rowp = E + (size_t)(row0 + ai * 128 + m * 16) * 128 + col0; *(f32x4*)rowp = acc[ai][0][m][0]; *(f32x4*)(rowp + 4) = acc[ai][0][m][1]; }
    }
};
struct EpiY {
    static constexpr bool PERM = true, AFTER_DRAIN = false;
    bf16* YG;
    __device__ __forceinline__ void operator()(const f32x4 (&acc)[2][2][4][2], const Unit& u, int wr, int wc, int fr, int fq) const {
        const int g = u.pn, r0 = (u.pm & 3) * 256 + wr * 64 + fr, n0 = wc * 32 + 8 * fq;
        EPI_LOOP_AM { const int r = r0 + ai * 128 + m * 16, b = r >> 7, k = r & 127;
#pragma unroll
            for (int bj = 0; bj < 2; ++bj) { const int n = n0 + bj * 128, j = n >> 4, h0 = n & 15; f32x4 a = acc[ai][bj][m][0], c = acc[ai][bj][m][1];
#pragma unroll
                for (int e = 0; e < 4; ++e) { a[e] = gelu_tanh(a[e]); c[e] = gelu_tanh(c[e]); }
                *(v4u*)(YG + (size_t)(b * SEQ + k * TC + j) * SSMW + GH * g + h0) = pack8(a, c); } }
    }
};
struct EpiScale {
    static constexpr bool PERM = true, AFTER_DRAIN = false;
    bf16* O; int ldc; const float* sq; float invk;
    __device__ __forceinline__ void operator()(const f32x4 (&acc)[2][2][4][2], const Unit& u, int wr, int wc, int fr, int fq) const {
        const int row0 = u.pm * 256 + wr * 64 + fr, col0 = u.pn * 256 + wc * 32 + 8 * fq;
        EPI_LOOP_AM { const int row = row0 + ai * 128 + m * 16; bf16* rowp = O + (size_t)row * ldc + col0; const float rs = __builtin_amdgcn_rsqf(sq[row] * invk + EPS);
#pragma unroll
            for (int bj = 0; bj < 2; ++bj) *(v4u*)(rowp + bj * 128) = pack8(acc[ai][bj][m][0] * rs, acc[ai][bj][m][1] * rs); }
    }
};
struct EpiPlain {
    static constexpr bool PERM = true, AFTER_DRAIN = false;
    bf16* O; int ldc;
    __device__ __forceinline__ void operator()(const f32x4 (&acc)[2][2][4][2], const Unit& u, int wr, int wc, int fr, int fq) const {
        const int row0 = u.pm * 256 + wr * 64 + fr, col0 = u.pn * 256 + wc * 32 + 8 * fq;
        EPI_LOOP_AM { bf16* rowp = O + (size_t)(row0 + ai * 128 + m * 16) * ldc + col0;
#pragma unroll
            for (int bj = 0; bj < 2; ++bj) *(v4u*)(rowp + bj * 128) = pack8(acc[ai][bj][m][0], acc[ai][bj][m][1]); }
    }
};
__device__ __forceinline__ void unpack8(const v4u w, float (&f)[8]) { f[0] = bflo(w.x); f[1] = bfhi(w.x); f[2] = bflo(w.y); f[3] = bfhi(w.y); f[4] = bflo(w.z); f[5] = bfhi(w.z); f[6] = bflo(w.w); f[7] = bfhi(w.w); }
struct EpiGlu {
    static constexpr bool PERM = true, AFTER_DRAIN = false;
    const bf16* YG; const float* bias; bf16* O;
    __device__ __forceinline__ void operator()(const f32x4 (&acc)[2][2][4][2], const Unit& u, int wr, int wc, int fr, int fq) const {
        const int row0 = u.pm * 256 + wr * 64 + fr, col0 = u.pn * 256 + wc * 32 + 8 * fq;
        f32x4 bv[2][2];
#pragma unroll
        for (int bj = 0; bj < 2; ++bj) { bv[bj][0] = *(const f32x4*)(bias + col0 + bj * 128); bv[bj][1] = *(const f32x4*)(bias + col0 + bj * 128 + 4); }
        EPI_LOOP_AM { const size_t off = (size_t)(row0 + ai * 128 + m * 16) * SSMW + col0;
#pragma unroll
            for (int bj = 0; bj < 2; ++bj) { float y[8]; unpack8(*(const v4u*)(YG + off + bj * 128), y);
                f32x4 a = acc[ai][bj][m][0] + bv[bj][0], b = acc[ai][bj][m][1] + bv[bj][1];
#pragma unroll
                for (int j = 0; j < 4; ++j) { a[j] = y[j] * sigmoid_f(a[j]); b[j] = y[4 + j] * sigmoid_f(b[j]); }
                *(v4u*)(O + off + bj * 128) = pack8(a, b); } }
    }
};
struct EpiResid {
    static constexpr bool PERM = true, AFTER_DRAIN = false;
    const float* xin; float* xout; bf16* xb; float* sq;
    __device__ __forceinline__ void operator()(const f32x4 (&acc)[2][2][4][2], const Unit& u, int wr, int wc, int fr, int fq) const {
        const int row0 = u.pm * 256 + wr * 64 + fr, col0 = u.pn * 256 + wc * 32 + 8 * fq;
        EPI_LOOP_AM { const int row = row0 + ai * 128 + m * 16; const size_t off = (size_t)row * D + col0; float s = 0.f;
#pragma unroll
            for (int bj = 0; bj < 2; ++bj) { const f32x4 a = *(const f32x4*)(xin + off + bj * 128) + acc[ai][bj][m][0], b = *(const f32x4*)(xin + off + bj * 128 + 4) + acc[ai][bj][m][1];
                *(f32x4*)(xout + off + bj * 128) = a; *(f32x4*)(xout + off + bj * 128 + 4) = b; *(v4u*)(xb + off + bj * 128) = pack8(a, b); s += sq8(a, b); }
            s += __shfl_xor(s, 16); s += __shfl_xor(s, 32); if (fq == 0) atomicAdd(sq + row, s); }
    }
};
struct EpiGateUp {
    static constexpr bool PERM = true, AFTER_DRAIN = false;
    bf16* H; const float* sq;
    __device__ __forceinline__ void operator()(const f32x4 (&acc)[2][2][4][2], const Unit& u, int wr, int wc, int fr, int fq) const {
        const int row0 = u.pm * 256 + wr * 64 + fr, col0 = u.pn * 128 + wc * 32 + 8 * fq;
        EPI_LOOP_AM { const int row = row0 + ai * 128 + m * 16; const float rs = __builtin_amdgcn_rsqf(sq[row] * (1.0f / D) + EPS);
            f32x4 a, b;
#pragma unroll
            for (int j = 0; j < 4; ++j) { const float g0 = acc[ai][0][m][0][j] * rs, u0 = acc[ai][1][m][0][j] * rs, g1 = acc[ai][0][m][1][j] * rs, u1 = acc[ai][1][m][1][j] * rs;
                a[j] = g0 * sigmoid_f(g0) * u0; b[j] = g1 * sigmoid_f(g1) * u1; }
            *(v4u*)(H + (size_t)row * FF + col0) = pack8(a, b); }
    }
};
struct EpiPle {
    static constexpr bool PERM = true, AFTER_DRAIN = false;
    float* xio; const bf16* PP; const float* sq;
    __device__ __forceinline__ void operator()(const f32x4 (&acc)[2][2][4][2], const Unit& u, int wr, int wc, int fr, int fq) const {
        const int row0 = u.pm * 256 + wr * 64 + fr, col0 = u.pn * 256 + wc * 32 + 8 * fq;
        EPI_LOOP_AM { const int row = row0 + ai * 128 + m * 16; const size_t off = (size_t)row * D + col0; const float rs = __builtin_amdgcn_rsqf(sq[row] * (1.0f / D) + EPS);
#pragma unroll
            for (int bj = 0; bj < 2; ++bj) { float pp[8]; unpack8(*(const v4u*)(PP + off + bj * 128), pp);
                f32x4 a = *(const f32x4*)(xio + off + bj * 128), b = *(const f32x4*)(xio + off + bj * 128 + 4);
#pragma unroll
                for (int j = 0; j < 4; ++j) { a[j] += sigmoid_f(acc[ai][bj][m][0][j] * rs) * pp[j]; b[j] += sigmoid_f(acc[ai][bj][m][1][j] * rs) * pp[4 + j]; }
                *(f32x4*)(xio + off + bj * 128) = a; *(f32x4*)(xio + off + bj * 128 + 4) = b; } }
    }
};

__device__ __forceinline__ int dest_row(int mode, int n) {
    if (mode == 0) return n;
    if (mode == 1) return n < 832 ? n : n + 192;
    if (mode == 2) return 256 * (n >> 7) + (n & 127);
    return 256 * (n >> 7) + 128 + (n & 127);
}
__device__ __forceinline__ void transpose_item(const float* W, int Nsrc, bf16* WT, int ldwt, const float* gain, int mode, LAS float* scr, int item, int lane) {
    const int nblk = Nsrc / 32, kb = item / nblk, nb = item % nblk, k0 = 64 * kb, n0 = 32 * nb;
#pragma unroll 8
    for (int i = 0; i < 32; ++i) { const int kk = 2 * i + (lane >> 5); float v = W[(size_t)(k0 + kk) * Nsrc + n0 + (lane & 31)]; if (gain) v *= gain[k0 + kk]; scr[kk * 33 + (lane & 31)] = v; }
    LDS_WAIT(); asm volatile("" ::: "memory");
    const int c = lane & 7; const int r0 = dest_row(mode, n0);
#pragma unroll
    for (int j = 0; j < 4; ++j) { const int n = (lane >> 3) + 8 * j; const LAS float* s = scr + (8 * c) * 33 + n;
        v4u o; o.x = pk2(s[0 * 33], s[1 * 33]); o.y = pk2(s[2 * 33], s[3 * 33]); o.z = pk2(s[4 * 33], s[5 * 33]); o.w = pk2(s[6 * 33], s[7 * 33]);
        *(GAS v4u*)(WT + (size_t)(r0 + n) * ldwt + k0 + 8 * c) = o; }
    LDS_WAIT(); asm volatile("" ::: "memory");
}
struct Args { const void* in[31]; float* out; unsigned char* ws; int ph_lo, ph_hi; };
typedef const __attribute__((address_space(4))) Args* KA;
__device__ __forceinline__ KA get_ka() { KA p = (KA)__builtin_amdgcn_kernarg_segment_ptr(); asm volatile("" : "+s"(p)); return p; }
#define INF(i) ((const float*)args->in[i])

struct Cplx { double re, im; };
__device__ __forceinline__ void s5_disc(KA args, int g, int p, double& lr, double& li, double& dt) {
    lr = fmin((double)INF(11)[g * NP + p], -1e-4); li = (double)INF(12)[g * NP + p]; dt = exp((double)INF(13)[g]);
}
__device__ __forceinline__ Cplx s5_apow(double lr, double li, double dt, int tau) { const double mag = exp(lr * dt * tau), th = li * dt * tau; Cplx r; r.re = mag * cos(th); r.im = mag * sin(th); return r; }
__device__ __forceinline__ Cplx s5_coef(double lr, double li, double dt) {
    const double mag = exp(lr * dt), are = mag * cos(li * dt), aim = mag * sin(li * dt), den = lr * lr + li * li, nre = are - 1.0, nim = aim;
    Cplx r; r.re = (nre * lr + nim * li) / den; r.im = (nim * lr - nre * li) / den; return r;
}
__device__ __forceinline__ void s5_tables(KA args, LAS unsigned char* lds, int gw, int NGW) {
    unsigned char* ws = args->ws; const int tid = fresh_tid(), lane = tid & 63;
    { LAS float* AP = (LAS float*)lds; LAS float* CF = AP + 512;
      for (int item = blockIdx.x; item < NG * 4; item += gridDim.x) {
        const int g = item >> 2, tq = item & 3;
        __syncthreads();
        if (tid < 256) { const int tl = tid >> 6, p = tid & 63; double lr, li, dt; s5_disc(args, g, p, lr, li, dt); const Cplx a = s5_apow(lr, li, dt, 4 * tq + tl); AP[tid * 2] = (float)a.re; AP[tid * 2 + 1] = (float)a.im; }
        else if (tid < 320) { const int p = tid - 256; double lr, li, dt; s5_disc(args, g, p, lr, li, dt); const Cplx c = s5_coef(lr, li, dt); CF[p * 2] = (float)c.re; CF[p * 2 + 1] = (float)c.im; }
        __syncthreads();
        for (int e = 0; e < 2; ++e) { const int idx = tid * 2 + e, tl = idx >> 8, hh = idx & 255, hp = hh >> 4, h = hh & 15, tau = 4 * tq + tl; float acc = 0.f;
            for (int p = 0; p < NP; ++p) { const float cr = INF(16)[(size_t)(g * GH + hp) * NP + p], ci = INF(17)[(size_t)(g * GH + hp) * NP + p], ar = AP[(tl * 64 + p) * 2], ai = AP[(tl * 64 + p) * 2 + 1];
                const float cbr = cr * ar - ci * ai, cbi = cr * ai + ci * ar, br = INF(14)[(size_t)(g * NP + p) * GH + h], bi = INF(15)[(size_t)(g * NP + p) * GH + h], fr_ = CF[p * 2], fi_ = CF[p * 2 + 1];
                const float bbr = fr_ * br - fi_ * bi, bbi = fr_ * bi + fi_ * br; acc += cbr * bbr - cbi * bbi; }
            if (tau == 0 && h == hp) acc += INF(18)[g * GH + hp];
            ((float*)(ws + WS_MT))[(size_t)(g * 16 + tau) * 256 + hh] = acc; }
      }
      __syncthreads(); }
    const int gt = gw * 64 + lane, NT = NGW * 64;
    for (int idx = gt; idx < NG * NP * TC; idx += NT) { const int g = idx >> 10, p = (idx >> 4) & 63, i = idx & 15; double lr, li, dt; s5_disc(args, g, p, lr, li, dt);
        const Cplx a = s5_apow(lr, li, dt, 15 - i), c = s5_coef(lr, li, dt); float vr[16], vi[16];
#pragma unroll
        for (int h = 0; h < GH; ++h) { const double br = INF(14)[(size_t)(g * NP + p) * GH + h], bi = INF(15)[(size_t)(g * NP + p) * GH + h], bbr = c.re * br - c.im * bi, bbi = c.re * bi + c.im * br;
            vr[h] = (float)(a.re * bbr - a.im * bbi); vi[h] = (float)(a.re * bbi + a.im * bbr); }
        bf16* pr = (bf16*)(ws + WS_PALL) + (size_t)(g * 256 + p) * 256 + i * 16; bf16* pi = pr + (size_t)64 * 256; v4u w;
        w.x = pk2(vr[0], vr[1]); w.y = pk2(vr[2], vr[3]); w.z = pk2(vr[4], vr[5]); w.w = pk2(vr[6], vr[7]); *(v4u*)pr = w;
        w.x = pk2(vr[8], vr[9]); w.y = pk2(vr[10], vr[11]); w.z = pk2(vr[12], vr[13]); w.w = pk2(vr[14], vr[15]); *(v4u*)(pr + 8) = w;
        w.x = pk2(vi[0], vi[1]); w.y = pk2(vi[2], vi[3]); w.z = pk2(vi[4], vi[5]); w.w = pk2(vi[6], vi[7]); *(v4u*)pi = w;
        w.x = pk2(vi[8], vi[9]); w.y = pk2(vi[10], vi[11]); w.z = pk2(vi[12], vi[13]); w.w = pk2(vi[14], vi[15]); *(v4u*)(pi + 8) = w; }
    for (int idx = gt; idx < NG * 128 * 32; idx += NT) { const int g = idx >> 12, r = (idx >> 5) & 127, c = idx & 31; *(v4u*)((bf16*)(ws + WS_PALL) + (size_t)(g * 256 + 128 + r) * 256 + c * 8) = (v4u){0u, 0u, 0u, 0u}; }
    for (int idx = gt; idx < NG * TC * NP; idx += NT) { const int g = idx >> 10, j = (idx >> 6) & 15, p = idx & 63; double lr, li, dt; s5_disc(args, g, p, lr, li, dt); const Cplx a = s5_apow(lr, li, dt, j + 1);
        for (int hp = 0; hp < GH; ++hp) { const double cr = INF(16)[(size_t)(g * GH + hp) * NP + p], ci = INF(17)[(size_t)(g * GH + hp) * NP + p];
            bf16* wrow = (bf16*)(ws + WS_WALL) + (size_t)(g * 256 + j * 16 + hp) * ASLD + 256 + p; wrow[0] = (bf16)f2bf((float)(cr * a.re - ci * a.im)); wrow[64] = (bf16)f2bf((float)(-(cr * a.im + ci * a.re))); } }
    for (int idx = gt; idx < NG * NP; idx += NT) { double lr, li, dt; s5_disc(args, idx >> 6, idx & 63, lr, li, dt); const Cplx a = s5_apow(lr, li, dt, 16); ((float*)(ws + WS_A16))[2 * idx] = (float)a.re; ((float*)(ws + WS_A16))[2 * idx + 1] = (float)a.im; }
}
__device__ __forceinline__ void s5_fill_w(KA args, int gw, int NGW) {
    unsigned char* ws = args->ws; const int lane = fresh_tid() & 63; const float* MT = (const float*)(ws + WS_MT);
    for (int idx = gw * 64 + lane; idx < NG * 256 * 32; idx += NGW * 64) { const int g = idx >> 13, n = (idx >> 5) & 255, ck = idx & 31, k0 = ck * 8, i = k0 >> 4, h0 = k0 & 15, j = n >> 4, hp = n & 15;
        v4u w = (v4u){0u, 0u, 0u, 0u};
        if (j >= i) { const float* src = MT + (size_t)(g * 16 + (j - i)) * 256 + hp * 16 + h0; const f32x4 a = *(const f32x4*)src, b = *(const f32x4*)(src + 4);
            w.x = pk2(a[0], a[1]); w.y = pk2(a[2], a[3]); w.z = pk2(b[0], b[1]); w.w = pk2(b[2], b[3]); }
        *(v4u*)((bf16*)(ws + WS_WALL) + (size_t)(g * 256 + n) * ASLD + k0) = w; }
}
__device__ __forceinline__ void s5_carry(KA args, int gw, int NGW) {
    unsigned char* ws = args->ws; const int lane = fresh_tid() & 63; const float* E = (const float*)(ws + WS_E); bf16* AS = (bf16*)(ws + WS_AS);
    for (int task = gw; task < NG * NB; task += NGW) { const int g = task >> 3, b = task & 7, p = lane;
        const float a_re = ((const float*)(ws + WS_A16))[2 * (g * NP + p)], a_im = ((const float*)(ws + WS_A16))[2 * (g * NP + p) + 1];
        float sr = 0.f, si = 0.f; const size_t row0 = (size_t)g * SROWS + b * NCH;
        for (int k0 = 0; k0 < NCH; k0 += 16) { float er[16], ei[16];
#pragma unroll
            for (int k = 0; k < 16; ++k) { er[k] = E[(row0 + k0 + k) * 128 + p]; ei[k] = E[(row0 + k0 + k) * 128 + 64 + p]; }
#pragma unroll
            for (int k = 0; k < 16; ++k) { bf16* o = AS + (row0 + k0 + k) * ASLD + 256 + p; o[0] = (bf16)f2bf(sr); o[64] = (bf16)f2bf(si);
                const float nr = a_re * sr - a_im * si + er[k], ni = a_re * si + a_im * sr + ei[k]; sr = nr; si = ni; } }
    }
}

__device__ __forceinline__ void phase_prologue(KA args, LAS unsigned char* lds, int gw, int NGW, int wave) {
    unsigned char* ws = args->ws; const int lane = fresh_tid() & 63;
    LAS float* scr = (LAS float*)(lds + wave * 16384);
    constexpr int I0 = 32 * 58, I1 = 8 * 48, I2 = 4 * 64, I3 = 16 * 32, I4 = 16 * 64, I5 = 16 * 64, I6 = 32 * 176, I7 = 32 * 176, I8 = 88 * 64, I9 = 32 * 64, I10 = 4 * 64;
    constexpr int NITEMS = I0 + I1 + I2 + I3 + I4 + I5 + I6 + I7 + I8 + I9 + I10;
    for (int it = gw; it < NITEMS; it += NGW) {
        int r = it;
        if (r < I0) { transpose_item(INF(4), 1856, (bf16*)(ws + WS_WIN), 2048, INF(3), 1, scr, r, lane); continue; } r -= I0;
        if (r < I1) { transpose_item(INF(6), 1536, (bf16*)(ws + WS_WUQ), 512, INF(5), 0, scr, r, lane); continue; } r -= I1;
        if (r < I2) { transpose_item(INF(8), 2048, (bf16*)(ws + WS_WUKV), 256, INF(7), 0, scr, r, lane); continue; } r -= I2;
        if (r < I3) { transpose_item(INF(19), 1024, (bf16*)(ws + WS_WGLU), 1024, nullptr, 0, scr, r, lane); continue; } r -= I3;
        if (r < I4) { transpose_item(INF(23), 2048, (bf16*)(ws + WS_WO), 2048, INF(21), 0, scr, r, lane); continue; } r -= I4;
        if (r < I5) { transpose_item(INF(23) + (size_t)1024 * 2048, 2048, (bf16*)(ws + WS_WO) + 1024, 2048, INF(22), 0, scr, r, lane); continue; } r -= I5;
        if (r < I6) { transpose_item(INF(25), FF, (bf16*)(ws + WS_WGU), 2048, INF(24), 2, scr, r, lane); continue; } r -= I6;
        if (r < I7) { transpose_item(INF(26), FF, (bf16*)(ws + WS_WGU), 2048, INF(24), 3, scr, r, lane); continue; } r -= I7;
        if (r < I8) { transpose_item(INF(27), 2048, (bf16*)(ws + WS_WDN), FF, nullptr, 0, scr, r, lane); continue; } r -= I8;
        if (r < I9) { transpose_item(INF(29), 2048, (bf16*)(ws + WS_WPG), 2048, INF(28), 0, scr, r, lane); continue; } r -= I9;
        transpose_item(INF(30), 2048, (bf16*)(ws + WS_WPP), 256, nullptr, 0, scr, r, lane);
    }
    { GAS v4u* z = (GAS v4u*)(ws + WS_WIN + (size_t)832 * 2048 * 2); const int n16 = 192 * 2048 * 2 / 16;
      for (int i = gw * 64 + lane; i < n16; i += NGW * 64) z[i] = (v4u){0u, 0u, 0u, 0u}; }
    for (int r = gw; r < M; r += NGW) {
        const GAS f32x4* xr = (const GAS f32x4*)(INF(0) + (size_t)r * D) + lane;
        f32x4 v[8]; float s = 0.f;
#pragma unroll
        for (int j = 0; j < 8; ++j) { v[j] = xr[64 * j]; s += (v[j][0] * v[j][0] + v[j][1] * v[j][1]) + (v[j][2] * v[j][2] + v[j][3] * v[j][3]); }
        const float rs = 1.0f / sqrtf(wave_sum(s) * (1.0f / D) + EPS);
        GAS v2u* o = (GAS v2u*)((bf16*)(ws + WS_HN) + (size_t)r * D) + lane;
#pragma unroll
        for (int j = 0; j < 8; ++j) { v2u w; w.x = pk2(v[j][0] * rs, v[j][1] * rs); w.y = pk2(v[j][2] * rs, v[j][3] * rs); o[64 * j] = w; }
    }
    { const GAS f32x4* p4 = (const GAS f32x4*)INF(1); GAS v2u* o = (GAS v2u*)(ws + WS_PB); const int n4 = M * PLE / 4;
      for (int i = gw * 64 + lane; i < n4; i += NGW * 64) { const f32x4 v = p4[i]; v2u w; w.x = pk2(v[0], v[1]); w.y = pk2(v[2], v[3]); o[i] = w; } }
    s5_tables(args, lds, gw, NGW);
}

__device__ __forceinline__ void phase_qkv_finalize(KA args, int gw, int NGW) {
    unsigned char* ws = args->ws; const int lane = fresh_tid() & 63;
    const bf16* QRAW = (const bf16*)(ws + WS_QRAW); const bf16* KVRAW = (const bf16*)(ws + WS_KVRAW); const bf16* Z = (const bf16*)(ws + WS_Z);
    bf16* Q = (bf16*)(ws + WS_Q); bf16* K = (bf16*)(ws + WS_K); bf16* V = (bf16*)(ws + WS_V);
    const float* gq = INF(9); const float* gk = INF(10); const int* pos = (const int*)args->in[2];
    const float gq0 = gq[lane], gq1 = gq[64 + lane], gq2 = gq[128 + lane], gk0 = gk[lane], gk1 = gk[64 + lane], gk2 = gk[128 + lane];
    const float invf = exp2f(-(float)(lane & 31) * (13.287712379549449f / 32.0f));
    for (int task = gw; task < M * NH; task += NGW) {
        const int tok = task >> 3, h = task & 7, b = tok / SEQ, t = tok % SEQ;
        const float ang = (float)pos[tok] * invf; float sn, cs; sincosf(ang, &sn, &cs);
        const size_t orow = (size_t)((b * NH + h) * SEQ + t);
        { const bf16* qp = QRAW + (size_t)tok * 1536 + h * DQK;
          float v0 = bf2f(qp[lane]), v1 = bf2f(qp[64 + lane]), v2 = bf2f(qp[128 + lane]);
          const float rs = 1.0f / sqrtf(wave_sum(v0 * v0 + v1 * v1 + v2 * v2) * (1.0f / DQK) + EPS);
          v0 *= rs * gq0; v1 *= rs * gq1; v2 *= rs * gq2;
          const float pr = __shfl_xor(v2, 32); const float r2 = lane < 32 ? v2 * cs - pr * sn : v2 * cs + pr * sn;
          bf16* o = Q + orow * DQK; o[lane] = (bf16)f2bf(v0); o[64 + lane] = (bf16)f2bf(v1); o[128 + lane] = (bf16)f2bf(r2); }
        { const bf16* kp = KVRAW + (size_t)tok * 2048 + h * 256;
          float v0 = bf2f(kp[lane]), v1 = bf2f(kp[64 + lane]), v2 = bf2f(Z[(size_t)tok * ZLD + ZC_KR + lane]);
          const float rs = 1.0f / sqrtf(wave_sum(v0 * v0 + v1 * v1 + v2 * v2) * (1.0f / DQK) + EPS);
          v0 *= rs * gk0; v1 *= rs * gk1; v2 *= rs * gk2;
          const float pr = __shfl_xor(v2, 32); const float r2 = lane < 32 ? v2 * cs - pr * sn : v2 * cs + pr * sn;
          bf16* o = K + orow * DQK; o[lane] = (bf16)f2bf(v0); o[64 + lane] = (bf16)f2bf(v1); o[128 + lane] = (bf16)f2bf(r2);
          bf16* vo = V + orow * DV; vo[lane] = kp[128 + lane]; vo[64 + lane] = kp[192 + lane]; }
    }
}

__device__ __forceinline__ void phase_attn(KA args, char* lds) {
    unsigned char* ws = args->ws;
    const bf16* Q = (const bf16*)(ws + WS_Q); const bf16* K = (const bf16*)(ws + WS_K); const bf16* V = (const bf16*)(ws + WS_V); bf16* OA = (bf16*)(ws + WS_OA);
    for (int L = blockIdx.x; L < NB * NH * 4; L += gridDim.x) {
        const int bh = (L & 7) + 8 * (L >> 5), y = (L >> 3) & 3, b = bh / NH, h = bh % NH;
        for (int pass = 0; pass < 2; ++pass) { const int qb = pass ? 7 - y : y;
            att::attn_block(Q + ((size_t)bh * SEQ + qb * 256) * DQK, K + (size_t)bh * SEQ * DQK, V + (size_t)bh * SEQ * DV,
                            OA + ((size_t)(b * SEQ + qb * 256)) * 1024 + h * DV, 1024, qb * 256, lds); }
    }
}

__device__ __forceinline__ void phase_mix_norm(KA args, int gw, int NGW) {
    unsigned char* ws = args->ws; const int lane = fresh_tid() & 63;
    for (int r = gw; r < M; r += NGW) {
#pragma unroll
        for (int part = 0; part < 2; ++part) {
            const bf16* src = (const bf16*)(ws + (part ? WS_OS : WS_OA)) + (size_t)r * 1024 + lane * 8;
            float a[8], c[8]; unpack8(*(const v4u*)src, a); unpack8(*(const v4u*)(src + 512), c);
            float s = 0.f;
#pragma unroll
            for (int j = 0; j < 8; ++j) s += a[j] * a[j] + c[j] * c[j];
            const float rs = 1.0f / sqrtf(wave_sum(s) * (1.0f / 1024.0f) + EPS);
            bf16* dst = (bf16*)(ws + WS_Z) + (size_t)r * 2048 + part * 1024 + lane * 8;
            v4u w0, w1; w0.x = pk2(a[0] * rs, a[1] * rs); w0.y = pk2(a[2] * rs, a[3] * rs); w0.z = pk2(a[4] * rs, a[5] * rs); w0.w = pk2(a[6] * rs, a[7] * rs);
            w1.x = pk2(c[0] * rs, c[1] * rs); w1.y = pk2(c[2] * rs, c[3] * rs); w1.z = pk2(c[4] * rs, c[5] * rs); w1.w = pk2(c[6] * rs, c[7] * rs);
            *(v4u*)dst = w0; *(v4u*)(dst + 512) = w1;
        }
    }
}

struct GroupOrder {
    int G, c;
    __device__ __forceinline__ bool next(int i, Unit& u) const { const int L = i * G + c; if (L >= NG * 4) return false; u.pm = L; u.pn = L >> 2; return true; }
    __device__ __forceinline__ void a_ready(const Unit&) const {}
    __device__ __forceinline__ void done(const Unit&) const {}
};
template <class Epi> __device__ __forceinline__ void run_gemm_grp(LAS unsigned char* lds, const bf16* A, int lda, const bf16* Bt, int ldb, int K, const Epi& E) {
    pg8::Gemm g{A, Bt, NG * SROWS, NG * 256, K, lda, ldb}; GroupOrder S{(int)gridDim.x, (int)blockIdx.x};
    pg8::gemm_phase<Epi, GroupOrder, PG8_ALIGN, PG8_SP2>(lds, g, S, E);
}
template <class Epi> __device__ __forceinline__ void run_gemm(LAS unsigned char* lds, const bf16* A, int lda, const bf16* Bt, int ldb, int N, int K, const Epi& E) {
    pg8::Gemm g{A, Bt, M, N, K, lda, ldb}; pg8::StaticOrder S; S.init(M, N, (int)gridDim.x, (int)blockIdx.x);
    pg8::gemm_phase<Epi, pg8::StaticOrder, PG8_ALIGN, PG8_SP2>(lds, g, S, E);
}

__global__ void __launch_bounds__(NWAVES * 64, 2) mega_fwd(Args kernel_args) {
    extern __shared__ __attribute__((aligned(16))) unsigned char lds_raw[];
    LAS unsigned char* lds = (LAS unsigned char*)lds_raw;
    volatile LAS unsigned* MISC = (volatile LAS unsigned*)(lds + MISC_OFF);
    const int wave = __builtin_amdgcn_readfirstlane((int)threadIdx.x >> 6);
    const int G = gridDim.x; const int bx = blockIdx.x; const int vcu = (G % 8 == 0) ? (bx % 8) * (G / 8) + bx / 8 : bx;
    const int gw = vcu * NWAVES + wave, NGW = G * NWAVES;
    unsigned char* ws0; int lo, hi; { KA args = get_ka(); ws0 = args->ws; lo = args->ph_lo; hi = args->ph_hi; }
    for (int u = fresh_tid(); u < (LDS_BYTES - 139264) / 4; u += NWAVES * 64) ((LAS unsigned*)(lds + 139264))[u] = 0u;
    __syncthreads();
    XcdBarrier bar; bar.bar = (unsigned*)(ws0 + WS_CTL) + CW_BAR; bar.x = 0; bar.st = nullptr;
    if (hi - lo > 1) bar = xcd_barrier_post((unsigned*)(ws0 + WS_CTL) + CW_BAR, MISC + 8);
#define IN(k) (lo <= (k) && (k) < hi)
#define SEAM(k) do { if (IN(k) && IN((k) + 1)) xcd_barrier(bar); } while (0)
#define PH_BEGIN KA args = get_ka(); unsigned char* ws = args->ws; float* sqq = (float*)(ws + SQ_Q); float* sqkv = (float*)(ws + SQ_KV); float* sqx1 = (float*)(ws + SQ_X1); float* sqx2 = (float*)(ws + SQ_X2); (void)sqq; (void)sqkv; (void)sqx1; (void)sqx2;

    if (IN(0)) { PH_BEGIN phase_prologue(args, lds, gw, NGW, wave); __syncthreads(); }
    SEAM(0);
    if (IN(1)) { PH_BEGIN s5_fill_w(args, gw, NGW);
        EpiZ E{(bf16*)(ws + WS_Z), (bf16*)(ws + WS_AS), sqq, sqkv}; run_gemm(lds, (const bf16*)(ws + WS_HN), D, (const bf16*)(ws + WS_WIN), D, 2048, D, E); }
    SEAM(1);
    if (IN(2)) { PH_BEGIN
        { EpiScale E{(bf16*)(ws + WS_QRAW), 1536, sqq, 1.0f / QL}; run_gemm(lds, (const bf16*)(ws + WS_Z) + ZC_Q, ZLD, (const bf16*)(ws + WS_WUQ), QL, 1536, QL, E); }
        { EpiScale E{(bf16*)(ws + WS_KVRAW), 2048, sqkv, 1.0f / KVL}; run_gemm(lds, (const bf16*)(ws + WS_Z) + ZC_KV, ZLD, (const bf16*)(ws + WS_WUKV), KVL, 2048, KVL, E); }
        { EpiE E{(float*)(ws + WS_E)}; run_gemm_grp(lds, (const bf16*)(ws + WS_AS), ASLD, (const bf16*)(ws + WS_PALL), 256, 256, E); }
    }
    SEAM(2);
    if (IN(3)) { PH_BEGIN s5_carry(args, gw, NGW); phase_qkv_finalize(args, gw, NGW); }
    SEAM(3);
    if (IN(4)) { PH_BEGIN
        { EpiY E{(bf16*)(ws + WS_YG)}; run_gemm_grp(lds, (const bf16*)(ws + WS_AS), ASLD, (const bf16*)(ws + WS_WALL), ASLD, ASLD, E); }
        phase_attn(args, (char*)lds_raw); __syncthreads();
    }
    SEAM(4);
    if (IN(5)) { PH_BEGIN EpiGlu E{(const bf16*)(ws + WS_YG), INF(20), (bf16*)(ws + WS_OS)}; run_gemm(lds, (const bf16*)(ws + WS_YG), SSMW, (const bf16*)(ws + WS_WGLU), SSMW, SSMW, SSMW, E); }
    SEAM(5);
    if (IN(6)) { PH_BEGIN phase_mix_norm(args, gw, NGW); }
    SEAM(6);
    if (IN(7)) { PH_BEGIN EpiResid E{INF(0), args->out, (bf16*)(ws + WS_HN), sqx1}; run_gemm(lds, (const bf16*)(ws + WS_Z), D, (const bf16*)(ws + WS_WO), D, D, D, E); }
    SEAM(7);
    if (IN(8)) { PH_BEGIN
        { EpiGateUp E{(bf16*)(ws + WS_H), sqx1}; run_gemm(lds, (const bf16*)(ws + WS_HN), D, (const bf16*)(ws + WS_WGU), D, 2 * FF, D, E); }
        { EpiPlain E{(bf16*)(ws + WS_PP), D}; run_gemm(lds, (const bf16*)(ws + WS_PB), PLE, (const bf16*)(ws + WS_WPP), PLE, D, PLE, E); }
    }
    SEAM(8);
    if (IN(9)) { PH_BEGIN EpiResid E{args->out, args->out, (bf16*)(ws + WS_HN), sqx2}; run_gemm(lds, (const bf16*)(ws + WS_H), FF, (const bf16*)(ws + WS_WDN), FF, D, FF, E); }
    SEAM(9);
    if (IN(10)) { PH_BEGIN EpiPle E{args->out, (const bf16*)(ws + WS_PP), sqx2}; run_gemm(lds, (const bf16*)(ws + WS_HN), D, (const bf16*)(ws + WS_WPG), D, D, D, E); }
#undef IN
#undef SEAM
}

extern "C" void kernel_launch(void* const* d_in, const int* in_sizes, int n_in, void* d_out, int out_size, void* d_ws, size_t ws_size, hipStream_t stream) {
    static int grid = 0;
    if (grid == 0) {
        if (n_in != 31 || out_size != M * D || ws_size < WS_END) { fprintf(stderr, "kernel_launch: unexpected shapes (n_in %d, out %d, ws %zu)\n", n_in, out_size, ws_size); grid = -1; return; }
        int dev = 0, cus = 0;
        if (hipGetDevice(&dev) != hipSuccess || hipDeviceGetAttribute(&cus, hipDeviceAttributeMultiprocessorCount, dev) != hipSuccess) { grid = -1; return; }
        if (hipFuncSetAttribute((const void*)mega_fwd, hipFuncAttributeMaxDynamicSharedMemorySize, LDS_BYTES) != hipSuccess) { fprintf(stderr, "kernel_launch: hipFuncSetAttribute failed\n"); grid = -1; return; }
        int per_cu = 0;
        if (hipOccupancyMaxActiveBlocksPerMultiprocessor(&per_cu, (const void*)mega_fwd, NWAVES * 64, LDS_BYTES) != hipSuccess || per_cu < 1) fprintf(stderr, "kernel_launch: occupancy query says %d blocks/CU\n", per_cu);
        (void)hipGetLastError();
        grid = cus > 0 ? cus : 256;
    }
    if (grid < 0) return;
    (void)hipMemsetAsync((char*)d_ws + WS_CTL, 0, CTL_ZERO_BYTES, stream);
    Args a{};
    for (int i = 0; i < 31; ++i) a.in[i] = d_in[i];
    a.out = (float*)d_out; a.ws = (unsigned char*)d_ws;
    constexpr int NL = MK_N_LAUNCHES;
    for (int li = 0; li < NL; ++li) {
        a.ph_lo = (NL == 1) ? 0 : li; a.ph_hi = (NL == 1) ? NPHASES : li + 1;
        hipLaunchKernelGGL(mega_fwd, dim3(grid), dim3(NWAVES * 64), LDS_BYTES, stream, a);
    }
}
```

```cpp
#include <hip/hip_runtime.h>
#include <cstdio>
#include <cstdint>
namespace pg8 {
#define PG8_LAS __attribute__((address_space(3)))
typedef unsigned short bf16_t;
typedef short bf16x8 __attribute__((ext_vector_type(8)));
typedef float f32x4 __attribute__((ext_vector_type(4)));
typedef unsigned u32x4 __attribute__((ext_vector_type(4)));
constexpr int BM = 256, BK = 64, HALF = 128, HTB = HALF * BK * 2  , STAGE_BYTES = 8 * HTB, NXCD = 8, WGM = 2;

__host__ __device__ __forceinline__ int lds_byte(int r, int c) { const int st = (r >> 4) * 2 + (c >> 5), rr = r & 15, cc = c & 31, ob = rr * 64 + cc * 2; return st * 1024 + (ob ^ (((ob >> 9) & 1) << 5)); }
__host__ __device__ __forceinline__ void stage_rc(int b, int& R, int& C) { const int st = b / 1024, sb = b % 1024, swz = sb ^ (((sb >> 9) & 1) << 5); R = (st >> 1) * 16 + swz / 64; C = (st & 1) * 32 + (swz % 64) / 2; }
__host__ __device__ __forceinline__ int perm32(int rho) { const int n = rho >> 4, i = rho & 15; return 8 * (i >> 2) + 4 * n + (i & 3); }

struct Unit { int pm, pn; };
struct Gemm { const bf16_t* A; const bf16_t* Bt; int M, N, K, lda, ldb; };

struct StaticOrder {
    int nM, nN, nwg, G, c;
    __host__ __device__ void init(int M, int N, int G_, int c_) { nM = M / BM; nN = N / BM; nwg = nM * nN; G = G_; c = c_; }
    __host__ __device__ bool next(int i, Unit& u) const {
        const long L = (long)i * G + c; if (L >= nwg) return false;
        int wgid = (int)L; { const int q = nwg / NXCD, r = nwg % NXCD, xcd = wgid % NXCD, off = wgid / NXCD; wgid = (xcd < r ? xcd * (q + 1) : r * (q + 1) + (xcd - r) * q) + off; }
        const int nig = WGM * nN, gid = wgid / nig, fm = gid * WGM, gsz = (nM - fm) < WGM ? (nM - fm) : WGM;
        u.pm = fm + ((wgid % nig) % gsz); u.pn = (wgid % nig) / gsz; return true;
    }
    __device__ __forceinline__ void a_ready(const Unit&) const {}
    __device__ __forceinline__ void done(const Unit&) const {}
};

__device__ __forceinline__ unsigned cvt_pk_bf16(float lo, float hi) { unsigned r; asm volatile("v_cvt_pk_bf16_f32 %0, %1, %2" : "=v"(r) : "v"(lo), "v"(hi)); return r; }
typedef float f32x2 __attribute__((ext_vector_type(2)));
template <class Epi, class Sched, bool ALIGN_EPI = false, bool SP2 = false>
__device__ __forceinline__ void gemm_phase(PG8_LAS unsigned char* lds, const Gemm g, const Sched& S, const Epi& E) {
    int tid_ = threadIdx.x; asm volatile("" : "+v"(tid_));
    const int tid = tid_, wid = __builtin_amdgcn_readfirstlane(tid >> 6), lane = tid & 63, wr = wid >> 2, wc = wid & 3, fr = lane & 15, fq = lane >> 4;
    const int K = g.K, nt = K / BK;
    unsigned voffA[2], voffB[2];
#pragma unroll
    for (int i = 0; i < 2; ++i) { int R, C; stage_rc(tid * 16 + i * 8192, R, C); const int Rb = Epi::PERM ? ((R & ~31) + perm32(R & 31)) : R;
        voffA[i] = (unsigned)(R * g.lda + C) * 2u; voffB[i] = (unsigned)(Rb * g.ldb + C) * 2u; }
    const size_t kstep = (size_t)(BK * 2);
    const size_t hstepA = (size_t)HALF * g.lda * 2, hstepB = (size_t)HALF * g.ldb * 2;
    const size_t tstepA = 2 * hstepA, tstepB = 2 * hstepB;
    const unsigned ldsw = (unsigned)wid * 1024u;
    const int aoff = lds_byte(wr * 64 + fr, fq * 8), boff = lds_byte(wc * 32 + fr, fq * 8);
#define PG8_SA(b, h) (((b) * 2 + (h)) * HTB)
#define PG8_SB(b, h) ((4 + (b) * 2 + (h)) * HTB)
#define PG8_STAGE(bufoff, gbase, voff) do { _Pragma("unroll") for (int _i = 0; _i < 2; ++_i) \
        __builtin_amdgcn_global_load_lds((const unsigned*)((const char*)(gbase) + (voff)[_i]), (PG8_LAS unsigned*)(lds + (bufoff) + ldsw + _i * 8192), 16, 0, 0); } while (0)
#define PG8_LDA(dst, b, h) do { _Pragma("unroll") for (int m = 0; m < 4; ++m) _Pragma("unroll") for (int k = 0; k < 2; ++k) dst[m][k] = *(const PG8_LAS bf16x8*)(lds + PG8_SA(b, h) + aoff + m * 2048 + k * 1024); } while (0)
#define PG8_LDB(dst, b, h) do { _Pragma("unroll") for (int n = 0; n < 2; ++n) _Pragma("unroll") for (int k = 0; k < 2; ++k) dst[n][k] = *(const PG8_LAS bf16x8*)(lds + PG8_SB(b, h) + boff + n * 2048 + k * 1024); } while (0)
#define PG8_MMA(ai, bj, At, Bt) do { __builtin_amdgcn_s_setprio(1); _Pragma("unroll") for (int m = 0; m < 4; ++m) _Pragma("unroll") for (int n = 0; n < 2; ++n) _Pragma("unroll") for (int k = 0; k < 2; ++k) \
        acc[ai][bj][m][n] = __builtin_amdgcn_mfma_f32_16x16x32_bf16(Bt[n][k], At[m][k], acc[ai][bj][m][n], 0, 0, 0); __builtin_amdgcn_s_setprio(0); } while (0)
#define PG8_WAIT_V(n) asm volatile("s_waitcnt vmcnt(" #n ")" ::: "memory")
#define PG8_WAIT_L(n) asm volatile("s_waitcnt lgkmcnt(" #n ")" ::: "memory")
#define PG8_BAR __builtin_amdgcn_s_barrier()
#define PG8_SCHED __builtin_amdgcn_sched_barrier(0)
    Unit cur, nxt; int ui = 0;
    if (!S.next(0, cur)) return;
    f32x4 acc[2][2][4][2];
#pragma unroll
    for (int a = 0; a < 2; ++a)
#pragma unroll
        for (int b = 0; b < 2; ++b)
#pragma unroll
            for (int m = 0; m < 4; ++m)
#pragma unroll
                for (int n = 0; n < 2; ++n) acc[a][b][m][n] = (f32x4){0.f, 0.f, 0.f, 0.f};
    bf16x8 At[4][2], B0[2][2], B1[2][2];
    const char* cA = (const char*)g.A + (size_t)cur.pm * tstepA; const char* cB = (const char*)g.Bt + (size_t)cur.pn * tstepB;
    S.a_ready(cur);
    if constexpr (SP2) {
        PG8_STAGE(PG8_SB(0, 0), cB, voffB); PG8_STAGE(PG8_SB(0, 1), cB + hstepB, voffB); PG8_STAGE(PG8_SA(0, 0), cA, voffA); PG8_STAGE(PG8_SA(0, 1), cA + hstepA, voffA);
        if (wr == 1) PG8_BAR;
        PG8_WAIT_V(2); PG8_BAR;
        PG8_STAGE(PG8_SB(1, 0), cB + kstep, voffB); PG8_STAGE(PG8_SA(1, 0), cA + kstep, voffA); PG8_STAGE(PG8_SB(1, 1), cB + hstepB + kstep, voffB);
        PG8_WAIT_V(6); PG8_BAR;
    } else {
        PG8_STAGE(PG8_SB(0, 0), cB, voffB); PG8_STAGE(PG8_SA(0, 0), cA, voffA); PG8_STAGE(PG8_SB(0, 1), cB + hstepB, voffB); PG8_STAGE(PG8_SA(0, 1), cA + hstepA, voffA);
        if (wr == 1) PG8_BAR;
        PG8_WAIT_V(4); PG8_BAR;
        PG8_STAGE(PG8_SB(1, 0), cB + kstep, voffB); PG8_STAGE(PG8_SA(1, 0), cA + kstep, voffA); PG8_STAGE(PG8_SB(1, 1), cB + hstepB + kstep, voffB);
        PG8_WAIT_V(6); PG8_BAR;
    }
    for (;;) {
        const bool has_next = S.next(ui + 1, nxt);
        const char* nA = has_next ? (const char*)g.A + (size_t)nxt.pm * tstepA : cA; const char* nB = has_next ? (const char*)g.Bt + (size_t)nxt.pn * tstepB : cB;
        for (int t = 0; t < nt; t += 2) {
            const bool last = (t == nt - 2);
            if constexpr (Epi::MIDK > 0) { if (t == Epi::MIDK) E.mid(acc, cur, wr, wc, fr, fq); }
            const char* a1 = cA + (size_t)(t + 1) * kstep;
            const char* a2 = last ? nA : cA + (size_t)(t + 2) * kstep; const char* b2 = last ? nB : cB + (size_t)(t + 2) * kstep;
            const char* a3 = a2 + kstep; const char* b3 = b2 + kstep;
            if (last && has_next) S.a_ready(nxt);
            if constexpr (SP2) {
            PG8_LDB(B0, 0, 0); PG8_LDB(B1, 0, 1); PG8_SCHED; PG8_LDA(At, 0, 0); PG8_STAGE(PG8_SA(1, 1), a1 + hstepA, voffA);
            PG8_WAIT_V(8); PG8_WAIT_L(0); PG8_BAR; PG8_MMA(0, 0, At, B0); PG8_MMA(0, 1, At, B1); PG8_BAR; PG8_SCHED;
            PG8_LDA(At, 0, 1); PG8_STAGE(PG8_SB(0, 0), b2, voffB); PG8_STAGE(PG8_SB(0, 1), b2 + hstepB, voffB); PG8_STAGE(PG8_SA(0, 0), a2, voffA);
            PG8_WAIT_V(8); PG8_WAIT_L(0); PG8_BAR; PG8_MMA(1, 0, At, B0); PG8_MMA(1, 1, At, B1); PG8_BAR; PG8_SCHED;
            PG8_LDB(B0, 1, 0); PG8_LDB(B1, 1, 1); PG8_SCHED; PG8_LDA(At, 1, 0); PG8_STAGE(PG8_SA(0, 1), a2 + hstepA, voffA);
            PG8_WAIT_V(8); PG8_WAIT_L(0); PG8_BAR; PG8_MMA(0, 0, At, B0); PG8_MMA(0, 1, At, B1); PG8_BAR; PG8_SCHED;
            PG8_LDA(At, 1, 1); PG8_STAGE(PG8_SB(1, 0), b3, voffB); PG8_STAGE(PG8_SB(1, 1), b3 + hstepB, voffB); PG8_STAGE(PG8_SA(1, 0), a3, voffA);
            PG8_WAIT_V(8); PG8_WAIT_L(0); PG8_BAR; PG8_MMA(1, 0, At, B0); PG8_MMA(1, 1, At, B1); PG8_BAR; PG8_SCHED;
            } else {
            PG8_LDB(B0, 0, 0); PG8_SCHED; PG8_LDA(At, 0, 0); PG8_STAGE(PG8_SA(1, 1), a1 + hstepA, voffA);
            PG8_WAIT_L(8); PG8_BAR; PG8_WAIT_L(0); PG8_MMA(0, 0, At, B0); PG8_BAR; PG8_SCHED;
            PG8_LDB(B1, 0, 1); PG8_STAGE(PG8_SB(0, 0), b2, voffB);
            PG8_BAR; PG8_WAIT_L(0); PG8_MMA(0, 1, At, B1); PG8_BAR;
            PG8_LDA(At, 0, 1); PG8_STAGE(PG8_SA(0, 0), a2, voffA);
            PG8_BAR; PG8_WAIT_L(0); PG8_MMA(1, 0, At, B0); PG8_BAR; PG8_SCHED;
            PG8_STAGE(PG8_SB(0, 1), b2 + hstepB, voffB);
            PG8_WAIT_V(6); PG8_BAR; PG8_MMA(1, 1, At, B1); PG8_BAR;
            PG8_LDB(B0, 1, 0); PG8_SCHED; PG8_LDA(At, 1, 0); PG8_STAGE(PG8_SA(0, 1), a2 + hstepA, voffA);
            PG8_WAIT_L(8); PG8_BAR; PG8_WAIT_L(0); PG8_MMA(0, 0, At, B0); PG8_BAR; PG8_SCHED;
            PG8_LDB(B1, 1, 1); PG8_STAGE(PG8_SB(1, 0), b3, voffB);
            PG8_BAR; PG8_WAIT_L(0); PG8_MMA(0, 1, At, B1); PG8_BAR;
            PG8_LDA(At, 1, 1); PG8_STAGE(PG8_SA(1, 0), a3, voffA);
            PG8_BAR; PG8_WAIT_L(0); PG8_MMA(1, 0, At, B0); PG8_BAR; PG8_SCHED;
            PG8_STAGE(PG8_SB(1, 1), b3 + hstepB, voffB);
            PG8_WAIT_V(6); PG8_BAR; PG8_MMA(1, 1, At, B1); PG8_BAR;
            }
        }
        if constexpr (ALIGN_EPI) { if (wr == 0) PG8_BAR; }
        if constexpr (!Epi::AFTER_DRAIN) { E(acc, cur, wr, wc, fr, fq); S.done(cur); }
        if (!has_next) break;
        { f32x4 zz; asm volatile("v_mov_b32 %0, 0\n\tv_mov_b32 %1, 0\n\tv_mov_b32 %2, 0\n\tv_mov_b32 %3, 0\n\ts_nop 3" : "=v"(zz[0]), "=v"(zz[1]), "=v"(zz[2]), "=v"(zz[3]));
#pragma unroll
        for (int a = 0; a < 2; ++a)
#pragma unroll
            for (int b = 0; b < 2; ++b)
#pragma unroll
                for (int m = 0; m < 4; ++m)
#pragma unroll
                    for (int n = 0; n < 2; ++n) asm volatile("v_mfma_f32_16x16x32_bf16 %0, %1, %1, 0" : "=&v"(acc[a][b][m][n]) : "v"(zz)); }
        cur = nxt; cA = nA; cB = nB; ++ui;
        if constexpr (ALIGN_EPI) { if (wr == 1) PG8_BAR; }
    }
    PG8_WAIT_V(0);
    if constexpr (!ALIGN_EPI) { if (wr == 0) PG8_BAR; }
    PG8_BAR;
    if constexpr (Epi::AFTER_DRAIN) { E.fused(acc, cur, wr, wc, fr, fq, lds, wid, lane); S.done(cur); }
#undef PG8_SA
#undef PG8_SB
#undef PG8_STAGE
#undef PG8_LDA
#undef PG8_LDB
#undef PG8_MMA
#undef PG8_WAIT_V
#undef PG8_WAIT_L
#undef PG8_BAR
#undef PG8_SCHED
}
}

namespace att {
typedef short bf16x8 __attribute__((ext_vector_type(8)));
typedef short s16x4 __attribute__((ext_vector_type(4)));
typedef float f32x16 __attribute__((ext_vector_type(16)));
typedef unsigned u32x4 __attribute__((ext_vector_type(4)));
typedef unsigned short bf16;
constexpr int DQK = 192, DV = 128, KROW = 384, SHM_K = 64 * KROW, SHM_V = 64 * DV * 2;
constexpr int V_OFF = 0, K_OFF = 2 * SHM_V, WS_OFF = 2 * SHM_V + 2 * SHM_K, ATT_LDS = WS_OFF + 8 * 64 * 4;
constexpr float SCALE = 0.07216878364870322f, THR = 8.f;
#define ATT_KSWZ(row, colB) ((row) * 384 + ((colB) ^ (((row) & 7) << 4)))
#define ATT_SBAR() __builtin_amdgcn_sched_barrier(0)
__device__ __forceinline__ int v_st(int k, int c) { const int kk = (k & ~0xC) | ((k & 4) << 1) | ((k & 8) >> 1); return ((kk >> 3) * 4 + (c >> 5)) * 512 + ((kk & 7) * 32 + (c & 31)) * 2; }
__device__ __forceinline__ int v_rd_base(int lane) { return ((lane & 3) << 3) | (((lane >> 2) & 3) << 6) | (((lane >> 4) & 1) << 5) | (((lane >> 5) & 1) << 8); }
constexpr int v_rd_off(int d0, int ks, int half) { return d0 * 512 + ks * 4096 + half * 2048; }
__device__ __forceinline__ int crow(int r, int hi) { return (r & 3) + 8 * (r >> 2) + 4 * hi; }
__device__ __forceinline__ unsigned cvtpk(float lo, float hi) { unsigned r; asm volatile("v_cvt_pk_bf16_f32 %0, %1, %2" : "=v"(r) : "v"(lo), "v"(hi)); return r; }
__device__ __forceinline__ void mask_tile(f32x16& p0, f32x16& p1, int dq) {
    const float NEG = -__builtin_inff();
#pragma unroll
    for (int r = 0; r < 16; ++r) { const int c = (r & 3) + 8 * (r >> 2); if (dq - c < 0) p0[r] = NEG; if (dq - c - 32 < 0) p1[r] = NEG; }
}
__device__ __forceinline__ void partialSM(f32x16& p0, f32x16& p1, float& m_reg, float& mn, float& alpha) {
    float pmax = p0[0];
#pragma unroll
    for (int r = 1; r < 16; ++r) pmax = fmaxf(pmax, p0[r]);
#pragma unroll
    for (int r = 0; r < 16; ++r) pmax = fmaxf(pmax, p1[r]);
    { auto rr = __builtin_amdgcn_permlane32_swap(__float_as_uint(pmax), __float_as_uint(pmax), false, false);
      pmax = fmaxf(__uint_as_float(rr[0]), __uint_as_float(rr[1])); }
    constexpr float C2 = 1.4426950408889634f * SCALE;
    if (__builtin_expect(__all((pmax - m_reg) * SCALE <= THR), 1)) { mn = m_reg; alpha = 1.f; }
    else { mn = fmaxf(m_reg, pmax); alpha = __builtin_amdgcn_exp2f((m_reg - mn) * C2); m_reg = mn; }
    const float mnL = -mn * C2;
#pragma unroll
    for (int r = 0; r < 16; ++r) p0[r] = fmaf(p0[r], C2, mnL);
#pragma unroll
    for (int r = 0; r < 16; ++r) p1[r] = fmaf(p1[r], C2, mnL);
#pragma unroll
    for (int r = 0; r < 16; ++r) p0[r] = __builtin_amdgcn_exp2f(p0[r]);
}
__device__ __forceinline__ void finishSM(f32x16& p0, f32x16& p1, float alpha, float& l_reg, bf16x8& pa0, bf16x8& pa1, bf16x8& pa2, bf16x8& pa3) {
#pragma unroll
    for (int r = 0; r < 16; ++r) p1[r] = __builtin_amdgcn_exp2f(p1[r]);
    float ps = 0;
#pragma unroll
    for (int r = 0; r < 16; ++r) ps += p0[r];
#pragma unroll
    for (int r = 0; r < 16; ++r) ps += p1[r];
    { auto rr = __builtin_amdgcn_permlane32_swap(__float_as_uint(ps), __float_as_uint(ps), false, false);
      ps = __uint_as_float(rr[0]) + __uint_as_float(rr[1]); }
    l_reg = l_reg * alpha + ps;
#define ATT_PK4(P, B_, OUT) do { unsigned a0 = cvtpk(P[B_+0], P[B_+1]), a1 = cvtpk(P[B_+2], P[B_+3]);                          \
        unsigned b0 = cvtpk(P[B_+4], P[B_+5]), b1 = cvtpk(P[B_+6], P[B_+7]);                                             \
        auto r0 = __builtin_amdgcn_permlane32_swap(a0, b0, false, false); auto r1 = __builtin_amdgcn_permlane32_swap(a1, b1, false, false); \
        u32x4 w = {r0[0], r1[0], r0[1], r1[1]}; OUT = *reinterpret_cast<bf16x8*>(&w); } while (0)
    ATT_PK4(p0, 0, pa0); ATT_PK4(p0, 8, pa1); ATT_PK4(p1, 0, pa2); ATT_PK4(p1, 8, pa3);
#undef ATT_PK4
}
template <int KB>
__device__ __forceinline__ void qkt(f32x16& p0, f32x16& p1, const char* K_lds, int r32, int hi, const bf16x8* qr) {
    p0 = f32x16{}; p1 = f32x16{};
    const char* kb[4];
#pragma unroll
    for (int dd = 0; dd < 4; ++dd) kb[dd] = K_lds + KB * SHM_K + ATT_KSWZ(r32, (dd * 16 + hi * 8) * 2);
#pragma unroll
    for (int d0 = 0; d0 < 12; ++d0) { const char* a = kb[d0 & 3] + (d0 >> 2) * 128;
        bf16x8 b0 = *reinterpret_cast<const bf16x8*>(a);
        bf16x8 b1 = *reinterpret_cast<const bf16x8*>(a + 32 * KROW);
        p0 = __builtin_amdgcn_mfma_f32_32x32x16_bf16(b0, qr[d0], p0, 0, 0, 0);
        p1 = __builtin_amdgcn_mfma_f32_32x32x16_bf16(b1, qr[d0], p1, 0, 0, 0); }
}
template <int VB>
__device__ __forceinline__ void pv_tile(f32x16* o, int vb0, bf16x8 pa0, bf16x8 pa1, bf16x8 pa2, bf16x8 pa3) {
#define ATT_TRRD(dst, off) asm volatile("ds_read_b64_tr_b16 %0, %1 offset:%2" : "=&v"(dst) : "v"(vb0), "i"(off) : "memory")
#define ATT_PV_D0(d0) do { s16x4 l0, l1, l2, l3, h0, h1, h2, h3; constexpr int b_ = V_OFF + VB * SHM_V + v_rd_off(d0, 0, 0); \
        ATT_TRRD(l0, b_); ATT_TRRD(h0, b_ + 2048); ATT_TRRD(l1, b_ + 4096); ATT_TRRD(h1, b_ + 6144); ATT_TRRD(l2, b_ + 8192); ATT_TRRD(h2, b_ + 10240); ATT_TRRD(l3, b_ + 12288); ATT_TRRD(h3, b_ + 14336); \
        asm volatile("s_waitcnt lgkmcnt(0)" ::: "memory"); ATT_SBAR();   \
        o[d0] = __builtin_amdgcn_mfma_f32_32x32x16_bf16(pa0, (bf16x8){l0[0], l0[1], l0[2], l0[3], h0[0], h0[1], h0[2], h0[3]}, o[d0], 0, 0, 0);   \
        o[d0] = __builtin_amdgcn_mfma_f32_32x32x16_bf16(pa1, (bf16x8){l1[0], l1[1], l1[2], l1[3], h1[0], h1[1], h1[2], h1[3]}, o[d0], 0, 0, 0);   \
        o[d0] = __builtin_amdgcn_mfma_f32_32x32x16_bf16(pa2, (bf16x8){l2[0], l2[1], l2[2], l2[3], h2[0], h2[1], h2[2], h2[3]}, o[d0], 0, 0, 0);   \
        o[d0] = __builtin_amdgcn_mfma_f32_32x32x16_bf16(pa3, (bf16x8){l3[0], l3[1], l3[2], l3[3], h3[0], h3[1], h3[2], h3[3]}, o[d0], 0, 0, 0); } while (0)
    ATT_PV_D0(0); ATT_PV_D0(1); ATT_PV_D0(2); ATT_PV_D0(3);
#undef ATT_PV_D0
#undef ATT_TRRD
}

__device__ __forceinline__ void attn_block(const bf16* Qb, const bf16* Kh, const bf16* Vh, bf16* Ob, int ldo, float* sqrow  , int P0, char* lds) {
    const int tid = threadIdx.x, wid = __builtin_amdgcn_readfirstlane(tid >> 6), lane = tid & 63, r32 = lane & 31, hi = lane >> 5;
    const int NT = (P0 + 256) / 64;
    const int qlo = P0 + wid * 32, qm = qlo + r32 - 4 * hi;
    char* V_lds = lds + V_OFF; char* K_lds = lds + K_OFF;
    float* wsf = (float*)(lds + WS_OFF) + wid * 64; float* li_l = wsf; float* al_l = wsf + 32;
    float m_reg = -1e30f, l_reg = 0.f; f32x16 o[4] = {};
    bf16x8 qr[12];
#pragma unroll
    for (int d0 = 0; d0 < 12; ++d0) qr[d0] = *reinterpret_cast<const bf16x8*>((const char*)Qb + (unsigned)(((wid * 32 + r32) * DQK + hi * 8) * 2) + d0 * 32);
    const int krow = tid >> 3, kws0 = ATT_KSWZ(krow, (tid & 7) * 16);
    const int sr = tid >> 4, sc = (tid & 15) * 8, vst0 = v_st(sr, sc);
    const int vb0 = (int)(uintptr_t)V_lds + v_rd_base(lane);
    bf16x8 st_k0, st_k1, st_k2, st_v0, st_v1;
    const unsigned kgo = (unsigned)(krow * KROW + (tid & 7) * 16), vgo = (unsigned)((sr * DV + sc) * 2);
#define ATT_SLOAD(t) do { const char* kp_ = (const char*)Kh + (size_t)(t) * (64 * KROW) + kgo; const char* vp_ = (const char*)Vh + (size_t)(t) * (64 * DV * 2) + vgo; \
        st_k0 = *reinterpret_cast<const bf16x8*>(kp_); st_k1 = *reinterpret_cast<const bf16x8*>(kp_ + 128); st_k2 = *reinterpret_cast<const bf16x8*>(kp_ + 256); \
        st_v0 = *reinterpret_cast<const bf16x8*>(vp_); st_v1 = *reinterpret_cast<const bf16x8*>(vp_ + 32 * DV * 2); } while (0)
#define ATT_SWRITE(bf) do { *(bf16x8*)(K_lds + (bf) * SHM_K + kws0) = st_k0; *(bf16x8*)(K_lds + (bf) * SHM_K + kws0 + 128) = st_k1; *(bf16x8*)(K_lds + (bf) * SHM_K + kws0 + 256) = st_k2; \
        *(bf16x8*)(V_lds + (bf) * SHM_V + vst0) = st_v0; *(bf16x8*)(V_lds + (bf) * SHM_V + vst0 + 8192) = st_v1; } while (0)
#define ATT_RESC(a) do { if (__any((a) < 1.f)) { if (hi == 0) al_l[r32] = (a); asm volatile("s_waitcnt lgkmcnt(0)" ::: "memory");              \
        _Pragma("unroll") for (int d_ = 0; d_ < 4; ++d_) _Pragma("unroll") for (int r = 0; r < 16; ++r) o[d_][r] *= al_l[crow(r, hi)]; } } while (0)
    ATT_SLOAD(0); ATT_SWRITE(0);
    __syncthreads();
    f32x16 p0, p1; float mn, alpha; bf16x8 pa0, pa1, pa2, pa3;
#define ATT_STEP(BF, t) do { \
        if ((t) + 1 < NT) ATT_SLOAD((t) + 1); \
        ATT_SBAR(); qkt<BF>(p0, p1, K_lds, r32, hi, qr); \
        { const int kb_ = (t) * 64; if (kb_ + 63 > qlo) mask_tile(p0, p1, qm - kb_); } \
        partialSM(p0, p1, m_reg, mn, alpha); ATT_RESC(alpha); \
        finishSM(p0, p1, alpha, l_reg, pa0, pa1, pa2, pa3); ATT_SBAR(); \
        pv_tile<BF>(o, vb0, pa0, pa1, pa2, pa3); \
        if ((t) + 1 < NT) ATT_SWRITE((BF) ^ 1); \
        __syncthreads(); } while (0)
    for (int t = 0; t < NT; t += 2) { ATT_STEP(0, t); ATT_STEP(1, t + 1); }
    if (hi == 0) li_l[r32] = l_reg; asm volatile("s_waitcnt lgkmcnt(0)" ::: "memory");
    float rli[16];
#pragma unroll
    for (int r = 0; r < 16; ++r) rli[r] = __builtin_amdgcn_rcpf(li_l[crow(r, hi)]);
    char* Ow = (char*)Ob + (size_t)(wid * 32) * ldo * 2; const unsigned olo = (unsigned)((4 * hi * ldo + r32) * 2);
#pragma unroll
    for (int r = 0; r < 16; ++r) { const int orow = (r & 3) + 8 * (r >> 2);
        float s2 = 0.f;
#pragma unroll
        for (int d0 = 0; d0 < 4; ++d0) { const float v = o[d0][r] * rli[r]; const float vn = __shfl_xor(v, 1); s2 += v * v;
            if ((r32 & 1) == 0) *(unsigned*)(Ow + olo + (unsigned)(orow * ldo * 2 + d0 * 64)) = cvtpk(v, vn); }
        s2 += __shfl_xor(s2, 1); s2 += __shfl_xor(s2, 2); s2 += __shfl_xor(s2, 4); s2 += __shfl_xor(s2, 8); s2 += __shfl_xor(s2, 16);
        if (r32 == 0) atomicAdd(sqrow + wid * 32 + orow + 4 * hi, s2); }
    __syncthreads();
#undef ATT_SLOAD
#undef ATT_SWRITE
#undef ATT_RESC
#undef ATT_STEP
}
}

#ifndef PG8_SP2
#define PG8_SP2 true
#endif
#ifndef PG8_ALIGN
#define PG8_ALIGN true
#endif
#ifndef MK_N_LAUNCHES
#define MK_N_LAUNCHES 1
#endif

constexpr int M = 16384, SEQ = 2048, NB = 8, D = 2048, NH = 8, DQK = 192, DV = 128;
constexpr int QL = 512, KVL = 256, NG = 64, GH = 16, NP = 64, FF = 5632, PLE = 256, SSMW = 1024;
constexpr float EPS = 1e-6f;
constexpr int ZC_Q = 0, ZC_KV = 512, ZC_KR = 768, ZLD = 1024;
constexpr int TC = 16, NCH = SEQ / TC, ASLD = 384, SROWS = NB * NCH;
constexpr int NPHASES = 8;

constexpr size_t MiB = 1u << 20;
constexpr size_t WS_CTL = 0, CTL_ZERO_BYTES = 1 * MiB;
constexpr int CW_BAR = 4096, CW_GBAR = 163840;
constexpr int CW_BAR_UNUSED = 0;
constexpr size_t SQ_Q = 65536 * 1, SQ_KV = 65536 * 2, SQ_X1 = 65536 * 3, SQ_X2 = 65536 * 4, SQ_A = 65536 * 5, SQ_S = 65536 * 6, SQ_KR = 65536 * 7, RS0_OFF = 65536 * 9;
constexpr size_t OUT_COS = 0, OUT_SIN = (size_t)16384 * 32, OUT_KR = (size_t)16384 * 64;
constexpr size_t WS_A16 = 1 * MiB;
constexpr size_t WS_WIN = 2 * MiB, WS_WUQ = 10 * MiB, WS_WUKV = 12 * MiB, WS_WGLU = 13 * MiB, WS_WO = 15 * MiB, WS_WGU = 23 * MiB, WS_WDN = 67 * MiB, WS_WPG = 89 * MiB, WS_WPP = 97 * MiB;
constexpr size_t WS_MT = 98 * MiB;
constexpr size_t WS_HN = 100 * MiB;
constexpr size_t WS_YG = 264 * MiB;
constexpr size_t WS_Z = 164 * MiB;
constexpr size_t WS_AS = 196 * MiB;
constexpr size_t WS_PALL = 244 * MiB;
constexpr size_t WS_WALL = 252 * MiB;
constexpr size_t WS_QRAW = 264 * MiB, WS_KVRAW = 312 * MiB;
constexpr size_t WS_Q = 376 * MiB, WS_K = 424 * MiB, WS_V = 472 * MiB;
constexpr size_t WS_H = 228 * MiB, WS_PP = 404 * MiB, WS_PB = 504 * MiB, WS_END = 512 * MiB;

constexpr int RING_BYTES = 131072, MISC_OFF = 139264 + 320, LDS_BYTES = 147456;
constexpr int NWAVES = 8;

#define GAS __attribute__((address_space(1)))
#define LAS __attribute__((address_space(3)))
typedef unsigned short bf16;
typedef unsigned v4u __attribute__((ext_vector_type(4)));
typedef unsigned v2u __attribute__((ext_vector_type(2)));
typedef float f32x4 __attribute__((ext_vector_type(4)));
typedef GAS unsigned gu32;
#define LDS_WAIT() asm volatile("s_waitcnt lgkmcnt(0)" ::: "memory")
__device__ __forceinline__ unsigned f2bf(float f) { unsigned u = __builtin_bit_cast(unsigned, f); return (u + 0x7fffu + ((u >> 16) & 1u)) >> 16; }
__device__ __forceinline__ unsigned pk2(float lo, float hi) { return f2bf(lo) | (f2bf(hi) << 16); }
__device__ __forceinline__ float bf2f(unsigned h) { return __builtin_bit_cast(float, h << 16); }
__device__ __forceinline__ float bflo(unsigned w) { return __builtin_bit_cast(float, w << 16); }
__device__ __forceinline__ float bfhi(unsigned w) { return __builtin_bit_cast(float, w & 0xffff0000u); }
__device__ __forceinline__ int fresh_tid() { int t = threadIdx.x; asm volatile("" : "+v"(t)); return t; }
__device__ __forceinline__ float wave_sum(float v) {
#pragma unroll
    for (int o = 1; o < 64; o <<= 1) v += __shfl_xor(v, o);
    return v;
}
__device__ __forceinline__ float wave_max(float v) {
#pragma unroll
    for (int o = 1; o < 64; o <<= 1) v = fmaxf(v, __shfl_xor(v, o));
    return v;
}
typedef float f32x2 __attribute__((ext_vector_type(2)));
__device__ __forceinline__ f32x2 splat2(float v) { return (f32x2){v, v}; }
__device__ __forceinline__ f32x2 fma2(f32x2 a, f32x2 b, f32x2 c) { return __builtin_elementwise_fma(a, b, c); }
__device__ __forceinline__ f32x2 rsig2(f32x2 t) {
    f32x2 e = {__builtin_amdgcn_exp2f(t[0]), __builtin_amdgcn_exp2f(t[1])}; e = e + splat2(1.0f);
    return (f32x2){__builtin_amdgcn_rcpf(e[0]), __builtin_amdgcn_rcpf(e[1])};
}
__device__ __forceinline__ f32x2 gelu_tanh2(f32x2 v) {
    constexpr float k1 = -2.0f * 0.7978845608028654f * 1.4426950408889634f, k2 = k1 * 0.044715f;
    return v * rsig2(v * fma2(v * v, splat2(k2), splat2(k1)));
}
__device__ __forceinline__ f32x2 half2of(const f32x4& v, int h) { return (f32x2){v[2 * h], v[2 * h + 1]}; }
__device__ __forceinline__ void sethalf(f32x4& v, int h, f32x2 x) { v[2 * h] = x[0]; v[2 * h + 1] = x[1]; }
__device__ __forceinline__ f32x2 unpack2(unsigned d) { return (f32x2){__uint_as_float(d << 16), __uint_as_float(d & 0xffff0000u)}; }

__device__ __forceinline__ float sigmoid_f(float v) { return __builtin_amdgcn_rcpf(1.0f + __builtin_amdgcn_exp2f(-1.4426950408889634f * v)); }
__device__ __forceinline__ float gelu_tanh(float v) {
    const float z = 0.7978845608028654f * (v + 0.044715f * v * v * v);
    const float e = __builtin_amdgcn_exp2f(2.0f * 1.4426950408889634f * z);
    const float th = 1.0f - 2.0f * __builtin_amdgcn_rcpf(e + 1.0f);
    return 0.5f * v * (1.0f + th);
}

#define XB_TMO      128
#define XB_XCNT(j)  (256  + 64 * (j))
#define XB_XSUB(j)  (1280 + 64 * (j))
#define XB_XGEN(j)  (2304 + 64 * (j))
#define XB_TOP      3328
#define XB_TOPGEN   3392
#define XCD_BAR_WORDS 3456
#define XB_SPIN_CAP (1u << 18)
__device__ __forceinline__ unsigned xb_ld(unsigned* p)              { return __hip_atomic_load(p, __ATOMIC_RELAXED, __HIP_MEMORY_SCOPE_AGENT); }
__device__ __forceinline__ unsigned xb_add(unsigned* p, unsigned v) { return __hip_atomic_fetch_add(p, v, __ATOMIC_RELAXED, __HIP_MEMORY_SCOPE_AGENT); }
__device__ __forceinline__ unsigned xb_xcc_id() { return (unsigned)__builtin_amdgcn_s_getreg((3 << 11) | 20) & 0xFu; }
#define XB_SPIN(cond, bar) do { unsigned _sp = 0; while (cond) { __builtin_amdgcn_s_sleep(1); \
    if ((++_sp & 255u) == 0u) { if (xb_ld(&(bar)[XB_TMO])) break; if (_sp > XB_SPIN_CAP) { atomicAdd(&(bar)[XB_TMO], 1u); break; } } } } while (0)
struct XcdBarrier { unsigned* bar; unsigned x; volatile LAS unsigned* st; unsigned members; };
__device__ __forceinline__ XcdBarrier xcd_barrier_post(unsigned* bar, volatile LAS unsigned* st, unsigned members) {
    XcdBarrier b; b.bar = bar; b.x = xb_xcc_id(); b.st = st; b.members = members;
    if (threadIdx.x == 0) (void)xb_add(&bar[XB_XCNT(b.x)], 1u);
    return b;
}
__device__ __forceinline__ void xcd_barrier_complete(unsigned* bar, unsigned x, unsigned G, unsigned& nloc, unsigned& nx) {
    unsigned sum, cnt, mine, sp = 0u;
    for (;;) {
        sum = 0u; cnt = 0u; mine = 0u;
#pragma unroll
        for (unsigned j = 0; j < 16; ++j) { const unsigned c = xb_ld(&bar[XB_XCNT(j)]); sum += c; cnt += (c > 0u) ? 1u : 0u; mine = (j == x) ? c : mine; }
        if (sum == G) break;
        __builtin_amdgcn_s_sleep(1);
        if ((++sp & 255u) == 0u) { if (xb_ld(&bar[XB_TMO])) break; if (sp > XB_SPIN_CAP) { atomicAdd(&bar[XB_TMO], 1u); break; } }
    }
    nloc = mine > 0u ? mine : 1u; nx = cnt > 0u ? cnt : 1u;
}
__device__ __forceinline__ void xcd_barrier(const XcdBarrier& b) {
    asm volatile("s_waitcnt vmcnt(0)" ::: "memory");
    __syncthreads();
    if (threadIdx.x == 0) {
        unsigned* bar = b.bar;
        __builtin_amdgcn_s_waitcnt(0);
        unsigned nloc = b.st[0], nx = b.st[1];
        if (nloc == 0u) { xcd_barrier_complete(bar, b.x, b.members, nloc, nx); b.st[0] = nloc; b.st[1] = nx; }
        const unsigned old = xb_add(&bar[XB_XSUB(b.x)], 1u);
        const unsigned gen = old / nloc;
        if (old + 1u == (gen + 1u) * nloc) {
            __builtin_amdgcn_fence(__ATOMIC_RELEASE, "agent");
            asm volatile("s_waitcnt vmcnt(0)" ::: "memory");
            const unsigned og = xb_add(&bar[XB_TOP], 1u);
            const unsigned tg = og / nx;
            if (og + 1u == (tg + 1u) * nx) xb_add(&bar[XB_TOPGEN], 1u);
            else XB_SPIN(xb_ld(&bar[XB_TOPGEN]) == tg, bar);
            __builtin_amdgcn_fence(__ATOMIC_ACQUIRE, "agent");
            xb_add(&bar[XB_XGEN(b.x)], 1u);
            asm volatile("s_waitcnt vmcnt(0)" ::: "memory");
        } else {
            XB_SPIN(xb_ld(&bar[XB_XGEN(b.x)]) == gen, bar);
            __builtin_amdgcn_fence(__ATOMIC_ACQUIRE, "agent");
            asm volatile("s_waitcnt vmcnt(0)" ::: "memory");
        }
    }
    __syncthreads();
}

using pg8::Unit; using pg8::cvt_pk_bf16;
#define EPI_LOOP_AM _Pragma("unroll") for (int ai = 0; ai < 2; ++ai) _Pragma("unroll") for (int m = 0; m < 4; ++m)
__device__ __forceinline__ float sq8(const f32x4& a, const f32x4& b) { f32x2 s = half2of(a, 0) * half2of(a, 0); s = fma2(half2of(a, 1), half2of(a, 1), s); s = fma2(half2of(b, 0), half2of(b, 0), s); s = fma2(half2of(b, 1), half2of(b, 1), s); return s[0] + s[1]; }
__device__ __forceinline__ v4u pack8(const f32x4& a, const f32x4& b) { v4u w; w.x = cvt_pk_bf16(a[0], a[1]); w.y = cvt_pk_bf16(a[2], a[3]); w.z = cvt_pk_bf16(b[0], b[1]); w.w = cvt_pk_bf16(b[2], b[3]); return w; }

__device__ __forceinline__ void unpack8(const v4u w, float (&f)[8]) { f[0] = bflo(w.x); f[1] = bfhi(w.x); f[2] = bflo(w.y); f[3] = bfhi(w.y); f[4] = bflo(w.z); f[5] = bfhi(w.z); f[6] = bflo(w.w); f[7] = bfhi(w.w); }
__device__ __forceinline__ v4u pack8f(const float (&f)[8]) { v4u w; w.x = pk2(f[0], f[1]); w.y = pk2(f[2], f[3]); w.z = pk2(f[4], f[5]); w.w = pk2(f[6], f[7]); return w; }
struct EpiZ {
    static constexpr bool PERM = true, AFTER_DRAIN = false; static constexpr int MIDK = 0;
    bf16* Z; bf16* AS; float* sqq; float* sqkv; float* sqkr; bf16* KR; const float* COS; const float* SIN; const float* gk;
    __device__ __forceinline__ void operator()(const f32x4 (&acc)[2][2][4][2], const Unit& u, int wr, int wc, int fr, int fq) const {
        int row0 = u.pm * 256 + wr * 64 + fr; asm volatile("" : "+v"(row0));
        if (u.pn < 3) {
            const int col0 = u.pn * 256 + wc * 32 + 8 * fq;
            float* sq = u.pn < 2 ? sqq : sqkv;
            EPI_LOOP_AM { const int row = row0 + ai * 128 + m * 16; bf16* rowp = Z + (size_t)row * ZLD + col0; float s = 0.f;
#pragma unroll
                for (int bj = 0; bj < 2; ++bj) { *(v4u*)(rowp + bj * 128) = pack8(acc[ai][bj][m][0], acc[ai][bj][m][1]); s += sq8(acc[ai][bj][m][0], acc[ai][bj][m][1]); }
                s += __shfl_xor(s, 16); s += __shfl_xor(s, 32); if (fq == 0) atomicAdd(sq + row, s); }
        } else if (u.pn == 3) {
            if (wc < 2) { const int i0 = 16 * wc + 4 * fq; const f32x4 g0 = *(const f32x4*)(gk + 128 + i0), g1 = *(const f32x4*)(gk + 160 + i0);
#pragma unroll
                for (int ai = 0; ai < 2; ++ai) { f32x4 csv[4], snv[4];
#pragma unroll
                    for (int m = 0; m < 4; ++m) { const int row = row0 + ai * 128 + m * 16; csv[m] = *(const f32x4*)(COS + (size_t)row * 32 + i0); snv[m] = *(const f32x4*)(SIN + (size_t)row * 32 + i0); }
#pragma unroll
                    for (int m = 0; m < 4; ++m) { const int row = row0 + ai * 128 + m * 16; const f32x4 a = acc[ai][0][m][0], b = acc[ai][0][m][1], cs = csv[m], sn = snv[m];
                        float s = sq8(a, b); const f32x4 ag = a * g0, bg = b * g1, ra = ag * cs - bg * sn, rb = bg * cs + ag * sn;
                        *(v4u*)(KR + (size_t)row * 64 + 32 * wc + 8 * fq) = pack8(ra, rb);
                        s += __shfl_xor(s, 16); s += __shfl_xor(s, 32); if (fq == 0) atomicAdd(sqkr + row, s); }
                    asm volatile("" ::: "memory"); } }
        } else {
            const int ch0 = (u.pn - 4) * 256 + wc * 32 + 8 * fq;
            EPI_LOOP_AM { const int row = row0 + ai * 128 + m * 16;
#pragma unroll
                for (int bj = 0; bj < 2; ++bj) { const int ch = ch0 + bj * 128, g = ch >> 4, h0 = ch & 15;
                    *(v4u*)(AS + ((size_t)(g * SROWS + (row >> 4)) * ASLD + (row & 15) * 16 + h0)) = pack8(acc[ai][bj][m][0], acc[ai][bj][m][1]); } }
        }
    }
};
struct EpiKV {
    static constexpr bool PERM = true, AFTER_DRAIN = false; static constexpr int MIDK = 0;
    bf16* K; bf16* V; const float* sqkv; const float* sqkr; const bf16* KR; const float* gk; LAS float* P;
    __device__ __forceinline__ void operator()(const f32x4 (&acc)[2][2][4][2], const Unit& u, int wr, int wc, int fr, int fq) const {
        int rb = wr * 64 + fr, c8 = wc * 32 + 8 * fq, pw = (wr * 64 + fr) * 4 + wc; const int h = u.pn; asm volatile("" : "+v"(rb), "+v"(c8), "+v"(pw));
        const f32x4 g0 = *(const f32x4*)(gk + c8), g1 = *(const f32x4*)(gk + c8 + 4);
        float skv[2][4], skr[2][4]; v4u krv[2][4];
        EPI_LOOP_AM { const int row = u.pm * 256 + ai * 128 + m * 16 + rb; skv[ai][m] = sqkv[row]; skr[ai][m] = sqkr[row]; }
        if (wc < 2) { EPI_LOOP_AM krv[ai][m] = *(const v4u*)(KR + (size_t)(u.pm * 256 + ai * 128 + m * 16 + rb) * 64 + c8); }
        EPI_LOOP_AM { float s = sq8(acc[ai][0][m][0], acc[ai][0][m][1]); s += __shfl_xor(s, 16); s += __shfl_xor(s, 32); if (fq == 0) P[pw + (ai * 128 + m * 16) * 4] = s; }
        asm volatile("s_waitcnt lgkmcnt(0)" ::: "memory"); __builtin_amdgcn_s_barrier(); asm volatile("" ::: "memory");
#pragma unroll
        for (int ai = 0; ai < 2; ++ai) {
#pragma unroll
          for (int m = 0; m < 4; ++m) { const int rt = ai * 128 + m * 16 + rb, row = u.pm * 256 + rt, b = row / SEQ, t = row % SEQ; const size_t orow = (size_t)(b * NH + h) * SEQ + t;
            const f32x4 pp = *(const LAS f32x4*)(P + rt * 4); const float rkv = __builtin_amdgcn_rsqf(skv[ai][m] * (1.0f / KVL) + EPS);
            const float rk = __builtin_amdgcn_rsqf((rkv * rkv * ((pp[0] + pp[1]) + (pp[2] + pp[3])) + skr[ai][m]) * (1.0f / DQK) + EPS), f = rkv * rk;
            *(v4u*)(K + orow * DQK + c8) = pack8(acc[ai][0][m][0] * g0 * f, acc[ai][0][m][1] * g1 * f);
            *(v4u*)(V + orow * DV + c8) = pack8(acc[ai][1][m][0] * rkv, acc[ai][1][m][1] * rkv);
            if (wc < 2) { float kr[8]; unpack8(krv[ai][m], kr);
#pragma unroll
                for (int j = 0; j < 8; ++j) kr[j] *= rk;
                *(v4u*)(K + orow * DQK + 128 + c8) = pack8f(kr); } }
          asm volatile("" ::: "memory"); }
    }
};
struct EpiQ {
    static constexpr bool PERM = true, AFTER_DRAIN = false; static constexpr int MIDK = 0;
    bf16* Q; const float* sqq; const float* COS; const float* SIN; const float* gq; LAS float* P;
    __device__ __forceinline__ void operator()(const f32x4 (&acc)[2][2][4][2], const Unit& u, int wr, int wc, int fr, int fq) const {
        int rb = wr * 64 + fr, c8 = wc * 32 + 8 * fq, pw = (wr * 64 + fr) * 4 + wc; const int h = u.pn; asm volatile("" : "+v"(rb), "+v"(c8), "+v"(pw));
        const f32x4 g0 = *(const f32x4*)(gq + c8), g1 = *(const f32x4*)(gq + c8 + 4);
        const int i0 = (c8 >> 1) & 28;
        f32x4 h0 = g0, h1 = g0; if (wc < 2) { h0 = *(const f32x4*)(gq + 128 + i0); h1 = *(const f32x4*)(gq + 160 + i0); }
        float sqv[2][4]; f32x4 csv[2][4], snv[2][4];
        EPI_LOOP_AM { const int row = u.pm * 256 + ai * 128 + m * 16 + rb; sqv[ai][m] = sqq[row]; }
        if (wc < 2) { EPI_LOOP_AM { const int row = u.pm * 256 + ai * 128 + m * 16 + rb; csv[ai][m] = *(const f32x4*)(COS + (size_t)row * 32 + i0); snv[ai][m] = *(const f32x4*)(SIN + (size_t)row * 32 + i0); } }
        EPI_LOOP_AM { float s = sq8(acc[ai][0][m][0], acc[ai][0][m][1]) + sq8(acc[ai][1][m][0], acc[ai][1][m][1]); s += __shfl_xor(s, 16); s += __shfl_xor(s, 32); if (fq == 0) P[pw + (ai * 128 + m * 16) * 4] = s; }
        asm volatile("s_waitcnt lgkmcnt(0)" ::: "memory"); __builtin_amdgcn_s_barrier(); asm volatile("" ::: "memory");
        EPI_LOOP_AM { const int rt = ai * 128 + m * 16 + rb, row = u.pm * 256 + rt, b = row / SEQ, t = row % SEQ; const size_t orow = (size_t)(b * NH + h) * SEQ + t;
            const f32x4 pp = *(const LAS f32x4*)(P + rt * 4); const float rq = __builtin_amdgcn_rsqf(sqv[ai][m] * (1.0f / QL) + EPS);
            const float rh = __builtin_amdgcn_rsqf(rq * rq * ((pp[0] + pp[1]) + (pp[2] + pp[3])) * (1.0f / DQK) + EPS), f = rq * rh;
            *(v4u*)(Q + orow * DQK + c8) = pack8(acc[ai][0][m][0] * g0 * f, acc[ai][0][m][1] * g1 * f);
            if (wc < 2) { const f32x4 a = acc[ai][1][m][0] * h0 * f, bq = acc[ai][1][m][1] * h1 * f, cs = csv[ai][m], sn = snv[ai][m];
                *(v4u*)(Q + orow * DQK + 128 + c8) = pack8(a * cs - bq * sn, bq * cs + a * sn); } }
    }
};
struct EpiE {
    static constexpr bool PERM = true, AFTER_DRAIN = true; static constexpr int MIDK = 0;
    bf16* AS; const float* A16;
    __device__ __forceinline__ void fused(f32x4 (&acc)[2][2][4][2], const Unit& u, int wr, int wc, int fr, int fq, LAS unsigned char* lds, int wid, int lane) const {
        LAS float* Et = (LAS float*)lds;
        EPI_LOOP_AM { const int row = ai * 128 + wr * 64 + m * 16 + fr, col = wc * 32 + 8 * fq, sw = (row & 7) << 3;
            *(LAS f32x4*)(Et + row * 128 + (col ^ sw)) = acc[ai][0][m][0]; *(LAS f32x4*)(Et + row * 128 + ((col + 4) ^ sw)) = acc[ai][0][m][1]; }
        asm volatile("s_waitcnt lgkmcnt(0)" ::: "memory"); __builtin_amdgcn_s_barrier(); asm volatile("" ::: "memory");
        if (wid < 2) { const int bq = wid, p = lane, g = u.pn; const float a_re = A16[2 * (g * NP + p)], a_im = A16[2 * (g * NP + p) + 1]; float sr = 0.f, si = 0.f;
            bf16* o = AS + ((size_t)u.pm * 256 + bq * 128) * ASLD + 256 + p;
#pragma unroll 8
            for (int k = 0; k < NCH; ++k) { const int row = bq * 128 + k, sw = (row & 7) << 3; const float er = Et[row * 128 + (p ^ sw)], ei = Et[row * 128 + 64 + (p ^ sw)];
                o[(size_t)k * ASLD] = (bf16)f2bf(sr); o[(size_t)k * ASLD + 64] = (bf16)f2bf(si);
                const float nr = a_re * sr - a_im * si + er, ni = a_re * si + a_im * sr + ei; sr = nr; si = ni; } }
    }
};
struct EpiY {
    static constexpr bool PERM = true, AFTER_DRAIN = false; static constexpr int MIDK = 0;
    bf16* YG;
    __device__ __forceinline__ void operator()(const f32x4 (&acc)[2][2][4][2], const Unit& u, int wr, int wc, int fr, int fq) const {
        const int g = u.pn, r0 = (u.pm & 3) * 256 + wr * 64 + fr, n0 = wc * 32 + 8 * fq;
        EPI_LOOP_AM { const int r = r0 + ai * 128 + m * 16, b = r >> 7, k = r & 127;
#pragma unroll
            for (int bj = 0; bj < 2; ++bj) { const int n = n0 + bj * 128, j = n >> 4, h0 = n & 15; f32x4 a = acc[ai][bj][m][0], c = acc[ai][bj][m][1];
#pragma unroll
                for (int e = 0; e < 2; ++e) { sethalf(a, e, gelu_tanh2(half2of(a, e))); sethalf(c, e, gelu_tanh2(half2of(c, e))); }
                *(v4u*)(YG + (size_t)(b * SEQ + k * TC + j) * SSMW + GH * g + h0) = pack8(a, c); } }
    }
};
struct EpiScale {
    static constexpr bool PERM = true, AFTER_DRAIN = false; static constexpr int MIDK = 0;
    bf16* O; int ldc; const float* sq; float invk;
    __device__ __forceinline__ void operator()(const f32x4 (&acc)[2][2][4][2], const Unit& u, int wr, int wc, int fr, int fq) const {
        int row0 = u.pm * 256 + wr * 64 + fr, col0 = u.pn * 256 + wc * 32 + 8 * fq; asm volatile("" : "+v"(row0), "+v"(col0));
        EPI_LOOP_AM { const int row = row0 + ai * 128 + m * 16; bf16* rowp = O + (size_t)row * ldc + col0; const float rs = __builtin_amdgcn_rsqf(sq[row] * invk + EPS);
#pragma unroll
            for (int bj = 0; bj < 2; ++bj) *(v4u*)(rowp + bj * 128) = pack8(acc[ai][bj][m][0] * rs, acc[ai][bj][m][1] * rs); }
    }
};
struct EpiPlain {
    static constexpr bool PERM = true, AFTER_DRAIN = false; static constexpr int MIDK = 0;
    bf16* O; int ldc;
    __device__ __forceinline__ void operator()(const f32x4 (&acc)[2][2][4][2], const Unit& u, int wr, int wc, int fr, int fq) const {
        int row0 = u.pm * 256 + wr * 64 + fr, col0 = u.pn * 256 + wc * 32 + 8 * fq; asm volatile("" : "+v"(row0), "+v"(col0));
        EPI_LOOP_AM { bf16* rowp = O + (size_t)(row0 + ai * 128 + m * 16) * ldc + col0;
#pragma unroll
            for (int bj = 0; bj < 2; ++bj) *(v4u*)(rowp + bj * 128) = pack8(acc[ai][bj][m][0], acc[ai][bj][m][1]); }
    }
};
struct EpiGlu {
    static constexpr bool PERM = true, AFTER_DRAIN = false; static constexpr int MIDK = 0;
    const bf16* YG; const float* bias; bf16* O; float* sq;
    __device__ __forceinline__ void operator()(const f32x4 (&acc)[2][2][4][2], const Unit& u, int wr, int wc, int fr, int fq) const {
        int row0 = u.pm * 256 + wr * 64 + fr, col0 = u.pn * 256 + wc * 32 + 8 * fq; asm volatile("" : "+v"(row0), "+v"(col0));
        f32x4 bv[2][2];
#pragma unroll
        for (int bj = 0; bj < 2; ++bj) { bv[bj][0] = *(const f32x4*)(bias + col0 + bj * 128) * -1.4426950408889634f; bv[bj][1] = *(const f32x4*)(bias + col0 + bj * 128 + 4) * -1.4426950408889634f; }
        v4u yv[2][4][2];
        EPI_LOOP_AM {
#pragma unroll
            for (int bj = 0; bj < 2; ++bj) yv[ai][m][bj] = __builtin_nontemporal_load((const v4u*)(YG + (size_t)(row0 + ai * 128 + m * 16) * SSMW + col0 + bj * 128)); }
#pragma unroll
        for (int ai = 0; ai < 2; ++ai) {
#pragma unroll
            for (int m = 0; m < 4; ++m) { const int row = row0 + ai * 128 + m * 16; float s = 0.f;
                f32x2 s2 = {0.f, 0.f};
#pragma unroll
                for (int bj = 0; bj < 2; ++bj) { const v4u yw = yv[ai][m][bj]; const unsigned yd[4] = {yw.x, yw.y, yw.z, yw.w};
                    f32x4 o[2];
#pragma unroll
                    for (int n = 0; n < 2; ++n)
#pragma unroll
                        for (int h = 0; h < 2; ++h) { const f32x2 v = unpack2(yd[2 * n + h]) * rsig2(fma2(half2of(acc[ai][bj][m][n], h), splat2(-1.4426950408889634f), half2of(bv[bj][n], h)));
                            sethalf(o[n], h, v); s2 = fma2(v, v, s2); }
                    *(v4u*)(O + (size_t)row * 2048 + col0 + bj * 128) = pack8(o[0], o[1]); }
                s = s2[0] + s2[1];
                s += __shfl_xor(s, 16); s += __shfl_xor(s, 32); if (fq == 0) atomicAdd(sq + row, s); }
            asm volatile("" ::: "memory"); }
    }
};
struct EpiWo {
    static constexpr bool PERM = true, AFTER_DRAIN = false; static constexpr int MIDK = 16;
    const float* rs0; bf16* xb; float* sq; const float* sqa; const float* sqs;
    __device__ __forceinline__ void mid(f32x4 (&acc)[2][2][4][2], const Unit& u, int wr, int wc, int fr, int fq) const {
        int row0 = u.pm * 256 + wr * 64 + fr; const float* pa = sqa; const float* ps = sqs;
        asm volatile("" : "+v"(row0), "+s"(pa), "+s"(ps));
        EPI_LOOP_AM { const int row = row0 + ai * 128 + m * 16; const float f = __builtin_amdgcn_rsqf(pa[row] * (1.0f / 1024.0f) + EPS) * sqrtf(ps[row] * (1.0f / 1024.0f) + EPS);
#pragma unroll
            for (int bj = 0; bj < 2; ++bj) { acc[ai][bj][m][0] *= f; acc[ai][bj][m][1] *= f; } }
    }
    __device__ __forceinline__ void operator()(const f32x4 (&acc)[2][2][4][2], const Unit& u, int wr, int wc, int fr, int fq) const {
        int row0 = u.pm * 256 + wr * 64 + fr, col0 = u.pn * 256 + wc * 32 + 8 * fq; asm volatile("" : "+v"(row0), "+v"(col0));
#pragma unroll
        for (int ai = 0; ai < 2; ++ai) { v4u xv[4][2]; float nr[4], ss[4];
#pragma unroll
            for (int m = 0; m < 4; ++m) { const int row = row0 + ai * 128 + m * 16; nr[m] = rs0[row]; ss[m] = sqs[row];
#pragma unroll
                for (int bj = 0; bj < 2; ++bj) xv[m][bj] = __builtin_nontemporal_load((const v4u*)(xb + (size_t)row * D + col0 + bj * 128)); }
#pragma unroll
            for (int m = 0; m < 4; ++m) { const int row = row0 + ai * 128 + m * 16; const size_t off = (size_t)row * D + col0; float s = 0.f; const float rs = __builtin_amdgcn_rsqf(ss[m] * (1.0f / 1024.0f) + EPS), nrm = nr[m];
                f32x2 s2 = {0.f, 0.f};
#pragma unroll
                for (int bj = 0; bj < 2; ++bj) { const v4u xw = xv[m][bj]; const unsigned xd[4] = {xw.x, xw.y, xw.z, xw.w}; f32x4 o[2];
#pragma unroll
                    for (int n = 0; n < 2; ++n)
#pragma unroll
                        for (int h = 0; h < 2; ++h) { const f32x2 v = fma2(unpack2(xd[2 * n + h]), splat2(nrm), half2of(acc[ai][bj][m][n], h) * splat2(rs)); sethalf(o[n], h, v); s2 = fma2(v, v, s2); }
                    *(v4u*)(xb + off + bj * 128) = pack8(o[0], o[1]); }
                s = s2[0] + s2[1];
                s += __shfl_xor(s, 16); s += __shfl_xor(s, 32); if (fq == 0) atomicAdd(sq + row, s); }
            asm volatile("" ::: "memory"); }
    }
};
struct EpiDown {
    static constexpr bool PERM = true, AFTER_DRAIN = false; static constexpr int MIDK = 0;
    bf16* xb; float* sq;
    __device__ __forceinline__ void operator()(const f32x4 (&acc)[2][2][4][2], const Unit& u, int wr, int wc, int fr, int fq) const {
        int row0 = u.pm * 256 + wr * 64 + fr, col0 = u.pn * 256 + wc * 32 + 8 * fq; asm volatile("" : "+v"(row0), "+v"(col0));
        v4u xv[2][4][2];
        EPI_LOOP_AM {
#pragma unroll
            for (int bj = 0; bj < 2; ++bj) xv[ai][m][bj] = __builtin_nontemporal_load((const v4u*)(xb + (size_t)(row0 + ai * 128 + m * 16) * D + col0 + bj * 128)); }
#pragma unroll
        for (int ai = 0; ai < 2; ++ai) {
#pragma unroll
            for (int m = 0; m < 4; ++m) { const int row = row0 + ai * 128 + m * 16; const size_t off = (size_t)row * D + col0; float s = 0.f;
                f32x2 s2 = {0.f, 0.f};
#pragma unroll
                for (int bj = 0; bj < 2; ++bj) { const v4u xw = xv[ai][m][bj]; const unsigned xd[4] = {xw.x, xw.y, xw.z, xw.w}; f32x4 o[2];
#pragma unroll
                    for (int n = 0; n < 2; ++n)
#pragma unroll
                        for (int h = 0; h < 2; ++h) { const f32x2 v = half2of(acc[ai][bj][m][n], h) + unpack2(xd[2 * n + h]); sethalf(o[n], h, v); s2 = fma2(v, v, s2); }
                    *(v4u*)(xb + off + bj * 128) = pack8(o[0], o[1]); }
                s = s2[0] + s2[1];
                s += __shfl_xor(s, 16); s += __shfl_xor(s, 32); if (fq == 0) atomicAdd(sq + row, s); }
            asm volatile("" ::: "memory"); }
    }
};
struct EpiGateUp {
    static constexpr bool PERM = true, AFTER_DRAIN = false; static constexpr int MIDK = 0;
    bf16* H; const float* sq;
    __device__ __forceinline__ void operator()(const f32x4 (&acc)[2][2][4][2], const Unit& u, int wr, int wc, int fr, int fq) const {
        int row0 = u.pm * 256 + wr * 64 + fr, col0 = u.pn * 128 + wc * 32 + 8 * fq; asm volatile("" : "+v"(row0), "+v"(col0));
        float sv[2][4];
        EPI_LOOP_AM sv[ai][m] = sq[row0 + ai * 128 + m * 16];
        EPI_LOOP_AM { const int row = row0 + ai * 128 + m * 16; const float rs = __builtin_amdgcn_rsqf(sv[ai][m] * (1.0f / D) + EPS);
            const f32x2 nl = {-1.4426950408889634f * rs, -1.4426950408889634f * rs}, r2 = {rs * rs, rs * rs};
            f32x4 o[2];
#pragma unroll
            for (int n = 0; n < 2; ++n)
#pragma unroll
                for (int h = 0; h < 2; ++h) { const f32x2 g = {acc[ai][0][m][n][2 * h], acc[ai][0][m][n][2 * h + 1]}, uu = {acc[ai][1][m][n][2 * h], acc[ai][1][m][n][2 * h + 1]};
                    const f32x2 hv = ((g * uu) * r2) * rsig2(g * nl);
                    o[n][2 * h] = hv[0]; o[n][2 * h + 1] = hv[1]; }
            __builtin_nontemporal_store(pack8(o[0], o[1]), (v4u*)(H + (size_t)row * FF + col0)); }
    }
};
struct EpiPle {
    static constexpr bool PERM = true, AFTER_DRAIN = false; static constexpr int MIDK = 0;
    float* out; const bf16* xb; const bf16* PP; const float* sq;
    __device__ __forceinline__ void operator()(const f32x4 (&acc)[2][2][4][2], const Unit& u, int wr, int wc, int fr, int fq) const {
        int row0 = u.pm * 256 + wr * 64 + fr, col0 = u.pn * 256 + wc * 32 + 8 * fq; asm volatile("" : "+v"(row0), "+v"(col0));
#pragma unroll
        for (int ai = 0; ai < 2; ++ai) { v4u pv[4][2], xv[4][2]; float sv[4];
#pragma unroll
            for (int m = 0; m < 4; ++m) { const int row = row0 + ai * 128 + m * 16; sv[m] = sq[row];
#pragma unroll
                for (int bj = 0; bj < 2; ++bj) { pv[m][bj] = __builtin_nontemporal_load((const v4u*)(PP + (size_t)row * D + col0 + bj * 128)); xv[m][bj] = __builtin_nontemporal_load((const v4u*)(xb + (size_t)row * D + col0 + bj * 128)); } }
#pragma unroll
            for (int m = 0; m < 4; ++m) { const int row = row0 + ai * 128 + m * 16; const size_t off = (size_t)row * D + col0; const float rs = __builtin_amdgcn_rsqf(sv[m] * (1.0f / D) + EPS);
#pragma unroll
                for (int bj = 0; bj < 2; ++bj) { const v4u pw = pv[m][bj], xw = xv[m][bj]; const unsigned pd[4] = {pw.x, pw.y, pw.z, pw.w}, xd[4] = {xw.x, xw.y, xw.z, xw.w};
                    const f32x2 nl = splat2(-1.4426950408889634f * rs); f32x4 o[2];
#pragma unroll
                    for (int n = 0; n < 2; ++n)
#pragma unroll
                        for (int h = 0; h < 2; ++h) sethalf(o[n], h, fma2(rsig2(half2of(acc[ai][bj][m][n], h) * nl), unpack2(pd[2 * n + h]), unpack2(xd[2 * n + h])));
                    *(f32x4*)(out + off + bj * 128) = o[0]; *(f32x4*)(out + off + bj * 128 + 4) = o[1]; } }
            asm volatile("" ::: "memory"); }
    }
};

__device__ __forceinline__ int xperm(int d) { const int i = d & 31, n = d >> 5; return 32 * (i >> 4) + 8 * ((i >> 2) & 3) + 4 * n + (i & 3); }
__device__ __forceinline__ int dest_row(int mode, int n) {
    if (mode == 0) return n;
    if (mode == 1) return n < 768 ? n : (n < 832 ? 768 + xperm(n - 768) : n + 192);
    if (mode == 5) { const int h = n / 192, d = n - h * 192; return 256 * h + (d < 128 ? d : 128 + xperm(d - 128)); }
    if (mode == 2) return 256 * (n >> 7) + (n & 127);
    return 256 * (n >> 7) + 128 + (n & 127);
}
struct TDesc { const float* W; bf16* WT; const float* gain; int Nsrc, ldwt, mode, k0, n0; };
__device__ __forceinline__ void tr_load(const TDesc& d, int lane, f32x4 (&r)[16], f32x4& g0, f32x4& g1) {
    const float* src = d.W + (size_t)(d.k0 + (lane >> 4)) * d.Nsrc + d.n0 + 4 * (lane & 15);
#pragma unroll
    for (int i = 0; i < 16; ++i) r[i] = __builtin_nontemporal_load((const f32x4*)(src + (size_t)(4 * i) * d.Nsrc));
    if (d.gain) { g0 = *(const f32x4*)(d.gain + d.k0 + 8 * (lane >> 3)); g1 = *(const f32x4*)(d.gain + d.k0 + 8 * (lane >> 3) + 4); } else { g0 = (f32x4){1.f, 1.f, 1.f, 1.f}; g1 = g0; }
}
__device__ __forceinline__ void tr_lds_write(LAS float* scr, int lane, const f32x4 (&r)[16]) {
    const int kr = lane >> 4, nc = lane & 15;
#pragma unroll
    for (int i = 0; i < 16; ++i) *(LAS f32x4*)(scr + (4 * i + kr) * 64 + 4 * (nc ^ (2 * ((i >> 1) & 7)))) = r[i];
}
__device__ __forceinline__ void tr_store(const TDesc& d, LAS float* scr, int lane, const f32x4& g0, const f32x4& g1) {
    const int nr = lane & 7, c = lane >> 3;
#pragma unroll
    for (int j = 0; j < 8; ++j) { const int n = nr + 8 * j; const LAS float* p = scr + (8 * c) * 64 + 4 * ((n >> 2) ^ (2 * c)) + (n & 3);
        v4u o; o.x = pk2(p[0 * 64] * g0[0], p[1 * 64] * g0[1]); o.y = pk2(p[2 * 64] * g0[2], p[3 * 64] * g0[3]); o.z = pk2(p[4 * 64] * g1[0], p[5 * 64] * g1[1]); o.w = pk2(p[6 * 64] * g1[2], p[7 * 64] * g1[3]);
        *(GAS v4u*)(d.WT + (size_t)dest_row(d.mode, d.n0 + n) * d.ldwt + d.k0 + 8 * c) = o; }
}
struct Args { const void* in[31]; float* out; unsigned char* ws; int ph_lo, ph_hi; };
typedef const __attribute__((address_space(4))) Args* KA;
__device__ __forceinline__ KA get_ka() { KA p = (KA)__builtin_amdgcn_kernarg_segment_ptr(); asm volatile("" : "+s"(p)); return p; }
#define INF(i) ((const float*)args->in[i])

struct Cplx { float re, im; };
__device__ __forceinline__ void s5_disc(KA args, int g, int p, float& lr, float& li, float& dt) {
    lr = fminf(INF(11)[g * NP + p], -1e-4f); li = INF(12)[g * NP + p]; dt = expf(INF(13)[g]);
}
__device__ __forceinline__ Cplx s5_apow(float lr, float li, float dt, int tau) { const float mag = expf(lr * dt * (float)tau), th = li * dt * (float)tau; float sn, cs; sincosf(th, &sn, &cs); Cplx r; r.re = mag * cs; r.im = mag * sn; return r; }
__device__ __forceinline__ Cplx s5_coef(float lr, float li, float dt) {
    float sn, cs; sincosf(li * dt, &sn, &cs); const float mag = expf(lr * dt), are = mag * cs, aim = mag * sn, den = lr * lr + li * li, nre = are - 1.0f, nim = aim;
    Cplx r; r.re = (nre * lr + nim * li) / den; r.im = (nim * lr - nre * li) / den; return r;
}
__device__ __forceinline__ void s5_tables(KA args, LAS unsigned char* lds, int gw, int NGW) {
    unsigned char* ws = args->ws; const int tid = fresh_tid(), lane = tid & 63;
    { LAS float* AP = (LAS float*)lds; LAS float* CF = AP + 512; LAS float* CR = CF + 128; LAS float* CI = CR + 1040; LAS float* BR = CI + 1040; LAS float* BI = BR + 1024;
      for (int item = blockIdx.x; item < NG * 4; item += gridDim.x) {
        const int g = item >> 2, tq = item & 3;
        __syncthreads();
        if (tid < 256) { const int tl = tid >> 6, p = tid & 63; float lr, li, dt; s5_disc(args, g, p, lr, li, dt); const Cplx a = s5_apow(lr, li, dt, 4 * tq + tl); AP[tid * 2] = (float)a.re; AP[tid * 2 + 1] = (float)a.im; }
        else if (tid < 320) { const int p = tid - 256; float lr, li, dt; s5_disc(args, g, p, lr, li, dt); const Cplx c = s5_coef(lr, li, dt); CF[p * 2] = (float)c.re; CF[p * 2 + 1] = (float)c.im; }
#pragma unroll
        for (int e = 0; e < 2; ++e) { const int idx = tid + 512 * e; CR[(idx >> 6) * 65 + (idx & 63)] = INF(16)[(size_t)g * 1024 + idx]; CI[(idx >> 6) * 65 + (idx & 63)] = INF(17)[(size_t)g * 1024 + idx];
            BR[idx] = INF(14)[(size_t)g * 1024 + idx]; BI[idx] = INF(15)[(size_t)g * 1024 + idx]; }
        __syncthreads();
#pragma unroll
        for (int e = 0; e < 2; ++e) { const int idx = tid + 512 * e, p = idx >> 4; const float fr_ = CF[p * 2], fi_ = CF[p * 2 + 1], br = BR[idx], bi = BI[idx]; BR[idx] = fr_ * br - fi_ * bi; BI[idx] = fr_ * bi + fi_ * br; }
        __syncthreads();
#pragma unroll
        for (int e = 0; e < 2; ++e) { const int idx = tid * 2 + e, tl = idx >> 8, hh = idx & 255, hp = hh >> 4, h = hh & 15, tau = 4 * tq + tl; float acc = 0.f;
#pragma unroll 8
            for (int p = 0; p < NP; ++p) { const float cr = CR[hp * 65 + p], ci = CI[hp * 65 + p], ar = AP[(tl * 64 + p) * 2], ai = AP[(tl * 64 + p) * 2 + 1];
                const float cbr = cr * ar - ci * ai, cbi = cr * ai + ci * ar; acc += cbr * BR[p * 16 + h] - cbi * BI[p * 16 + h]; }
            if (tau == 0 && h == hp) acc += INF(18)[g * GH + hp];
            ((float*)(ws + WS_MT))[(size_t)(g * 16 + tau) * 256 + hh] = acc; }
      }
      __syncthreads(); }
    const int gt = gw * 64 + lane, NT = NGW * 64;
    for (int idx = gt; idx < NG * NP * TC; idx += NT) { const int g = idx >> 10, p = (idx >> 4) & 63, i = idx & 15; float lr, li, dt; s5_disc(args, g, p, lr, li, dt);
        const Cplx a = s5_apow(lr, li, dt, 15 - i), c = s5_coef(lr, li, dt); float vr[16], vi[16];
#pragma unroll
        for (int h = 0; h < GH; ++h) { const float br = INF(14)[(size_t)(g * NP + p) * GH + h], bi = INF(15)[(size_t)(g * NP + p) * GH + h], bbr = c.re * br - c.im * bi, bbi = c.re * bi + c.im * br;
            vr[h] = (float)(a.re * bbr - a.im * bbi); vi[h] = (float)(a.re * bbi + a.im * bbr); }
        bf16* pr = (bf16*)(ws + WS_PALL) + (size_t)(g * 256 + p) * 256 + i * 16; bf16* pi = pr + (size_t)64 * 256; v4u w;
        w.x = pk2(vr[0], vr[1]); w.y = pk2(vr[2], vr[3]); w.z = pk2(vr[4], vr[5]); w.w = pk2(vr[6], vr[7]); *(v4u*)pr = w;
        w.x = pk2(vr[8], vr[9]); w.y = pk2(vr[10], vr[11]); w.z = pk2(vr[12], vr[13]); w.w = pk2(vr[14], vr[15]); *(v4u*)(pr + 8) = w;
        w.x = pk2(vi[0], vi[1]); w.y = pk2(vi[2], vi[3]); w.z = pk2(vi[4], vi[5]); w.w = pk2(vi[6], vi[7]); *(v4u*)pi = w;
        w.x = pk2(vi[8], vi[9]); w.y = pk2(vi[10], vi[11]); w.z = pk2(vi[12], vi[13]); w.w = pk2(vi[14], vi[15]); *(v4u*)(pi + 8) = w; }
    for (int idx = gt; idx < NG * 128 * 32; idx += NT) { const int g = idx >> 12, r = (idx >> 5) & 127, c = idx & 31; *(v4u*)((bf16*)(ws + WS_PALL) + (size_t)(g * 256 + 128 + r) * 256 + c * 8) = (v4u){0u, 0u, 0u, 0u}; }
    for (int idx = gt; idx < NG * TC * NP; idx += NT) { const int g = idx >> 10, j = (idx >> 6) & 15, p = idx & 63; float lr, li, dt; s5_disc(args, g, p, lr, li, dt); const Cplx a = s5_apow(lr, li, dt, j + 1);
        float crv[GH], civ[GH];
#pragma unroll
        for (int hp = 0; hp < GH; ++hp) { crv[hp] = INF(16)[(size_t)(g * GH + hp) * NP + p]; civ[hp] = INF(17)[(size_t)(g * GH + hp) * NP + p]; }
#pragma unroll
        for (int hp = 0; hp < GH; ++hp) { const float cr = crv[hp], ci = civ[hp];
            bf16* wrow = (bf16*)(ws + WS_WALL) + (size_t)(g * 256 + j * 16 + hp) * ASLD + 256 + p; wrow[0] = (bf16)f2bf((float)(cr * a.re - ci * a.im)); wrow[64] = (bf16)f2bf((float)(-(cr * a.im + ci * a.re))); } }
    for (int idx = gt; idx < NG * NP; idx += NT) { float lr, li, dt; s5_disc(args, idx >> 6, idx & 63, lr, li, dt); const Cplx a = s5_apow(lr, li, dt, 16); ((float*)(ws + WS_A16))[2 * idx] = (float)a.re; ((float*)(ws + WS_A16))[2 * idx + 1] = (float)a.im; }
}
__device__ __forceinline__ void s5_fill_w(KA args, int gw, int NGW) {
    unsigned char* ws = args->ws; const int lane = fresh_tid() & 63; const float* MT = (const float*)(ws + WS_MT);
    const int st = NGW * 64;
    for (int i0 = gw * 64 + lane; i0 < NG * 256 * 32; i0 += 4 * st) { f32x4 av[4], bv[4];
#pragma unroll
        for (int q = 0; q < 4; ++q) { const int idx = i0 + q * st < NG * 256 * 32 ? i0 + q * st : i0; const int g = idx >> 13, n = (idx >> 5) & 255, ck = idx & 31, k0 = ck * 8, i = k0 >> 4, h0 = k0 & 15, j = n >> 4, hp = n & 15;
            const float* src = MT + (size_t)(g * 16 + (j >= i ? j - i : 0)) * 256 + hp * 16 + h0; av[q] = *(const f32x4*)src; bv[q] = *(const f32x4*)(src + 4); }
#pragma unroll
        for (int q = 0; q < 4; ++q) { const int idx = i0 + q * st; if (idx < NG * 256 * 32) { const int g = idx >> 13, n = (idx >> 5) & 255, ck = idx & 31, k0 = ck * 8, i = k0 >> 4, j = n >> 4;
            v4u w = (v4u){0u, 0u, 0u, 0u};
            if (j >= i) { w.x = pk2(av[q][0], av[q][1]); w.y = pk2(av[q][2], av[q][3]); w.z = pk2(bv[q][0], bv[q][1]); w.w = pk2(bv[q][2], bv[q][3]); }
            *(v4u*)((bf16*)(ws + WS_WALL) + (size_t)(g * 256 + n) * ASLD + k0) = w; } } }
}
#ifdef PROBE_A
#define PSTAMP(k) do { if (blockIdx.x == 0 && threadIdx.x == 0) ((unsigned long long*)(args->ws + 524288))[k] = __builtin_amdgcn_s_memrealtime(); } while (0)
#else
#define PSTAMP(k) do { } while (0)
#endif
__device__ __forceinline__ void prologue_streams(KA args, LAS unsigned char* lds, int gw, int NGW, int wave) {
    unsigned char* ws = args->ws; const int lane = fresh_tid() & 63;
    LAS float* scr = (LAS float*)(lds + wave * 16384);
    constexpr int I0 = 32 * 29, I1 = 8 * 24, I2 = 4 * 32, I3 = 16 * 16, I4 = 16 * 32, I5 = 16 * 32, I6 = 32 * 88, I7 = 32 * 88, I8 = 88 * 32, I9 = 32 * 32, I10 = 4 * 32;
    constexpr int NITEMS = I0 + I1 + I2 + I3 + I4 + I5 + I6 + I7 + I8 + I9 + I10;
#define TR_DESC(d, it_) do { int r_ = (it_); int nb_; \
        if (r_ < I0) { d.W = INF(4); d.Nsrc = 1856; d.WT = (bf16*)(ws + WS_WIN); d.ldwt = 2048; d.gain = INF(3); d.mode = 1; nb_ = 29; } \
        else if ((r_ -= I0) < I1) { d.W = INF(6); d.Nsrc = 1536; d.WT = (bf16*)(ws + WS_WUQ); d.ldwt = 512; d.gain = INF(5); d.mode = 5; nb_ = 24; } \
        else if ((r_ -= I1) < I2) { d.W = INF(8); d.Nsrc = 2048; d.WT = (bf16*)(ws + WS_WUKV); d.ldwt = 256; d.gain = INF(7); d.mode = 0; nb_ = 32; } \
        else if ((r_ -= I2) < I3) { d.W = INF(19); d.Nsrc = 1024; d.WT = (bf16*)(ws + WS_WGLU); d.ldwt = 1024; d.gain = nullptr; d.mode = 0; nb_ = 16; } \
        else if ((r_ -= I3) < I4) { d.W = INF(23); d.Nsrc = 2048; d.WT = (bf16*)(ws + WS_WO); d.ldwt = 2048; d.gain = INF(21); d.mode = 0; nb_ = 32; } \
        else if ((r_ -= I4) < I5) { d.W = INF(23) + (size_t)1024 * 2048; d.Nsrc = 2048; d.WT = (bf16*)(ws + WS_WO) + 1024; d.ldwt = 2048; d.gain = INF(22); d.mode = 0; nb_ = 32; } \
        else if ((r_ -= I5) < I6) { d.W = INF(25); d.Nsrc = FF; d.WT = (bf16*)(ws + WS_WGU); d.ldwt = 2048; d.gain = INF(24); d.mode = 2; nb_ = 88; } \
        else if ((r_ -= I6) < I7) { d.W = INF(26); d.Nsrc = FF; d.WT = (bf16*)(ws + WS_WGU); d.ldwt = 2048; d.gain = INF(24); d.mode = 3; nb_ = 88; } \
        else if ((r_ -= I7) < I8) { d.W = INF(27); d.Nsrc = 2048; d.WT = (bf16*)(ws + WS_WDN); d.ldwt = FF; d.gain = nullptr; d.mode = 0; nb_ = 32; } \
        else if ((r_ -= I8) < I9) { d.W = INF(29); d.Nsrc = 2048; d.WT = (bf16*)(ws + WS_WPG); d.ldwt = 2048; d.gain = INF(28); d.mode = 0; nb_ = 32; } \
        else { r_ -= I9; d.W = INF(30); d.Nsrc = 2048; d.WT = (bf16*)(ws + WS_WPP); d.ldwt = 256; d.gain = nullptr; d.mode = 0; nb_ = 32; } \
        d.k0 = 64 * (r_ / nb_); d.n0 = 64 * (r_ % nb_); } while (0)
    { int it = gw; TDesc d; f32x4 r[16], g0, g1;
      if (it < NITEMS) { TR_DESC(d, it); tr_load(d, lane, r, g0, g1); }
      while (it < NITEMS) {
        tr_lds_write(scr, lane, r);
        const TDesc dc = d; const f32x4 h0 = g0, h1 = g1; const int nit = it + NGW;
        if (nit < NITEMS) { TR_DESC(d, nit); tr_load(d, lane, r, g0, g1); }
        LDS_WAIT(); asm volatile("" ::: "memory");
        tr_store(dc, scr, lane, h0, h1);
        LDS_WAIT(); asm volatile("" ::: "memory");
        it = nit; } }
#undef TR_DESC
    PSTAMP(16);
    { GAS v4u* z = (GAS v4u*)(ws + WS_WIN + (size_t)832 * 2048 * 2); const int n16 = 192 * 2048 * 2 / 16;
      for (int i = gw * 64 + lane; i < n16; i += NGW * 64) z[i] = (v4u){0u, 0u, 0u, 0u}; }
    PSTAMP(17);
    { const int n16 = 8 * 64 * 512 * 2 / 16;
      for (int i = gw * 64 + lane; i < n16; i += NGW * 64) { const int h = i >> 12, r = (i >> 6) & 63, c = i & 63; *(GAS v4u*)((bf16*)(ws + WS_WUQ) + (size_t)(256 * h + 192 + r) * 512 + c * 8) = (v4u){0u, 0u, 0u, 0u}; } }
    for (int r0 = gw; r0 < M; r0 += 4 * NGW) {
        f32x4 v[4][8];
#pragma unroll
        for (int q = 0; q < 4; ++q) { const int r = r0 + q * NGW < M ? r0 + q * NGW : r0; const GAS f32x4* xr = (const GAS f32x4*)(INF(0) + (size_t)r * D) + lane;
#pragma unroll
            for (int j = 0; j < 8; ++j) v[q][j] = __builtin_nontemporal_load(xr + 64 * j); }
#pragma unroll
        for (int q = 0; q < 4; ++q) { const int r = r0 + q * NGW; float s = 0.f;
#pragma unroll
            for (int j = 0; j < 8; ++j) s += (v[q][j][0] * v[q][j][0] + v[q][j][1] * v[q][j][1]) + (v[q][j][2] * v[q][j][2] + v[q][j][3] * v[q][j][3]);
            const float nrm = sqrtf(wave_sum(s) * (1.0f / D) + EPS), rs = 1.0f / nrm;
            if (r < M) { if (lane == 0) ((float*)(ws + RS0_OFF))[r] = nrm;
                GAS v2u* o = (GAS v2u*)((bf16*)(ws + WS_HN) + (size_t)r * D) + lane;
#pragma unroll
                for (int j = 0; j < 8; ++j) { v2u w; w.x = pk2(v[q][j][0] * rs, v[q][j][1] * rs); w.y = pk2(v[q][j][2] * rs, v[q][j][3] * rs); o[64 * j] = w; } } }
    }
    PSTAMP(18);
}
__device__ __forceinline__ void prologue_tables(KA args, LAS unsigned char* lds, int gw, int NGW) {
    unsigned char* ws = args->ws; const int lane = fresh_tid() & 63;
    { const GAS f32x4* p4 = (const GAS f32x4*)INF(1); GAS v2u* o = (GAS v2u*)(ws + WS_PB); const int n4 = M * PLE / 4;
      const int st = NGW * 64;
      for (int i0 = gw * 64 + lane; i0 < n4; i0 += 8 * st) { f32x4 v[8];
#pragma unroll
          for (int q = 0; q < 8; ++q) v[q] = __builtin_nontemporal_load(p4 + (i0 + q * st < n4 ? i0 + q * st : i0));
#pragma unroll
          for (int q = 0; q < 8; ++q) if (i0 + q * st < n4) { v2u w; w.x = pk2(v[q][0], v[q][1]); w.y = pk2(v[q][2], v[q][3]); o[i0 + q * st] = w; } } }
    { float* co = args->out + OUT_COS; float* si = args->out + OUT_SIN; const int* pos = (const int*)args->in[2];
      const int st = NGW * 64;
      for (int i0 = gw * 64 + lane; i0 < M * 32; i0 += 4 * st) { int pv[4];
#pragma unroll
          for (int q = 0; q < 4; ++q) pv[q] = pos[(i0 + q * st < M * 32 ? i0 + q * st : i0) >> 5];
#pragma unroll
          for (int q = 0; q < 4; ++q) { const int i = i0 + q * st; if (i < M * 32) { float sn, cs; sincosf((float)pv[q] * exp2f(-(float)(i & 31) * (13.287712379549449f / 32.0f)), &sn, &cs); co[i] = cs; si[i] = sn; } } } }
    PSTAMP(19);
    s5_tables(args, lds, gw, NGW);
    PSTAMP(20);
}

__device__ __forceinline__ void phase_prologue(KA args, LAS unsigned char* lds, int gw, int NGW, int wave) {
    const bool tables_first = ((blockIdx.x >> 3) & 1) != 0;
    if (tables_first) { prologue_tables(args, lds, gw, NGW); __syncthreads(); }
    prologue_streams(args, lds, gw, NGW, wave);
    if (!tables_first) { __syncthreads(); prologue_tables(args, lds, gw, NGW); }
}

__device__ __forceinline__ void phase_attn(KA args, char* lds) {
    unsigned char* ws = args->ws;
    const bf16* Q = (const bf16*)(ws + WS_Q); const bf16* K = (const bf16*)(ws + WS_K); const bf16* V = (const bf16*)(ws + WS_V); bf16* OA = (bf16*)(ws + WS_Z); float* sqa = (float*)(ws + SQ_A);
    for (int L = blockIdx.x; L < NB * NH * 4; L += gridDim.x) {
        const int bh = (L & 7) + 8 * (L >> 5), y = (L >> 3) & 3, b = bh / NH, h = bh % NH;
        for (int pass = 0; pass < 2; ++pass) { const int qb = pass ? 7 - y : y;
            att::attn_block(Q + ((size_t)bh * SEQ + qb * 256) * DQK, K + (size_t)bh * SEQ * DQK, V + (size_t)bh * SEQ * DV,
                            OA + ((size_t)(b * SEQ + qb * 256)) * 2048 + h * DV, 2048, sqa + b * SEQ + qb * 256, qb * 256, lds); }
    }
}

struct GroupOrder {
    int G, c;
    __device__ __forceinline__ bool next(int i, Unit& u) const { const int L = i * G + c; if (L >= NG * 4) return false; u.pm = L; u.pn = L >> 2; return true; }
    __device__ __forceinline__ void a_ready(const Unit&) const {}
    __device__ __forceinline__ void done(const Unit&) const {}
};
template <class Epi, bool ALIGN = PG8_ALIGN> __device__ __forceinline__ void run_gemm_grp(LAS unsigned char* lds, const bf16* A, int lda, const bf16* Bt, int ldb, int K, const Epi& E) {
    pg8::Gemm g{A, Bt, NG * SROWS, NG * 256, K, lda, ldb}; GroupOrder S{(int)gridDim.x, (int)blockIdx.x};
    pg8::gemm_phase<Epi, GroupOrder, ALIGN, PG8_SP2>(lds, g, S, E);
}
template <class Epi> __device__ __forceinline__ void run_gemm(LAS unsigned char* lds, const bf16* A, int lda, const bf16* Bt, int ldb, int N, int K, const Epi& E) {
    pg8::Gemm g{A, Bt, M, N, K, lda, ldb}; pg8::StaticOrder S; S.init(M, N, (int)gridDim.x, (int)blockIdx.x);
    pg8::gemm_phase<Epi, pg8::StaticOrder, PG8_ALIGN, PG8_SP2>(lds, g, S, E);
}

__global__ void __launch_bounds__(NWAVES * 64, 2) mega_fwd(Args kernel_args) {
    extern __shared__ __attribute__((aligned(16))) unsigned char lds_raw[];
    LAS unsigned char* lds = (LAS unsigned char*)lds_raw;
    volatile LAS unsigned* MISC = (volatile LAS unsigned*)(lds + MISC_OFF);
    const int wave = __builtin_amdgcn_readfirstlane((int)threadIdx.x >> 6);
    const int G = gridDim.x; const int bx = blockIdx.x; const int vcu = (G % 8 == 0) ? (bx % 8) * (G / 8) + bx / 8 : bx;
    const int gw = vcu * NWAVES + wave, NGW = G * NWAVES;
    unsigned char* ws0; int lo, hi; { KA args = get_ka(); ws0 = args->ws; lo = args->ph_lo; hi = args->ph_hi; }
    for (int u = fresh_tid(); u < (LDS_BYTES - 139264) / 4; u += NWAVES * 64) ((LAS unsigned*)(lds + 139264))[u] = 0u;
    __syncthreads();
    XcdBarrier bar; bar.bar = (unsigned*)(ws0 + WS_CTL) + CW_BAR; bar.x = 0; bar.st = nullptr; bar.members = 0; XcdBarrier barg = bar;
    if (hi - lo > 1) { bar = xcd_barrier_post((unsigned*)(ws0 + WS_CTL) + CW_BAR, MISC + 8, (unsigned)G);
        if ((G & 7) == 0) barg = xcd_barrier_post((unsigned*)(ws0 + WS_CTL) + CW_GBAR + (bx & 7) * 4096, MISC + 10, (unsigned)G / 8u); else barg = bar; }
#ifdef PROBE_A
#define STAMP(k) do { if (blockIdx.x == 0 && threadIdx.x == 0) ((unsigned long long*)(ws0 + 524288))[k] = __builtin_amdgcn_s_memrealtime(); } while (0)
#else
#define STAMP(k) do { } while (0)
#endif
#define IN(k) (lo <= (k) && (k) < hi)
#define SEAM(k) do { if (IN(k) && IN((k) + 1)) xcd_barrier(bar); STAMP((k) + 1); } while (0)
#define SEAMG(k) do { if (IN(k) && IN((k) + 1)) xcd_barrier(barg); STAMP((k) + 1); } while (0)
    STAMP(0);
#define PH_BEGIN KA args = get_ka(); unsigned char* ws = args->ws; float* sqq = (float*)(ws + SQ_Q); float* sqkv = (float*)(ws + SQ_KV); float* sqx1 = (float*)(ws + SQ_X1); float* sqx2 = (float*)(ws + SQ_X2); (void)sqq; (void)sqkv; (void)sqx1; (void)sqx2;

    if (IN(0)) { PH_BEGIN phase_prologue(args, lds, gw, NGW, wave); __syncthreads(); }
    SEAM(0);
    if (IN(1)) { PH_BEGIN s5_fill_w(args, gw, NGW);
        EpiZ E{(bf16*)(ws + WS_Z), (bf16*)(ws + WS_AS), sqq, sqkv, (float*)(ws + SQ_KR), (bf16*)(args->out + OUT_KR), args->out + OUT_COS, args->out + OUT_SIN, INF(10)}; run_gemm(lds, (const bf16*)(ws + WS_HN), D, (const bf16*)(ws + WS_WIN), D, 2048, D, E); }
    SEAM(1);
    if (IN(2)) { PH_BEGIN
        { EpiQ E{(bf16*)(ws + WS_Q), sqq, args->out + OUT_COS, args->out + OUT_SIN, INF(9), (LAS float*)(lds + RING_BYTES)}; run_gemm(lds, (const bf16*)(ws + WS_Z) + ZC_Q, ZLD, (const bf16*)(ws + WS_WUQ), QL, 2048, QL, E); }
        PSTAMP(21);
        { EpiKV E{(bf16*)(ws + WS_K), (bf16*)(ws + WS_V), sqkv, (const float*)(ws + SQ_KR), (const bf16*)(args->out + OUT_KR), INF(10), (LAS float*)(lds + RING_BYTES)}; run_gemm(lds, (const bf16*)(ws + WS_Z) + ZC_KV, ZLD, (const bf16*)(ws + WS_WUKV), KVL, 2048, KVL, E); }
        PSTAMP(22);
        { EpiE E{(bf16*)(ws + WS_AS), (const float*)(ws + WS_A16)}; run_gemm_grp<EpiE, false>(lds, (const bf16*)(ws + WS_AS), ASLD, (const bf16*)(ws + WS_PALL), 256, 256, E); }
        asm volatile("s_waitcnt vmcnt(0)" ::: "memory"); __syncthreads();
        PSTAMP(23);
        { EpiY E{(bf16*)(ws + WS_YG)}; run_gemm_grp(lds, (const bf16*)(ws + WS_AS), ASLD, (const bf16*)(ws + WS_WALL), ASLD, ASLD, E); }
    }
    SEAM(2);
    if (IN(3)) { PH_BEGIN
        { EpiGlu E{(const bf16*)(ws + WS_YG), INF(20), (bf16*)(ws + WS_Z) + 1024, (float*)(ws + SQ_S)}; run_gemm(lds, (const bf16*)(ws + WS_YG), SSMW, (const bf16*)(ws + WS_WGLU), SSMW, SSMW, SSMW, E); }
        PSTAMP(24); phase_attn(args, (char*)lds_raw); __syncthreads(); PSTAMP(25);
    }
    SEAM(3);
    if (IN(4)) { PH_BEGIN
        const bool pp_first = ((blockIdx.x >> 3) & 1) != 0;
        if (pp_first) { EpiPlain E{(bf16*)(ws + WS_PP), D}; run_gemm(lds, (const bf16*)(ws + WS_PB), PLE, (const bf16*)(ws + WS_WPP), PLE, D, PLE, E); }
        { EpiWo E{(const float*)(ws + RS0_OFF), (bf16*)(ws + WS_HN), sqx1, (const float*)(ws + SQ_A), (const float*)(ws + SQ_S)}; run_gemm(lds, (const bf16*)(ws + WS_Z), D, (const bf16*)(ws + WS_WO), D, D, D, E); }
        if (!pp_first) { EpiPlain E{(bf16*)(ws + WS_PP), D}; run_gemm(lds, (const bf16*)(ws + WS_PB), PLE, (const bf16*)(ws + WS_WPP), PLE, D, PLE, E); }
    }
    SEAMG(4);
    if (IN(5)) { PH_BEGIN
        { EpiGateUp E{(bf16*)(ws + WS_H), sqx1}; run_gemm(lds, (const bf16*)(ws + WS_HN), D, (const bf16*)(ws + WS_WGU), D, 2 * FF, D, E); }
    }
    SEAMG(5);
    if (IN(6)) { PH_BEGIN EpiDown E{(bf16*)(ws + WS_HN), sqx2}; run_gemm(lds, (const bf16*)(ws + WS_H), FF, (const bf16*)(ws + WS_WDN), FF, D, FF, E); }
    SEAMG(6);
    if (IN(7)) { PH_BEGIN EpiPle E{args->out, (const bf16*)(ws + WS_HN), (const bf16*)(ws + WS_PP), sqx2}; run_gemm(lds, (const bf16*)(ws + WS_HN), D, (const bf16*)(ws + WS_WPG), D, D, D, E); }
#ifdef PROBE_A
    xcd_barrier(bar); STAMP(NPHASES);
    if (blockIdx.x == 0 && threadIdx.x == 0) { const unsigned long long* st = (const unsigned long long*)(ws0 + 524288);
        const unsigned long long t1 = st[NPHASES], d = 8ull * (st[PROBE_B] - st[PROBE_A]);
        while (__builtin_amdgcn_s_memrealtime() - t1 < d) __builtin_amdgcn_s_sleep(8); }
#endif
#undef IN
#undef SEAM
#undef SEAMG
}

extern "C" void kernel_launch(void* const* d_in, const int* in_sizes, int n_in, void* d_out, int out_size, void* d_ws, size_t ws_size, hipStream_t stream) {
    static int grid = 0;
    if (grid == 0) {
        if (n_in != 31 || out_size != M * D || ws_size < WS_END) { fprintf(stderr, "kernel_launch: unexpected shapes (n_in %d, out %d, ws %zu)\n", n_in, out_size, ws_size); grid = -1; return; }
        int dev = 0, cus = 0;
        if (hipGetDevice(&dev) != hipSuccess || hipDeviceGetAttribute(&cus, hipDeviceAttributeMultiprocessorCount, dev) != hipSuccess) { grid = -1; return; }
        if (hipFuncSetAttribute((const void*)mega_fwd, hipFuncAttributeMaxDynamicSharedMemorySize, LDS_BYTES) != hipSuccess) { fprintf(stderr, "kernel_launch: hipFuncSetAttribute failed\n"); grid = -1; return; }
        int per_cu = 0;
        if (hipOccupancyMaxActiveBlocksPerMultiprocessor(&per_cu, (const void*)mega_fwd, NWAVES * 64, LDS_BYTES) != hipSuccess || per_cu < 1) fprintf(stderr, "kernel_launch: occupancy query says %d blocks/CU\n", per_cu);
        (void)hipGetLastError();
        grid = cus > 0 ? cus : 256;
    }
    if (grid < 0) return;
    (void)hipMemsetAsync((char*)d_ws + WS_CTL, 0, CTL_ZERO_BYTES, stream);
    Args a{};
    for (int i = 0; i < 31; ++i) a.in[i] = d_in[i];
    a.out = (float*)d_out; a.ws = (unsigned char*)d_ws;
    constexpr int NL = MK_N_LAUNCHES;
    for (int li = 0; li < NL; ++li) {
        a.ph_lo = (NL == 1) ? 0 : li; a.ph_hi = (NL == 1) ? NPHASES : li + 1;
        hipLaunchKernelGGL(mega_fwd, dim3(grid), dim3(NWAVES * 64), LDS_BYTES, stream, a);
    }
}
```

```cpp
#include <hip/hip_runtime.h>
#include <cstdio>
#include <cstdint>
namespace pg8 {
#define PG8_LAS __attribute__((address_space(3)))
typedef unsigned short bf16_t;
typedef short bf16x8 __attribute__((ext_vector_type(8)));
typedef float f32x4 __attribute__((ext_vector_type(4)));
typedef unsigned u32x4 __attribute__((ext_vector_type(4)));
typedef int i32x8 __attribute__((ext_vector_type(8)));
constexpr int BM = 256, BK = 64, HALF = 128, HTB = HALF * BK * 2  , STAGE_BYTES = 8 * HTB, NXCD = 8, WGM = 2;

__host__ __device__ __forceinline__ int lds_byte(int r, int c) { const int st = (r >> 4) * 2 + (c >> 5), rr = r & 15, cc = c & 31, ob = rr * 64 + cc * 2; return st * 1024 + (ob ^ (((ob >> 9) & 1) << 5)); }
__host__ __device__ __forceinline__ void stage_rc(int b, int& R, int& C) { const int st = b / 1024, sb = b % 1024, swz = sb ^ (((sb >> 9) & 1) << 5); R = (st >> 1) * 16 + swz / 64; C = (st & 1) * 32 + (swz % 64) / 2; }
__host__ __device__ __forceinline__ int perm32(int rho) { const int n = rho >> 4, i = rho & 15; return 8 * (i >> 2) + 4 * n + (i & 3); }

struct Unit { int pm, pn; };
struct Gemm { const bf16_t* A; const bf16_t* Bt; int M, N, K, lda, ldb; };

struct StaticOrder {
    int nM, nN, nwg, G, c;
    __host__ __device__ void init(int M, int N, int G_, int c_) { nM = M / BM; nN = N / BM; nwg = nM * nN; G = G_; c = c_; }
    __host__ __device__ bool next(int i, Unit& u) const {
        const long L = (long)i * G + c; if (L >= nwg) return false;
        int wgid = (int)L; { const int q = nwg / NXCD, r = nwg % NXCD, xcd = wgid % NXCD, off = wgid / NXCD; wgid = (xcd < r ? xcd * (q + 1) : r * (q + 1) + (xcd - r) * q) + off; }
        const int nig = WGM * nN, gid = wgid / nig, fm = gid * WGM, gsz = (nM - fm) < WGM ? (nM - fm) : WGM;
        u.pm = fm + ((wgid % nig) % gsz); u.pn = (wgid % nig) / gsz; return true;
    }
    __device__ __forceinline__ void a_ready(const Unit&) const {}
    __device__ __forceinline__ void done(const Unit&) const {}
};

__device__ __forceinline__ unsigned cvt_pk_bf16(float lo, float hi) { unsigned r; asm volatile("v_cvt_pk_bf16_f32 %0, %1, %2" : "=v"(r) : "v"(lo), "v"(hi)); return r; }
typedef float f32x2 __attribute__((ext_vector_type(2)));
template <class Epi, class Sched, bool ALIGN_EPI = false, bool SP2 = false>
__device__ __forceinline__ void gemm_phase(PG8_LAS unsigned char* lds, const Gemm g, const Sched& S, const Epi& E) {
    int tid_ = threadIdx.x; asm volatile("" : "+v"(tid_));
    const int tid = tid_, wid = __builtin_amdgcn_readfirstlane(tid >> 6), lane = tid & 63, wr = wid >> 2, wc = wid & 3, fr = lane & 15, fq = lane >> 4;
    const int K = g.K; int nt_ = K / BK; asm volatile("" : "+s"(nt_)); const int nt = nt_;
    unsigned voffA[2], voffB[2];
#pragma unroll
    for (int i = 0; i < 2; ++i) { int R, C; stage_rc(tid * 16 + i * 8192, R, C); const int Rb = Epi::PERM ? ((R & ~31) + perm32(R & 31)) : R;
        voffA[i] = Epi::AGRP ? (unsigned)((C >> 4) * g.lda + R * 16 + (C & 15)) * 2u : (unsigned)(R * g.lda + C) * 2u; voffB[i] = (unsigned)(Rb * g.ldb + C) * 2u; }
    const size_t kstep = (size_t)(BK * 2);
    const size_t kstepA = Epi::AGRP ? (size_t)(BK / 16) * g.lda * 2 : kstep;
    const size_t hstepA = Epi::AGRP ? (size_t)HALF * 16 * 2 : (size_t)HALF * g.lda * 2, hstepB = (size_t)HALF * g.ldb * 2;
    const size_t tstepA = 2 * hstepA, tstepB = 2 * hstepB;
    const unsigned ldsw = (unsigned)wid * 1024u;
    const int aoff = lds_byte(wr * 64 + fr, fq * 8), boff = lds_byte(wc * 32 + fr, fq * 8);
#define PG8_SA(b, h) (((b) * 2 + (h)) * HTB)
#define PG8_SB(b, h) ((4 + (b) * 2 + (h)) * HTB)
#define PG8_STAGE(bufoff, gbase, voff) do { _Pragma("unroll") for (int _i = 0; _i < 2; ++_i) \
        __builtin_amdgcn_global_load_lds((const unsigned*)((const char*)(gbase) + (voff)[_i]), (PG8_LAS unsigned*)(lds + (bufoff) + ldsw + _i * 8192), 16, 0, 0); } while (0)
#define PG8_LDA(dst, b, h) do { _Pragma("unroll") for (int m = 0; m < 4; ++m) _Pragma("unroll") for (int k = 0; k < 2; ++k) dst[m][k] = *(const PG8_LAS bf16x8*)(lds + PG8_SA(b, h) + aoff + m * 2048 + k * 1024); } while (0)
#define PG8_LDB(dst, b, h) do { _Pragma("unroll") for (int n = 0; n < 2; ++n) _Pragma("unroll") for (int k = 0; k < 2; ++k) dst[n][k] = *(const PG8_LAS bf16x8*)(lds + PG8_SB(b, h) + boff + n * 2048 + k * 1024); } while (0)
#define PG8_CAT8(x, y) __builtin_bit_cast(i32x8, __builtin_shufflevector(x, y, 0, 1, 2, 3, 4, 5, 6, 7, 8, 9, 10, 11, 12, 13, 14, 15))
#define PG8_MMA(ai, bj, At, Bt) do { __builtin_amdgcn_s_setprio(1); _Pragma("unroll") for (int m = 0; m < 4; ++m) _Pragma("unroll") for (int n = 0; n < 2; ++n) { \
        if constexpr (Epi::F8) acc[ai][bj][m][n] = __builtin_amdgcn_mfma_scale_f32_16x16x128_f8f6f4(PG8_CAT8(Bt[n][0], Bt[n][1]), PG8_CAT8(At[m][0], At[m][1]), acc[ai][bj][m][n], 0, 0, 0, 0x7F7F7F7F, 0, 0x7F7F7F7F); \
        else { _Pragma("unroll") for (int k = 0; k < 2; ++k) acc[ai][bj][m][n] = __builtin_amdgcn_mfma_f32_16x16x32_bf16(Bt[n][k], At[m][k], acc[ai][bj][m][n], 0, 0, 0); } } \
        __builtin_amdgcn_s_setprio(0); } while (0)
#define PG8_WAIT_V(n) asm volatile("s_waitcnt vmcnt(" #n ")" ::: "memory")
#define PG8_WAIT_L(n) asm volatile("s_waitcnt lgkmcnt(" #n ")" ::: "memory")
#define PG8_BAR __builtin_amdgcn_s_barrier()
#define PG8_SCHED __builtin_amdgcn_sched_barrier(0)
    Unit cur, nxt; int ui = 0;
    if (!S.next(0, cur)) return;
    f32x4 acc[2][2][4][2];
#pragma unroll
    for (int a = 0; a < 2; ++a)
#pragma unroll
        for (int b = 0; b < 2; ++b)
#pragma unroll
            for (int m = 0; m < 4; ++m)
#pragma unroll
                for (int n = 0; n < 2; ++n) acc[a][b][m][n] = (f32x4){0.f, 0.f, 0.f, 0.f};
    bf16x8 At[4][2], B0[2][2], B1[2][2];
    const char* cA = (const char*)g.A + (size_t)cur.pm * tstepA; const char* cB = (const char*)g.Bt + (size_t)cur.pn * tstepB;
    S.a_ready(cur);
    if constexpr (SP2) {
        PG8_STAGE(PG8_SB(0, 0), cB, voffB); PG8_STAGE(PG8_SB(0, 1), cB + hstepB, voffB); PG8_STAGE(PG8_SA(0, 0), cA, voffA); PG8_STAGE(PG8_SA(0, 1), cA + hstepA, voffA);
        if (wr == 1) PG8_BAR;
        PG8_WAIT_V(2); PG8_BAR;
        PG8_STAGE(PG8_SB(1, 0), cB + kstep, voffB); PG8_STAGE(PG8_SA(1, 0), cA + kstepA, voffA); PG8_STAGE(PG8_SB(1, 1), cB + hstepB + kstep, voffB);
        PG8_WAIT_V(6); PG8_BAR;
    } else {
        PG8_STAGE(PG8_SB(0, 0), cB, voffB); PG8_STAGE(PG8_SA(0, 0), cA, voffA); PG8_STAGE(PG8_SB(0, 1), cB + hstepB, voffB); PG8_STAGE(PG8_SA(0, 1), cA + hstepA, voffA);
        if (wr == 1) PG8_BAR;
        PG8_WAIT_V(4); PG8_BAR;
        PG8_STAGE(PG8_SB(1, 0), cB + kstep, voffB); PG8_STAGE(PG8_SA(1, 0), cA + kstepA, voffA); PG8_STAGE(PG8_SB(1, 1), cB + hstepB + kstep, voffB);
        PG8_WAIT_V(6); PG8_BAR;
    }
    for (;;) {
        const bool has_next = S.next(ui + 1, nxt);
        const char* nA = has_next ? (const char*)g.A + (size_t)nxt.pm * tstepA : cA; const char* nB = has_next ? (const char*)g.Bt + (size_t)nxt.pn * tstepB : cB;
        for (int t = 0; t < nt; t += 2) {
            const bool last = (t == nt - 2);
            if constexpr (Epi::MIDK > 0) { if (t == Epi::MIDK) E.mid(acc, cur, wr, wc, fr, fq); }
            const char* a1 = cA + (size_t)(t + 1) * kstepA;
            const char* a2 = last ? nA : cA + (size_t)(t + 2) * kstepA; const char* b2 = last ? nB : cB + (size_t)(t + 2) * kstep;
            const char* a3 = a2 + kstepA; const char* b3 = b2 + kstep;
            { asm volatile("" : "+s"(a1), "+s"(a2), "+s"(b2), "+s"(a3), "+s"(b3)); }
            if (last && has_next) S.a_ready(nxt);
            if constexpr (SP2) {
            PG8_LDB(B0, 0, 0); PG8_LDB(B1, 0, 1); PG8_SCHED; PG8_LDA(At, 0, 0); PG8_STAGE(PG8_SA(1, 1), a1 + hstepA, voffA);
            PG8_WAIT_V(8); PG8_WAIT_L(0); PG8_BAR; PG8_MMA(0, 0, At, B0); PG8_MMA(0, 1, At, B1); PG8_BAR; PG8_SCHED;
            PG8_LDA(At, 0, 1); PG8_STAGE(PG8_SB(0, 0), b2, voffB); PG8_STAGE(PG8_SB(0, 1), b2 + hstepB, voffB); PG8_STAGE(PG8_SA(0, 0), a2, voffA);
            PG8_WAIT_V(8); PG8_WAIT_L(0); PG8_BAR; PG8_MMA(1, 0, At, B0); PG8_MMA(1, 1, At, B1); PG8_BAR; PG8_SCHED;
            PG8_LDB(B0, 1, 0); PG8_LDB(B1, 1, 1); PG8_SCHED; PG8_LDA(At, 1, 0); PG8_STAGE(PG8_SA(0, 1), a2 + hstepA, voffA);
            PG8_WAIT_V(8); PG8_WAIT_L(0); PG8_BAR; PG8_MMA(0, 0, At, B0); PG8_MMA(0, 1, At, B1); PG8_BAR; PG8_SCHED;
            PG8_LDA(At, 1, 1); PG8_STAGE(PG8_SB(1, 0), b3, voffB); PG8_STAGE(PG8_SB(1, 1), b3 + hstepB, voffB); PG8_STAGE(PG8_SA(1, 0), a3, voffA);
            PG8_WAIT_V(8); PG8_WAIT_L(0); PG8_BAR; PG8_MMA(1, 0, At, B0); PG8_MMA(1, 1, At, B1); PG8_BAR; PG8_SCHED;
            } else {
            PG8_LDB(B0, 0, 0); PG8_SCHED; PG8_LDA(At, 0, 0); PG8_STAGE(PG8_SA(1, 1), a1 + hstepA, voffA);
            PG8_WAIT_L(8); PG8_BAR; PG8_WAIT_L(0); PG8_MMA(0, 0, At, B0); PG8_BAR; PG8_SCHED;
            PG8_LDB(B1, 0, 1); PG8_STAGE(PG8_SB(0, 0), b2, voffB);
            PG8_BAR; PG8_WAIT_L(0); PG8_MMA(0, 1, At, B1); PG8_BAR;
            PG8_LDA(At, 0, 1); PG8_STAGE(PG8_SA(0, 0), a2, voffA);
            PG8_BAR; PG8_WAIT_L(0); PG8_MMA(1, 0, At, B0); PG8_BAR; PG8_SCHED;
            PG8_STAGE(PG8_SB(0, 1), b2 + hstepB, voffB);
            PG8_WAIT_V(6); PG8_BAR; PG8_MMA(1, 1, At, B1); PG8_BAR;
            PG8_LDB(B0, 1, 0); PG8_SCHED; PG8_LDA(At, 1, 0); PG8_STAGE(PG8_SA(0, 1), a2 + hstepA, voffA);
            PG8_WAIT_L(8); PG8_BAR; PG8_WAIT_L(0); PG8_MMA(0, 0, At, B0); PG8_BAR; PG8_SCHED;
            PG8_LDB(B1, 1, 1); PG8_STAGE(PG8_SB(1, 0), b3, voffB);
            PG8_BAR; PG8_WAIT_L(0); PG8_MMA(0, 1, At, B1); PG8_BAR;
            PG8_LDA(At, 1, 1); PG8_STAGE(PG8_SA(1, 0), a3, voffA);
            PG8_BAR; PG8_WAIT_L(0); PG8_MMA(1, 0, At, B0); PG8_BAR; PG8_SCHED;
            PG8_STAGE(PG8_SB(1, 1), b3 + hstepB, voffB);
            PG8_WAIT_V(6); PG8_BAR; PG8_MMA(1, 1, At, B1); PG8_BAR;
            }
        }
        if constexpr (ALIGN_EPI) { if (wr == 0) PG8_BAR; }
        if constexpr (!Epi::AFTER_DRAIN) { E(acc, cur, wr, wc, fr, fq); S.done(cur); }
        if (!has_next) break;
        { f32x4 zz; asm volatile("v_mov_b32 %0, 0\n\tv_mov_b32 %1, 0\n\tv_mov_b32 %2, 0\n\tv_mov_b32 %3, 0\n\ts_nop 3" : "=v"(zz[0]), "=v"(zz[1]), "=v"(zz[2]), "=v"(zz[3]));
#pragma unroll
        for (int a = 0; a < 2; ++a)
#pragma unroll
            for (int b = 0; b < 2; ++b)
#pragma unroll
                for (int m = 0; m < 4; ++m)
#pragma unroll
                    for (int n = 0; n < 2; ++n) asm volatile("v_mfma_f32_16x16x32_bf16 %0, %1, %1, 0" : "=&v"(acc[a][b][m][n]) : "v"(zz)); }
        cur = nxt; cA = nA; cB = nB; ++ui;
        if constexpr (ALIGN_EPI) { if (wr == 1) PG8_BAR; }
    }
    PG8_WAIT_V(0);
    if constexpr (!ALIGN_EPI) { if (wr == 0) PG8_BAR; }
    PG8_BAR;
    if constexpr (Epi::AFTER_DRAIN) { E.fused(acc, cur, wr, wc, fr, fq, lds, wid, lane); S.done(cur); }
#undef PG8_SA
#undef PG8_SB
#undef PG8_STAGE
#undef PG8_LDA
#undef PG8_LDB
#undef PG8_MMA
#undef PG8_CAT8
#undef PG8_WAIT_V
#undef PG8_WAIT_L
#undef PG8_BAR
#undef PG8_SCHED
}
}

namespace att {
typedef short bf16x8 __attribute__((ext_vector_type(8)));
typedef short s16x4 __attribute__((ext_vector_type(4)));
typedef float f32x16 __attribute__((ext_vector_type(16)));
typedef unsigned u32x4 __attribute__((ext_vector_type(4)));
typedef unsigned short bf16;
constexpr int DQK = 192, DV = 128, KROW = 384, SHM_K = 64 * KROW, SHM_V = 64 * DV * 2;
constexpr int V_OFF = 0, K_OFF = 2 * SHM_V, WS_OFF = 2 * SHM_V + 2 * SHM_K, ATT_LDS = WS_OFF + 8 * 64 * 4;
constexpr float SCALE = 0.07216878364870322f, THR = 8.f;
#define ATT_KSWZ(row, colB) ((row) * 384 + ((colB) ^ (((row) & 7) << 4)))
#define ATT_SBAR() __builtin_amdgcn_sched_barrier(0)
__device__ __forceinline__ int v_st(int k, int c) { const int kk = (k & ~0xC) | ((k & 4) << 1) | ((k & 8) >> 1); return ((kk >> 3) * 4 + (c >> 5)) * 512 + ((kk & 7) * 32 + (c & 31)) * 2; }
__device__ __forceinline__ int v_rd_base(int lane) { return ((lane & 3) << 3) | (((lane >> 2) & 3) << 6) | (((lane >> 4) & 1) << 5) | (((lane >> 5) & 1) << 8); }
constexpr int v_rd_off(int d0, int ks, int half) { return d0 * 512 + ks * 4096 + half * 2048; }
__device__ __forceinline__ int crow(int r, int hi) { return (r & 3) + 8 * (r >> 2) + 4 * hi; }
__device__ __forceinline__ unsigned cvtpk(float lo, float hi) { unsigned r; asm volatile("v_cvt_pk_bf16_f32 %0, %1, %2" : "=v"(r) : "v"(lo), "v"(hi)); return r; }
__device__ __forceinline__ void mask_tile(f32x16& p0, f32x16& p1, int dq) {
    const float NEG = -__builtin_inff();
#pragma unroll
    for (int r = 0; r < 16; ++r) { const int c = (r & 3) + 8 * (r >> 2); if (dq - c < 0) p0[r] = NEG; if (dq - c - 32 < 0) p1[r] = NEG; }
}
__device__ __forceinline__ void partialSM(f32x16& p0, f32x16& p1, float& m_reg, float& mn, float& alpha) {
    float pmax = p0[0];
#pragma unroll
    for (int r = 1; r < 16; ++r) pmax = fmaxf(pmax, p0[r]);
#pragma unroll
    for (int r = 0; r < 16; ++r) pmax = fmaxf(pmax, p1[r]);
    { auto rr = __builtin_amdgcn_permlane32_swap(__float_as_uint(pmax), __float_as_uint(pmax), false, false);
      pmax = fmaxf(__uint_as_float(rr[0]), __uint_as_float(rr[1])); }
    constexpr float C2 = 1.4426950408889634f * SCALE;
    if (__builtin_expect(__all((pmax - m_reg) * SCALE <= THR), 1)) { mn = m_reg; alpha = 1.f; }
    else { mn = fmaxf(m_reg, pmax); alpha = __builtin_amdgcn_exp2f((m_reg - mn) * C2); m_reg = mn; }
    const float mnL = -mn * C2;
#pragma unroll
    for (int r = 0; r < 16; ++r) p0[r] = fmaf(p0[r], C2, mnL);
#pragma unroll
    for (int r = 0; r < 16; ++r) p1[r] = fmaf(p1[r], C2, mnL);
#pragma unroll
    for (int r = 0; r < 16; ++r) p0[r] = __builtin_amdgcn_exp2f(p0[r]);
}
__device__ __forceinline__ void finishSM(f32x16& p0, f32x16& p1, float alpha, float& l_reg, bf16x8& pa0, bf16x8& pa1, bf16x8& pa2, bf16x8& pa3) {
#pragma unroll
    for (int r = 0; r < 16; ++r) p1[r] = __builtin_amdgcn_exp2f(p1[r]);
    float ps = 0;
#pragma unroll
    for (int r = 0; r < 16; ++r) ps += p0[r];
#pragma unroll
    for (int r = 0; r < 16; ++r) ps += p1[r];
    { auto rr = __builtin_amdgcn_permlane32_swap(__float_as_uint(ps), __float_as_uint(ps), false, false);
      ps = __uint_as_float(rr[0]) + __uint_as_float(rr[1]); }
    l_reg = l_reg * alpha + ps;
#define ATT_PK4(P, B_, OUT) do { unsigned a0 = cvtpk(P[B_+0], P[B_+1]), a1 = cvtpk(P[B_+2], P[B_+3]);                          \
        unsigned b0 = cvtpk(P[B_+4], P[B_+5]), b1 = cvtpk(P[B_+6], P[B_+7]);                                             \
        auto r0 = __builtin_amdgcn_permlane32_swap(a0, b0, false, false); auto r1 = __builtin_amdgcn_permlane32_swap(a1, b1, false, false); \
        u32x4 w = {r0[0], r1[0], r0[1], r1[1]}; OUT = *reinterpret_cast<bf16x8*>(&w); } while (0)
    ATT_PK4(p0, 0, pa0); ATT_PK4(p0, 8, pa1); ATT_PK4(p1, 0, pa2); ATT_PK4(p1, 8, pa3);
#undef ATT_PK4
}
template <int KB>
__device__ __forceinline__ void qkt(f32x16& p0, f32x16& p1, const char* K_lds, int r32, int hi, const bf16x8* qr) {
    p0 = f32x16{}; p1 = f32x16{};
    const char* kb[4];
#pragma unroll
    for (int dd = 0; dd < 4; ++dd) kb[dd] = K_lds + KB * SHM_K + ATT_KSWZ(r32, (dd * 16 + hi * 8) * 2);
#pragma unroll
    for (int d0 = 0; d0 < 12; ++d0) { const char* a = kb[d0 & 3] + (d0 >> 2) * 128;
        bf16x8 b0 = *reinterpret_cast<const bf16x8*>(a);
        bf16x8 b1 = *reinterpret_cast<const bf16x8*>(a + 32 * KROW);
        p0 = __builtin_amdgcn_mfma_f32_32x32x16_bf16(b0, qr[d0], p0, 0, 0, 0);
        p1 = __builtin_amdgcn_mfma_f32_32x32x16_bf16(b1, qr[d0], p1, 0, 0, 0); }
}
template <int VB>
__device__ __forceinline__ void pv_tile(f32x16* o, int vb0, bf16x8 pa0, bf16x8 pa1, bf16x8 pa2, bf16x8 pa3) {
#define ATT_TRRD(dst, off) asm volatile("ds_read_b64_tr_b16 %0, %1 offset:%2" : "=&v"(dst) : "v"(vb0), "i"(off) : "memory")
#define ATT_PV_D0(d0) do { s16x4 l0, l1, l2, l3, h0, h1, h2, h3; constexpr int b_ = V_OFF + VB * SHM_V + v_rd_off(d0, 0, 0); \
        ATT_TRRD(l0, b_); ATT_TRRD(h0, b_ + 2048); ATT_TRRD(l1, b_ + 4096); ATT_TRRD(h1, b_ + 6144); ATT_TRRD(l2, b_ + 8192); ATT_TRRD(h2, b_ + 10240); ATT_TRRD(l3, b_ + 12288); ATT_TRRD(h3, b_ + 14336); \
        asm volatile("s_waitcnt lgkmcnt(0)" ::: "memory"); ATT_SBAR();   \
        o[d0] = __builtin_amdgcn_mfma_f32_32x32x16_bf16((bf16x8){l0[0], l0[1], l0[2], l0[3], h0[0], h0[1], h0[2], h0[3]}, pa0, o[d0], 0, 0, 0);   \
        o[d0] = __builtin_amdgcn_mfma_f32_32x32x16_bf16((bf16x8){l1[0], l1[1], l1[2], l1[3], h1[0], h1[1], h1[2], h1[3]}, pa1, o[d0], 0, 0, 0);   \
        o[d0] = __builtin_amdgcn_mfma_f32_32x32x16_bf16((bf16x8){l2[0], l2[1], l2[2], l2[3], h2[0], h2[1], h2[2], h2[3]}, pa2, o[d0], 0, 0, 0);   \
        o[d0] = __builtin_amdgcn_mfma_f32_32x32x16_bf16((bf16x8){l3[0], l3[1], l3[2], l3[3], h3[0], h3[1], h3[2], h3[3]}, pa3, o[d0], 0, 0, 0); } while (0)
    ATT_PV_D0(0); ATT_PV_D0(1); ATT_PV_D0(2); ATT_PV_D0(3);
#undef ATT_PV_D0
#undef ATT_TRRD
}

__device__ __forceinline__ void attn_block(const bf16* Qb, const bf16* Kh, const bf16* Vh, bf16* Ob, int ldo, float* sqrow  , int P0, char* lds) {
    const int tid = threadIdx.x, wid = __builtin_amdgcn_readfirstlane(tid >> 6), lane = tid & 63, r32 = lane & 31, hi = lane >> 5;
    const int NT = (P0 + 256) / 64;
    const int qlo = P0 + wid * 32, qm = qlo + r32 - 4 * hi;
    char* V_lds = lds + V_OFF; char* K_lds = lds + K_OFF;
    float m_reg = -1e30f, l_reg = 0.f; f32x16 o[4] = {};
    bf16x8 qr[12];
#pragma unroll
    for (int d0 = 0; d0 < 12; ++d0) qr[d0] = *reinterpret_cast<const bf16x8*>((const char*)Qb + (unsigned)(((wid * 32 + r32) * DQK + hi * 8) * 2) + d0 * 32);
    const int krow = tid >> 3, kws0 = ATT_KSWZ(krow, (tid & 7) * 16);
    const int sr = tid >> 4, sc = (tid & 15) * 8, vst0 = v_st(sr, sc);
    const int vb0 = (int)(uintptr_t)V_lds + v_rd_base(lane);
    bf16x8 st_k0, st_k1, st_k2, st_v0, st_v1;
    const unsigned kgo = (unsigned)(krow * KROW + (tid & 7) * 16), vgo = (unsigned)((sr * DV + sc) * 2);
#define ATT_SLOAD(t) do { const char* kp_ = (const char*)Kh + (size_t)(t) * (64 * KROW) + kgo; const char* vp_ = (const char*)Vh + (size_t)(t) * (64 * DV * 2) + vgo; \
        st_k0 = *reinterpret_cast<const bf16x8*>(kp_); st_k1 = *reinterpret_cast<const bf16x8*>(kp_ + 128); st_k2 = *reinterpret_cast<const bf16x8*>(kp_ + 256); \
        st_v0 = *reinterpret_cast<const bf16x8*>(vp_); st_v1 = *reinterpret_cast<const bf16x8*>(vp_ + 32 * DV * 2); } while (0)
#define ATT_SWRITE(bf) do { *(bf16x8*)(K_lds + (bf) * SHM_K + kws0) = st_k0; *(bf16x8*)(K_lds + (bf) * SHM_K + kws0 + 128) = st_k1; *(bf16x8*)(K_lds + (bf) * SHM_K + kws0 + 256) = st_k2; \
        *(bf16x8*)(V_lds + (bf) * SHM_V + vst0) = st_v0; *(bf16x8*)(V_lds + (bf) * SHM_V + vst0 + 8192) = st_v1; } while (0)
#define ATT_RESC(a) do { if (__any((a) < 1.f)) { _Pragma("unroll") for (int d_ = 0; d_ < 4; ++d_) _Pragma("unroll") for (int r = 0; r < 16; ++r) o[d_][r] *= (a); } } while (0)
    ATT_SLOAD(0); ATT_SWRITE(0);
    __syncthreads();
#pragma unroll
    for (int d0 = 0; d0 < 12; ++d0) asm volatile("" : "+v"(qr[d0]));
    f32x16 p0, p1; float mn, alpha; bf16x8 pa0, pa1, pa2, pa3;
#define ATT_STEP(BF, t) do { \
        if ((t) + 1 < NT) ATT_SLOAD((t) + 1); \
        if ((t) * 64 <= qlo + 31) {        \
        ATT_SBAR(); qkt<BF>(p0, p1, K_lds, r32, hi, qr); \
        { const int kb_ = (t) * 64; if (kb_ + 63 > qlo) mask_tile(p0, p1, qm - kb_); } \
        partialSM(p0, p1, m_reg, mn, alpha); ATT_RESC(alpha); \
        finishSM(p0, p1, alpha, l_reg, pa0, pa1, pa2, pa3); ATT_SBAR(); } \
        if ((t) + 1 < NT) ATT_SWRITE((BF) ^ 1);        \
        if ((t) * 64 <= qlo + 31) { ATT_SBAR(); pv_tile<BF>(o, vb0, pa0, pa1, pa2, pa3); } \
        __syncthreads(); } while (0)
    for (int t = 0; t < NT; t += 2) { ATT_STEP(0, t); ATT_STEP(1, t + 1); }
    { const float rl = __builtin_amdgcn_rcpf(l_reg);
      char* Ow = (char*)Ob + (size_t)(wid * 32 + r32) * ldo * 2 + hi * 16;
      float s2 = 0.f;
#pragma unroll
      for (int d0 = 0; d0 < 4; ++d0)
#pragma unroll
        for (int pr = 0; pr < 2; ++pr) { float v[8];
#pragma unroll
            for (int j = 0; j < 8; ++j) { v[j] = o[d0][8 * pr + j] * rl; s2 = fmaf(v[j], v[j], s2); }
            const unsigned a0 = cvtpk(v[0], v[1]), a1 = cvtpk(v[2], v[3]), b0 = cvtpk(v[4], v[5]), b1 = cvtpk(v[6], v[7]);
            auto r0 = __builtin_amdgcn_permlane32_swap(a0, b0, false, false); auto r1 = __builtin_amdgcn_permlane32_swap(a1, b1, false, false);
            u32x4 w = {r0[0], r1[0], r0[1], r1[1]};
            *(u32x4*)(Ow + (d0 * 32 + 16 * pr) * 2) = w; }
      { auto rr = __builtin_amdgcn_permlane32_swap(__float_as_uint(s2), __float_as_uint(s2), false, false); s2 = __uint_as_float(rr[0]) + __uint_as_float(rr[1]); }
      if (hi == 0) atomicAdd(sqrow + wid * 32 + r32, s2); }
    __syncthreads();
#undef ATT_SLOAD
#undef ATT_SWRITE
#undef ATT_RESC
#undef ATT_STEP
}
}

#ifndef PG8_SP2
#define PG8_SP2 true
#endif
#ifndef PG8_ALIGN
#define PG8_ALIGN true
#endif
#ifndef MK_N_LAUNCHES
#define MK_N_LAUNCHES 1
#endif

constexpr int M = 16384, SEQ = 2048, NB = 8, D = 2048, NH = 8, DQK = 192, DV = 128;
constexpr int QL = 512, KVL = 256, NG = 64, GH = 16, NP = 64, FF = 5632, PLE = 256, SSMW = 1024;
constexpr float EPS = 1e-6f;
constexpr int ZC_Q = 0, ZC_KV = 512, ZC_KR = 768, ZLD = 1024;
constexpr int TC = 16, NCH = SEQ / TC, ASLD = 384, SROWS = NB * NCH;
constexpr int NPHASES = 8;

constexpr size_t MiB = 1u << 20;
constexpr size_t WS_CTL = 0, CTL_ZERO_BYTES = 1 * MiB;
constexpr float F8_SA = 4.0f, F8_SW = 128.0f;
constexpr int CW_BAR = 4096, CW_GBAR = 163840;
constexpr int CW_BAR_UNUSED = 0;
constexpr size_t SQ_Q = 65536 * 1, SQ_KV = 65536 * 2, SQ_X1 = 65536 * 3, SQ_X2 = 65536 * 4, SQ_A = 65536 * 5, SQ_S = 65536 * 6, SQ_KR = 65536 * 7, RS0_OFF = 65536 * 9;
constexpr size_t OUT_COS = 0, OUT_SIN = (size_t)16384 * 32, OUT_KR = (size_t)16384 * 64;
constexpr size_t WS_A16 = 1 * MiB;
constexpr size_t WS_WIN = 2 * MiB, WS_WUQ = 10 * MiB, WS_WUKV = 12 * MiB, WS_WGLU = 13 * MiB, WS_WO = 15 * MiB, WS_WGU = 23 * MiB, WS_WDN = 67 * MiB, WS_WPG = 89 * MiB, WS_WPP = 97 * MiB;
constexpr size_t WS_MT = 98 * MiB;
constexpr size_t WS_HN = 100 * MiB;
constexpr size_t WS_YG = 264 * MiB;
constexpr size_t WS_Z = 164 * MiB;
constexpr size_t WS_AS = 196 * MiB;
constexpr size_t WS_PALL = 244 * MiB;
constexpr size_t WS_WALL = 252 * MiB;
constexpr size_t WS_QRAW = 264 * MiB, WS_KVRAW = 312 * MiB;
constexpr size_t WS_Q = 376 * MiB, WS_K = 424 * MiB, WS_V = 472 * MiB;
constexpr size_t WS_H = 228 * MiB, WS_PP = 404 * MiB, WS_PB = 504 * MiB, WS_END = 512 * MiB;

constexpr int RING_BYTES = 131072, MISC_OFF = 139264 + 320, LDS_BYTES = 147456;
constexpr int NWAVES = 8;

#define GAS __attribute__((address_space(1)))
#define LAS __attribute__((address_space(3)))
typedef unsigned short bf16;
typedef unsigned v4u __attribute__((ext_vector_type(4)));
typedef unsigned v2u __attribute__((ext_vector_type(2)));
typedef float f32x4 __attribute__((ext_vector_type(4)));
typedef GAS unsigned gu32;
#define LDS_WAIT() asm volatile("s_waitcnt lgkmcnt(0)" ::: "memory")
__device__ __forceinline__ unsigned f2bf(float f) { unsigned u = __builtin_bit_cast(unsigned, f); return (u + 0x7fffu + ((u >> 16) & 1u)) >> 16; }
__device__ __forceinline__ unsigned pk2(float lo, float hi) { return f2bf(lo) | (f2bf(hi) << 16); }
__device__ __forceinline__ float bf2f(unsigned h) { return __builtin_bit_cast(float, h << 16); }
__device__ __forceinline__ float bflo(unsigned w) { return __builtin_bit_cast(float, w << 16); }
__device__ __forceinline__ float bfhi(unsigned w) { return __builtin_bit_cast(float, w & 0xffff0000u); }
__device__ __forceinline__ int fresh_tid() { int t = threadIdx.x; asm volatile("" : "+v"(t)); return t; }
__device__ __forceinline__ float wave_sum(float v) {
#pragma unroll
    for (int o = 1; o < 64; o <<= 1) v += __shfl_xor(v, o);
    return v;
}
__device__ __forceinline__ float wave_max(float v) {
#pragma unroll
    for (int o = 1; o < 64; o <<= 1) v = fmaxf(v, __shfl_xor(v, o));
    return v;
}
typedef float f32x2 __attribute__((ext_vector_type(2)));
__device__ __forceinline__ f32x2 splat2(float v) { return (f32x2){v, v}; }
__device__ __forceinline__ f32x2 fma2(f32x2 a, f32x2 b, f32x2 c) { return __builtin_elementwise_fma(a, b, c); }
__device__ __forceinline__ f32x2 rsig2(f32x2 t) {
    f32x2 e = {__builtin_amdgcn_exp2f(t[0]), __builtin_amdgcn_exp2f(t[1])}; e = e + splat2(1.0f);
    return (f32x2){__builtin_amdgcn_rcpf(e[0]), __builtin_amdgcn_rcpf(e[1])};
}
__device__ __forceinline__ f32x2 gelu_tanh2(f32x2 v) {
    constexpr float k1 = -2.0f * 0.7978845608028654f * 1.4426950408889634f, k2 = k1 * 0.044715f;
    return v * rsig2(v * fma2(v * v, splat2(k2), splat2(k1)));
}
__device__ __forceinline__ f32x2 half2of(const f32x4& v, int h) { return (f32x2){v[2 * h], v[2 * h + 1]}; }
__device__ __forceinline__ void sethalf(f32x4& v, int h, f32x2 x) { v[2 * h] = x[0]; v[2 * h + 1] = x[1]; }
__device__ __forceinline__ f32x2 unpack2(unsigned d) { return (f32x2){__uint_as_float(d << 16), __uint_as_float(d & 0xffff0000u)}; }

__device__ __forceinline__ float sigmoid_f(float v) { return __builtin_amdgcn_rcpf(1.0f + __builtin_amdgcn_exp2f(-1.4426950408889634f * v)); }
__device__ __forceinline__ float gelu_tanh(float v) {
    const float z = 0.7978845608028654f * (v + 0.044715f * v * v * v);
    const float e = __builtin_amdgcn_exp2f(2.0f * 1.4426950408889634f * z);
    const float th = 1.0f - 2.0f * __builtin_amdgcn_rcpf(e + 1.0f);
    return 0.5f * v * (1.0f + th);
}

#define XB_TMO      128
#define XB_XCNT(j)  (256  + 64 * (j))
#define XB_XSUB(j)  (1280 + 64 * (j))
#define XB_XGEN(j)  (2304 + 64 * (j))
#define XB_TOP      3328
#define XB_TOPGEN   3392
#define XCD_BAR_WORDS 3456
#define XB_SPIN_CAP (1u << 18)
__device__ __forceinline__ unsigned xb_ld(unsigned* p)              { return __hip_atomic_load(p, __ATOMIC_RELAXED, __HIP_MEMORY_SCOPE_AGENT); }
__device__ __forceinline__ unsigned xb_add(unsigned* p, unsigned v) { return __hip_atomic_fetch_add(p, v, __ATOMIC_RELAXED, __HIP_MEMORY_SCOPE_AGENT); }
__device__ __forceinline__ unsigned xb_xcc_id() { return (unsigned)__builtin_amdgcn_s_getreg((3 << 11) | 20) & 0xFu; }
#define XB_SPIN(cond, bar) do { unsigned _sp = 0; while (cond) { __builtin_amdgcn_s_sleep(1); \
    if ((++_sp & 255u) == 0u) { if (xb_ld(&(bar)[XB_TMO])) break; if (_sp > XB_SPIN_CAP) { atomicAdd(&(bar)[XB_TMO], 1u); break; } } } } while (0)
struct XcdBarrier { unsigned* bar; unsigned x; volatile LAS unsigned* st; unsigned members; };
__device__ __forceinline__ XcdBarrier xcd_barrier_post(unsigned* bar, volatile LAS unsigned* st, unsigned members) {
    XcdBarrier b; b.bar = bar; b.x = xb_xcc_id(); b.st = st; b.members = members;
    if (threadIdx.x == 0) (void)xb_add(&bar[XB_XCNT(b.x)], 1u);
    return b;
}
__device__ __forceinline__ void xcd_barrier_complete(unsigned* bar, unsigned x, unsigned G, unsigned& nloc, unsigned& nx) {
    unsigned sum, cnt, mine, sp = 0u;
    for (;;) {
        sum = 0u; cnt = 0u; mine = 0u;
#pragma unroll
        for (unsigned j = 0; j < 16; ++j) { const unsigned c = xb_ld(&bar[XB_XCNT(j)]); sum += c; cnt += (c > 0u) ? 1u : 0u; mine = (j == x) ? c : mine; }
        if (sum == G) break;
        __builtin_amdgcn_s_sleep(1);
        if ((++sp & 255u) == 0u) { if (xb_ld(&bar[XB_TMO])) break; if (sp > XB_SPIN_CAP) { atomicAdd(&bar[XB_TMO], 1u); break; } }
    }
    nloc = mine > 0u ? mine : 1u; nx = cnt > 0u ? cnt : 1u;
}
__device__ __forceinline__ void xcd_barrier(const XcdBarrier& b) {
    asm volatile("s_waitcnt vmcnt(0)" ::: "memory");
    __syncthreads();
    if (threadIdx.x == 0) {
        unsigned* bar = b.bar;
        __builtin_amdgcn_s_waitcnt(0);
        unsigned nloc = b.st[0], nx = b.st[1];
        if (nloc == 0u) { xcd_barrier_complete(bar, b.x, b.members, nloc, nx); b.st[0] = nloc; b.st[1] = nx; }
        const unsigned old = xb_add(&bar[XB_XSUB(b.x)], 1u);
        const unsigned gen = old / nloc;
        if (old + 1u == (gen + 1u) * nloc) {
            __builtin_amdgcn_fence(__ATOMIC_RELEASE, "agent");
            asm volatile("s_waitcnt vmcnt(0)" ::: "memory");
            const unsigned og = xb_add(&bar[XB_TOP], 1u);
            const unsigned tg = og / nx;
            if (og + 1u == (tg + 1u) * nx) xb_add(&bar[XB_TOPGEN], 1u);
            else XB_SPIN(xb_ld(&bar[XB_TOPGEN]) == tg, bar);
            __builtin_amdgcn_fence(__ATOMIC_ACQUIRE, "agent");
            xb_add(&bar[XB_XGEN(b.x)], 1u);
            asm volatile("s_waitcnt vmcnt(0)" ::: "memory");
        } else {
            XB_SPIN(xb_ld(&bar[XB_XGEN(b.x)]) == gen, bar);
            __builtin_amdgcn_fence(__ATOMIC_ACQUIRE, "agent");
            asm volatile("s_waitcnt vmcnt(0)" ::: "memory");
        }
    }
    __syncthreads();
}

using pg8::Unit; using pg8::cvt_pk_bf16;
#define EPI_LOOP_AM _Pragma("unroll") for (int ai = 0; ai < 2; ++ai) _Pragma("unroll") for (int m = 0; m < 4; ++m)
__device__ __forceinline__ float sq8(const f32x4& a, const f32x4& b) { f32x2 s = half2of(a, 0) * half2of(a, 0); s = fma2(half2of(a, 1), half2of(a, 1), s); s = fma2(half2of(b, 0), half2of(b, 0), s); s = fma2(half2of(b, 1), half2of(b, 1), s); return s[0] + s[1]; }
__device__ __forceinline__ v4u pack8(const f32x4& a, const f32x4& b) { v4u w; w.x = cvt_pk_bf16(a[0], a[1]); w.y = cvt_pk_bf16(a[2], a[3]); w.z = cvt_pk_bf16(b[0], b[1]); w.w = cvt_pk_bf16(b[2], b[3]); return w; }

__device__ __forceinline__ void unpack8(const v4u w, float (&f)[8]) { f[0] = bflo(w.x); f[1] = bfhi(w.x); f[2] = bflo(w.y); f[3] = bfhi(w.y); f[4] = bflo(w.z); f[5] = bfhi(w.z); f[6] = bflo(w.w); f[7] = bfhi(w.w); }
__device__ __forceinline__ v4u pack8f(const float (&f)[8]) { v4u w; w.x = pk2(f[0], f[1]); w.y = pk2(f[2], f[3]); w.z = pk2(f[4], f[5]); w.w = pk2(f[6], f[7]); return w; }
__device__ __forceinline__ unsigned pk4_fp8(float a, float b, float c, float d) {
    a = __builtin_amdgcn_fmed3f(a, -448.f, 448.f); b = __builtin_amdgcn_fmed3f(b, -448.f, 448.f); c = __builtin_amdgcn_fmed3f(c, -448.f, 448.f); d = __builtin_amdgcn_fmed3f(d, -448.f, 448.f);
    int w = __builtin_amdgcn_cvt_pk_fp8_f32(a, b, 0, false); w = __builtin_amdgcn_cvt_pk_fp8_f32(c, d, w, true); return (unsigned)w; }
struct EpiZ {
    static constexpr bool PERM = true, AFTER_DRAIN = false; static constexpr int MIDK = 0; static constexpr bool AGRP = false; static constexpr bool F8 = false;
    bf16* Z; bf16* AS; float* sqq; float* sqkv; float* sqkr; bf16* KR; const float* COS; const float* SIN; const float* gk;
    __device__ __forceinline__ void operator()(const f32x4 (&acc)[2][2][4][2], const Unit& u, int wr, int wc, int fr, int fq) const {
        int row0 = u.pm * 256 + wr * 64 + fr; asm volatile("" : "+v"(row0));
        if (u.pn < 3) {
            const int col0 = u.pn * 256 + wc * 32 + 8 * fq;
            float* sq = u.pn < 2 ? sqq : sqkv;
            EPI_LOOP_AM { const int row = row0 + ai * 128 + m * 16; bf16* rowp = Z + (size_t)row * ZLD + col0; float s = 0.f;
#pragma unroll
                for (int bj = 0; bj < 2; ++bj) { *(v4u*)(rowp + bj * 128) = pack8(acc[ai][bj][m][0], acc[ai][bj][m][1]); s += sq8(acc[ai][bj][m][0], acc[ai][bj][m][1]); }
                s += __shfl_xor(s, 16); s += __shfl_xor(s, 32); if (fq == 0) atomicAdd(sq + row, s); }
        } else if (u.pn == 3) {
            if (wc < 2) { const int i0 = 16 * wc + 4 * fq; const f32x4 g0 = *(const f32x4*)(gk + 128 + i0), g1 = *(const f32x4*)(gk + 160 + i0);
#pragma unroll
                for (int ai = 0; ai < 2; ++ai) { f32x4 csv[4], snv[4];
#pragma unroll
                    for (int m = 0; m < 4; ++m) { const int row = row0 + ai * 128 + m * 16; csv[m] = *(const f32x4*)(COS + (size_t)row * 32 + i0); snv[m] = *(const f32x4*)(SIN + (size_t)row * 32 + i0); }
#pragma unroll
                    for (int m = 0; m < 4; ++m) { const int row = row0 + ai * 128 + m * 16; const f32x4 a = acc[ai][0][m][0], b = acc[ai][0][m][1], cs = csv[m], sn = snv[m];
                        float s = sq8(a, b); const f32x4 ag = a * g0, bg = b * g1, ra = ag * cs - bg * sn, rb = bg * cs + ag * sn;
                        *(v4u*)(KR + (size_t)row * 64 + 32 * wc + 8 * fq) = pack8(ra, rb);
                        s += __shfl_xor(s, 16); s += __shfl_xor(s, 32); if (fq == 0) atomicAdd(sqkr + row, s); }
                    asm volatile("" ::: "memory"); } }
        } else {
            const int ch0 = (u.pn - 4) * 256 + wc * 32 + 8 * fq;
            EPI_LOOP_AM { const int row = row0 + ai * 128 + m * 16;
#pragma unroll
                for (int bj = 0; bj < 2; ++bj) { const int ch = ch0 + bj * 128, g = ch >> 4, h0 = ch & 15;
                    *(v4u*)(AS + ((size_t)(g * SROWS + (row >> 4)) * ASLD + (row & 15) * 16 + h0)) = pack8(acc[ai][bj][m][0], acc[ai][bj][m][1]); } }
        }
    }
};
struct EpiKV {
    static constexpr bool PERM = true, AFTER_DRAIN = false; static constexpr int MIDK = 0; static constexpr bool AGRP = false; static constexpr bool F8 = false;
    bf16* K; bf16* V; const float* sqkv; const float* sqkr; const bf16* KR; const float* gk; LAS float* P;
    __device__ __forceinline__ void operator()(const f32x4 (&acc)[2][2][4][2], const Unit& u, int wr, int wc, int fr, int fq) const {
        int rb = wr * 64 + fr, c8 = wc * 32 + 8 * fq, pw = (wr * 64 + fr) * 4 + wc; const int h = u.pn; asm volatile("" : "+v"(rb), "+v"(c8), "+v"(pw));
        const f32x4 g0 = *(const f32x4*)(gk + c8), g1 = *(const f32x4*)(gk + c8 + 4);
        float skv[2][4], skr[2][4]; v4u krv[2][4];
        EPI_LOOP_AM { const int row = u.pm * 256 + ai * 128 + m * 16 + rb; skv[ai][m] = sqkv[row]; skr[ai][m] = sqkr[row]; }
        if (wc < 2) { EPI_LOOP_AM krv[ai][m] = *(const v4u*)(KR + (size_t)(u.pm * 256 + ai * 128 + m * 16 + rb) * 64 + c8); }
        EPI_LOOP_AM { float s = sq8(acc[ai][0][m][0], acc[ai][0][m][1]); s += __shfl_xor(s, 16); s += __shfl_xor(s, 32); if (fq == 0) P[pw + (ai * 128 + m * 16) * 4] = s; }
        asm volatile("s_waitcnt lgkmcnt(0)" ::: "memory"); __builtin_amdgcn_s_barrier(); asm volatile("" ::: "memory");
#pragma unroll
        for (int ai = 0; ai < 2; ++ai) {
#pragma unroll
          for (int m = 0; m < 4; ++m) { const int rt = ai * 128 + m * 16 + rb, row = u.pm * 256 + rt, b = row / SEQ, t = row % SEQ; const size_t orow = (size_t)(b * NH + h) * SEQ + t;
            const f32x4 pp = *(const LAS f32x4*)(P + rt * 4); const float rkv = __builtin_amdgcn_rsqf(skv[ai][m] * (1.0f / KVL) + EPS);
            const float rk = __builtin_amdgcn_rsqf((rkv * rkv * ((pp[0] + pp[1]) + (pp[2] + pp[3])) + skr[ai][m]) * (1.0f / DQK) + EPS), f = rkv * rk;
            *(v4u*)(K + orow * DQK + c8) = pack8(acc[ai][0][m][0] * g0 * f, acc[ai][0][m][1] * g1 * f);
            *(v4u*)(V + orow * DV + c8) = pack8(acc[ai][1][m][0] * rkv, acc[ai][1][m][1] * rkv);
            if (wc < 2) { float kr[8]; unpack8(krv[ai][m], kr);
#pragma unroll
                for (int j = 0; j < 8; ++j) kr[j] *= rk;
                *(v4u*)(K + orow * DQK + 128 + c8) = pack8f(kr); } }
          asm volatile("" ::: "memory"); }
    }
};
struct EpiQ {
    static constexpr bool PERM = true, AFTER_DRAIN = false; static constexpr int MIDK = 0; static constexpr bool AGRP = false; static constexpr bool F8 = false;
    bf16* Q; const float* sqq; const float* COS; const float* SIN; const float* gq; LAS float* P;
    __device__ __forceinline__ void operator()(const f32x4 (&acc)[2][2][4][2], const Unit& u, int wr, int wc, int fr, int fq) const {
        int rb = wr * 64 + fr, c8 = wc * 32 + 8 * fq, pw = (wr * 64 + fr) * 4 + wc; const int h = u.pn; asm volatile("" : "+v"(rb), "+v"(c8), "+v"(pw));
        const f32x4 g0 = *(const f32x4*)(gq + c8), g1 = *(const f32x4*)(gq + c8 + 4);
        const int i0 = (c8 >> 1) & 28;
        f32x4 h0 = g0, h1 = g0; if (wc < 2) { h0 = *(const f32x4*)(gq + 128 + i0); h1 = *(const f32x4*)(gq + 160 + i0); }
        float sqv[2][4]; f32x4 csv[2][4], snv[2][4];
        EPI_LOOP_AM { const int row = u.pm * 256 + ai * 128 + m * 16 + rb; sqv[ai][m] = sqq[row]; }
        if (wc < 2) { EPI_LOOP_AM { const int row = u.pm * 256 + ai * 128 + m * 16 + rb; csv[ai][m] = *(const f32x4*)(COS + (size_t)row * 32 + i0); snv[ai][m] = *(const f32x4*)(SIN + (size_t)row * 32 + i0); } }
        EPI_LOOP_AM { float s = sq8(acc[ai][0][m][0], acc[ai][0][m][1]) + sq8(acc[ai][1][m][0], acc[ai][1][m][1]); s += __shfl_xor(s, 16); s += __shfl_xor(s, 32); if (fq == 0) P[pw + (ai * 128 + m * 16) * 4] = s; }
        asm volatile("s_waitcnt lgkmcnt(0)" ::: "memory"); __builtin_amdgcn_s_barrier(); asm volatile("" ::: "memory");
        EPI_LOOP_AM { const int rt = ai * 128 + m * 16 + rb, row = u.pm * 256 + rt, b = row / SEQ, t = row % SEQ; const size_t orow = (size_t)(b * NH + h) * SEQ + t;
            const f32x4 pp = *(const LAS f32x4*)(P + rt * 4); const float rq = __builtin_amdgcn_rsqf(sqv[ai][m] * (1.0f / QL) + EPS);
            const float rh = __builtin_amdgcn_rsqf(rq * rq * ((pp[0] + pp[1]) + (pp[2] + pp[3])) * (1.0f / DQK) + EPS), f = rq * rh;
            *(v4u*)(Q + orow * DQK + c8) = pack8(acc[ai][0][m][0] * g0 * f, acc[ai][0][m][1] * g1 * f);
            if (wc < 2) { const f32x4 a = acc[ai][1][m][0] * h0 * f, bq = acc[ai][1][m][1] * h1 * f, cs = csv[ai][m], sn = snv[ai][m];
                *(v4u*)(Q + orow * DQK + 128 + c8) = pack8(a * cs - bq * sn, bq * cs + a * sn); } }
    }
};
struct EpiE {
    static constexpr bool PERM = true, AFTER_DRAIN = true; static constexpr int MIDK = 0; static constexpr bool AGRP = false; static constexpr bool F8 = false;
    bf16* AS; const float* A16;
    __device__ __forceinline__ void fused(f32x4 (&acc)[2][2][4][2], const Unit& u, int wr, int wc, int fr, int fq, LAS unsigned char* lds, int wid, int lane) const {
        LAS float* Et = (LAS float*)lds;
        EPI_LOOP_AM { const int row = ai * 128 + wr * 64 + m * 16 + fr, col = wc * 32 + 8 * fq, sw = (row & 7) << 3;
            *(LAS f32x4*)(Et + row * 128 + (col ^ sw)) = acc[ai][0][m][0]; *(LAS f32x4*)(Et + row * 128 + ((col + 4) ^ sw)) = acc[ai][0][m][1]; }
        asm volatile("s_waitcnt lgkmcnt(0)" ::: "memory"); __builtin_amdgcn_s_barrier(); asm volatile("" ::: "memory");
        if (wid < 2) { const int bq = wid, p = lane, g = u.pn; const float a_re = A16[2 * (g * NP + p)], a_im = A16[2 * (g * NP + p) + 1]; float sr = 0.f, si = 0.f;
            for (int k0 = 0; k0 < NCH; k0 += 8) { float er[8], ei[8];
#pragma unroll
                for (int q = 0; q < 8; ++q) { const int row = bq * 128 + k0 + q; LAS float* e = Et + row * 128 + (p ^ (q << 3)); er[q] = e[0]; ei[q] = e[64]; }
#pragma unroll
                for (int q = 0; q < 8; ++q) { const int row = bq * 128 + k0 + q; LAS float* e = Et + row * 128 + (p ^ (q << 3));
                    e[0] = sr; e[64] = si;
                    const float nr = a_re * sr - a_im * si + er[q], ni = a_re * si + a_im * sr + ei[q]; sr = nr; si = ni; } } }
        asm volatile("s_waitcnt lgkmcnt(0)" ::: "memory"); __builtin_amdgcn_s_barrier(); asm volatile("" ::: "memory");
        { const int tid_ = wid * 64 + lane;
#pragma unroll
          for (int j = 0; j < 8; ++j) { const int c = tid_ + 512 * j, row = c >> 4, p0 = (c & 15) * 8, sw = (row & 7) << 3;
              const f32x4 lo = *(const LAS f32x4*)(Et + row * 128 + (p0 ^ sw)), hi4 = *(const LAS f32x4*)(Et + row * 128 + (p0 ^ sw) + 4);
              *(v4u*)(AS + ((size_t)u.pm * 256 + row) * ASLD + 256 + p0) = pack8(lo, hi4); } }
    }
};
struct EpiY {
    static constexpr bool PERM = true, AFTER_DRAIN = false; static constexpr int MIDK = 0; static constexpr bool AGRP = false; static constexpr bool F8 = false;
    bf16* YG;
    __device__ __forceinline__ void operator()(const f32x4 (&acc)[2][2][4][2], const Unit& u, int wr, int wc, int fr, int fq) const {
        const int g = u.pn, r0 = (u.pm & 3) * 256 + wr * 64 + fr, n0 = wc * 32 + 8 * fq;
        EPI_LOOP_AM { const int r = r0 + ai * 128 + m * 16, b = r >> 7, k = r & 127;
#pragma unroll
            for (int bj = 0; bj < 2; ++bj) { const int n = n0 + bj * 128, j = n >> 4, h0 = n & 15; f32x4 a = acc[ai][bj][m][0], c = acc[ai][bj][m][1];
#pragma unroll
                for (int e = 0; e < 2; ++e) { sethalf(a, e, gelu_tanh2(half2of(a, e))); sethalf(c, e, gelu_tanh2(half2of(c, e))); }
                *(v4u*)((char*)YG + (unsigned)(((g * M + (b * SEQ + k * TC + j)) * 16 + h0) * 2)) = pack8(a, c); } }
    }
};
struct EpiScale {
    static constexpr bool PERM = true, AFTER_DRAIN = false; static constexpr int MIDK = 0; static constexpr bool AGRP = false; static constexpr bool F8 = false;
    bf16* O; int ldc; const float* sq; float invk;
    __device__ __forceinline__ void operator()(const f32x4 (&acc)[2][2][4][2], const Unit& u, int wr, int wc, int fr, int fq) const {
        int row0 = u.pm * 256 + wr * 64 + fr, col0 = u.pn * 256 + wc * 32 + 8 * fq; asm volatile("" : "+v"(row0), "+v"(col0));
        EPI_LOOP_AM { const int row = row0 + ai * 128 + m * 16; bf16* rowp = O + (size_t)row * ldc + col0; const float rs = __builtin_amdgcn_rsqf(sq[row] * invk + EPS);
#pragma unroll
            for (int bj = 0; bj < 2; ++bj) *(v4u*)(rowp + bj * 128) = pack8(acc[ai][bj][m][0] * rs, acc[ai][bj][m][1] * rs); }
    }
};
struct EpiPlain {
    static constexpr bool PERM = true, AFTER_DRAIN = false; static constexpr int MIDK = 0; static constexpr bool AGRP = false; static constexpr bool F8 = false;
    bf16* O; int ldc;
    __device__ __forceinline__ void operator()(const f32x4 (&acc)[2][2][4][2], const Unit& u, int wr, int wc, int fr, int fq) const {
        int row0 = u.pm * 256 + wr * 64 + fr, col0 = u.pn * 256 + wc * 32 + 8 * fq; asm volatile("" : "+v"(row0), "+v"(col0));
        EPI_LOOP_AM { bf16* rowp = O + (size_t)(row0 + ai * 128 + m * 16) * ldc + col0;
#pragma unroll
            for (int bj = 0; bj < 2; ++bj) *(v4u*)(rowp + bj * 128) = pack8(acc[ai][bj][m][0], acc[ai][bj][m][1]); }
    }
};
struct EpiGlu {
    static constexpr bool PERM = true, AFTER_DRAIN = false; static constexpr int MIDK = 0; static constexpr bool AGRP = true; static constexpr bool F8 = false;
    const bf16* YG; const float* bias; bf16* O; float* sq;
    __device__ __forceinline__ void operator()(const f32x4 (&acc)[2][2][4][2], const Unit& u, int wr, int wc, int fr, int fq) const {
        int row0 = u.pm * 256 + wr * 64 + fr, col0 = u.pn * 256 + wc * 32 + 8 * fq; asm volatile("" : "+v"(row0), "+v"(col0));
        f32x4 bv[2][2];
#pragma unroll
        for (int bj = 0; bj < 2; ++bj) { bv[bj][0] = *(const f32x4*)(bias + col0 + bj * 128) * -1.4426950408889634f; bv[bj][1] = *(const f32x4*)(bias + col0 + bj * 128 + 4) * -1.4426950408889634f; }
        v4u yv[2][4][2];
        EPI_LOOP_AM {
#pragma unroll
            for (int bj = 0; bj < 2; ++bj) { const int col = col0 + bj * 128; yv[ai][m][bj] = *(const v4u*)((const char*)YG + (unsigned)((((col >> 4) * M + (row0 + ai * 128 + m * 16)) * 16 + (col & 15)) * 2)); } }
#pragma unroll
        for (int ai = 0; ai < 2; ++ai) {
#pragma unroll
            for (int m = 0; m < 4; ++m) { const int row = row0 + ai * 128 + m * 16; float s = 0.f;
                f32x2 s2 = {0.f, 0.f};
#pragma unroll
                for (int bj = 0; bj < 2; ++bj) { const v4u yw = yv[ai][m][bj]; const unsigned yd[4] = {yw.x, yw.y, yw.z, yw.w};
                    f32x4 o[2];
#pragma unroll
                    for (int n = 0; n < 2; ++n)
#pragma unroll
                        for (int h = 0; h < 2; ++h) { const f32x2 v = unpack2(yd[2 * n + h]) * rsig2(fma2(half2of(acc[ai][bj][m][n], h), splat2(-1.4426950408889634f), half2of(bv[bj][n], h)));
                            sethalf(o[n], h, v); s2 = fma2(v, v, s2); }
                    *(v4u*)(O + (size_t)row * 2048 + col0 + bj * 128) = pack8(o[0], o[1]); }
                s = s2[0] + s2[1];
                s += __shfl_xor(s, 16); s += __shfl_xor(s, 32); if (fq == 0) atomicAdd(sq + row, s); }
            asm volatile("" ::: "memory"); }
    }
};
struct EpiWo {
    static constexpr bool PERM = true, AFTER_DRAIN = false; static constexpr int MIDK = 16; static constexpr bool AGRP = false; static constexpr bool F8 = false;
    const float* rs0; bf16* xb; float* sq; const float* sqa; const float* sqs;
    __device__ __forceinline__ void mid(f32x4 (&acc)[2][2][4][2], const Unit& u, int wr, int wc, int fr, int fq) const {
        int row0 = u.pm * 256 + wr * 64 + fr; const float* pa = sqa; const float* ps = sqs;
        asm volatile("" : "+v"(row0), "+s"(pa), "+s"(ps));
        EPI_LOOP_AM { const int row = row0 + ai * 128 + m * 16; const float f = __builtin_amdgcn_rsqf(pa[row] * (1.0f / 1024.0f) + EPS) * sqrtf(ps[row] * (1.0f / 1024.0f) + EPS);
#pragma unroll
            for (int bj = 0; bj < 2; ++bj) { acc[ai][bj][m][0] *= f; acc[ai][bj][m][1] *= f; } }
    }
    __device__ __forceinline__ void operator()(const f32x4 (&acc)[2][2][4][2], const Unit& u, int wr, int wc, int fr, int fq) const {
        int row0 = u.pm * 256 + wr * 64 + fr, col0 = u.pn * 256 + wc * 32 + 8 * fq; asm volatile("" : "+v"(row0), "+v"(col0));
        v4u xv[4][2]; float nr[4], ss[4];
#define WO_LOAD(ai_, m_) do { const int row_ = row0 + (ai_) * 128 + (m_) * 16; nr[m_] = rs0[row_]; ss[m_] = sqs[row_]; \
            _Pragma("unroll") for (int bj = 0; bj < 2; ++bj) xv[m_][bj] = *(const v4u*)(xb + (size_t)row_ * D + col0 + bj * 128); } while (0)
#define WO_CALC(ai_, m_) do { const int row = row0 + (ai_) * 128 + (m_) * 16; const size_t off = (size_t)row * D + col0; float s = 0.f; const float rs = __builtin_amdgcn_rsqf(ss[m_] * (1.0f / 1024.0f) + EPS), nrm = nr[m_]; \
            f32x2 s2 = {0.f, 0.f}; \
            _Pragma("unroll") for (int bj = 0; bj < 2; ++bj) { const v4u xw = xv[m_][bj]; const unsigned xd[4] = {xw.x, xw.y, xw.z, xw.w}; f32x4 o[2]; \
                _Pragma("unroll") for (int n = 0; n < 2; ++n) _Pragma("unroll") for (int h = 0; h < 2; ++h) { const f32x2 v = fma2(unpack2(xd[2 * n + h]), splat2(nrm), half2of(acc[ai_][bj][m_][n], h) * splat2(rs)); sethalf(o[n], h, v); s2 = fma2(v, v, s2); } \
                *(v4u*)(xb + off + bj * 128) = pack8(o[0], o[1]); } \
            s = s2[0] + s2[1]; \
            s += __shfl_xor(s, 16); s += __shfl_xor(s, 32); if (fq == 0) atomicAdd(sq + row, s); } while (0)
#pragma unroll
        for (int m = 0; m < 4; ++m) WO_LOAD(0, m);
        asm volatile("" ::: "memory");
#pragma unroll
        for (int m = 0; m < 4; ++m) { WO_CALC(0, m); asm volatile("" ::: "memory"); WO_LOAD(1, m); asm volatile("" ::: "memory"); }
#pragma unroll
        for (int m = 0; m < 4; ++m) WO_CALC(1, m);
#undef WO_LOAD
#undef WO_CALC
    }
};
struct EpiDown {
    static constexpr bool PERM = true, AFTER_DRAIN = false; static constexpr int MIDK = 0; static constexpr bool AGRP = false; static constexpr bool F8 = false;
    bf16* xb; float* sq; unsigned char* x8;
    __device__ __forceinline__ void operator()(const f32x4 (&acc)[2][2][4][2], const Unit& u, int wr, int wc, int fr, int fq) const {
        int row0 = u.pm * 256 + wr * 64 + fr, col0 = u.pn * 256 + wc * 32 + 8 * fq; asm volatile("" : "+v"(row0), "+v"(col0));
        v4u xv[2][4][2];
        EPI_LOOP_AM {
#pragma unroll
            for (int bj = 0; bj < 2; ++bj) xv[ai][m][bj] = *(const v4u*)(xb + (size_t)(row0 + ai * 128 + m * 16) * D + col0 + bj * 128); }
#pragma unroll
        for (int ai = 0; ai < 2; ++ai) {
#pragma unroll
            for (int m = 0; m < 4; ++m) { const int row = row0 + ai * 128 + m * 16; const size_t off = (size_t)row * D + col0; float s = 0.f;
                f32x2 s2 = {0.f, 0.f};
#pragma unroll
                for (int bj = 0; bj < 2; ++bj) { const v4u xw = xv[ai][m][bj]; const unsigned xd[4] = {xw.x, xw.y, xw.z, xw.w}; f32x4 o[2];
#pragma unroll
                    for (int n = 0; n < 2; ++n)
#pragma unroll
                        for (int h = 0; h < 2; ++h) { const f32x2 v = half2of(acc[ai][bj][m][n], h) + unpack2(xd[2 * n + h]); sethalf(o[n], h, v); s2 = fma2(v, v, s2); }
                    *(v4u*)(xb + off + bj * 128) = pack8(o[0], o[1]);
                    { v2u w8; w8.x = pk4_fp8(o[0][0] * F8_SA, o[0][1] * F8_SA, o[0][2] * F8_SA, o[0][3] * F8_SA); w8.y = pk4_fp8(o[1][0] * F8_SA, o[1][1] * F8_SA, o[1][2] * F8_SA, o[1][3] * F8_SA);
                      *(v2u*)(x8 + (unsigned)(row * D + col0 + bj * 128)) = w8; } }
                s = s2[0] + s2[1];
                s += __shfl_xor(s, 16); s += __shfl_xor(s, 32); if (fq == 0) atomicAdd(sq + row, s); }
            asm volatile("" ::: "memory"); }
    }
};
struct EpiGateUp {
    static constexpr bool PERM = true, AFTER_DRAIN = false; static constexpr int MIDK = 0; static constexpr bool AGRP = false; static constexpr bool F8 = false;
    bf16* H; const float* sq;
    __device__ __forceinline__ void operator()(const f32x4 (&acc)[2][2][4][2], const Unit& u, int wr, int wc, int fr, int fq) const {
        int row0 = u.pm * 256 + wr * 64 + fr, col0 = u.pn * 128 + wc * 32 + 8 * fq; asm volatile("" : "+v"(row0), "+v"(col0));
        float sv[2][4];
        EPI_LOOP_AM sv[ai][m] = sq[row0 + ai * 128 + m * 16];
        EPI_LOOP_AM { const int row = row0 + ai * 128 + m * 16; const float rs = __builtin_amdgcn_rsqf(sv[ai][m] * (1.0f / D) + EPS);
            const f32x2 nl = {-1.4426950408889634f * rs, -1.4426950408889634f * rs}, r2 = {rs * rs, rs * rs};
            f32x4 o[2];
#pragma unroll
            for (int n = 0; n < 2; ++n)
#pragma unroll
                for (int h = 0; h < 2; ++h) { const f32x2 g = {acc[ai][0][m][n][2 * h], acc[ai][0][m][n][2 * h + 1]}, uu = {acc[ai][1][m][n][2 * h], acc[ai][1][m][n][2 * h + 1]};
                    const f32x2 hv = ((g * uu) * r2) * rsig2(g * nl);
                    o[n][2 * h] = hv[0]; o[n][2 * h + 1] = hv[1]; }
            *(v4u*)(H + (size_t)row * FF + col0) = pack8(o[0], o[1]); }
    }
};
struct EpiPle {
    static constexpr bool PERM = true, AFTER_DRAIN = false; static constexpr int MIDK = 0; static constexpr bool AGRP = false; static constexpr bool F8 = true;
    float* out; const bf16* xb; const bf16* PP; const float* sq;
    __device__ __forceinline__ void operator()(const f32x4 (&acc)[2][2][4][2], const Unit& u, int wr, int wc, int fr, int fq) const {
        int row0 = u.pm * 256 + wr * 64 + fr, col0 = u.pn * 256 + wc * 32 + 8 * fq; asm volatile("" : "+v"(row0), "+v"(col0));
        v4u pv[4][2], xv[4][2]; float sv[4];
#define PLE_LOAD(ai_, m_) do { const int row_ = row0 + (ai_) * 128 + (m_) * 16; sv[m_] = sq[row_]; \
            _Pragma("unroll") for (int bj = 0; bj < 2; ++bj) { pv[m_][bj] = *(const v4u*)(PP + (size_t)row_ * D + col0 + bj * 128); xv[m_][bj] = *(const v4u*)(xb + (size_t)row_ * D + col0 + bj * 128); } } while (0)
#define PLE_CALC(ai_, m_) do { const int row_ = row0 + (ai_) * 128 + (m_) * 16; const size_t off = (size_t)row_ * D + col0; const float rs = __builtin_amdgcn_rsqf(sv[m_] * (1.0f / D) + EPS) * (1.0f / (F8_SA * F8_SW)); \
            _Pragma("unroll") for (int bj = 0; bj < 2; ++bj) { const v4u pw = pv[m_][bj], xw = xv[m_][bj]; const unsigned pd[4] = {pw.x, pw.y, pw.z, pw.w}, xd[4] = {xw.x, xw.y, xw.z, xw.w}; \
                const f32x2 nl = splat2(-1.4426950408889634f * rs); f32x4 o[2]; \
                _Pragma("unroll") for (int n = 0; n < 2; ++n) _Pragma("unroll") for (int h = 0; h < 2; ++h) sethalf(o[n], h, fma2(rsig2(half2of(acc[ai_][bj][m_][n], h) * nl), unpack2(pd[2 * n + h]), unpack2(xd[2 * n + h]))); \
                *(f32x4*)(out + off + bj * 128) = o[0]; *(f32x4*)(out + off + bj * 128 + 4) = o[1]; } } while (0)
#pragma unroll
        for (int m = 0; m < 4; ++m) PLE_LOAD(0, m);
        asm volatile("" ::: "memory");
#pragma unroll
        for (int m = 0; m < 4; ++m) { PLE_CALC(0, m); asm volatile("" ::: "memory"); PLE_LOAD(1, m); asm volatile("" ::: "memory"); }
#pragma unroll
        for (int m = 0; m < 4; ++m) PLE_CALC(1, m);
#undef PLE_LOAD
#undef PLE_CALC
    }
};

__device__ __forceinline__ int xperm(int d) { const int i = d & 31, n = d >> 5; return 32 * (i >> 4) + 8 * ((i >> 2) & 3) + 4 * n + (i & 3); }
__device__ __forceinline__ int dest_row(int mode, int n) {
    if (mode == 0) return n;
    if (mode == 1) return n < 768 ? n : (n < 832 ? 768 + xperm(n - 768) : n + 192);
    if (mode == 5) { const int h = n / 192, d = n - h * 192; return 256 * h + (d < 128 ? d : 128 + xperm(d - 128)); }
    if (mode == 2) return 256 * (n >> 7) + (n & 127);
    return 256 * (n >> 7) + 128 + (n & 127);
}
struct TDesc { const float* W; bf16* WT; const float* gain; int Nsrc, ldwt, mode, k0, n0, f8; };
__device__ __forceinline__ void tr_load(const TDesc& d, int lane, f32x4 (&r)[16], f32x4& g0, f32x4& g1) {
    const float* src = d.W + (size_t)(d.k0 + (lane >> 4)) * d.Nsrc + d.n0 + 4 * (lane & 15);
#pragma unroll
    for (int i = 0; i < 16; ++i) r[i] = __builtin_nontemporal_load((const f32x4*)(src + (size_t)(4 * i) * d.Nsrc));
    if (d.gain) { g0 = *(const f32x4*)(d.gain + d.k0 + 8 * (lane >> 3)); g1 = *(const f32x4*)(d.gain + d.k0 + 8 * (lane >> 3) + 4); } else { g0 = (f32x4){1.f, 1.f, 1.f, 1.f}; g1 = g0; }
}
__device__ __forceinline__ void tr_lds_write(LAS float* scr, int lane, const f32x4 (&r)[16]) {
    const int kr = lane >> 4, nc = lane & 15;
#pragma unroll
    for (int i = 0; i < 16; ++i) *(LAS f32x4*)(scr + (4 * i + kr) * 64 + 4 * (nc ^ (2 * ((i >> 1) & 7)))) = r[i];
}
__device__ __forceinline__ void tr_store(const TDesc& d, LAS float* scr, int lane, const f32x4& g0, const f32x4& g1) {
    const int nr = lane & 7, c = lane >> 3;
#pragma unroll
    for (int j = 0; j < 8; ++j) { const int n = nr + 8 * j; const LAS float* p = scr + (8 * c) * 64 + 4 * ((n >> 2) ^ (2 * c)) + (n & 3);
        if (d.f8) {
            v2u o8; o8.x = pk4_fp8(p[0 * 64] * g0[0] * F8_SW, p[1 * 64] * g0[1] * F8_SW, p[2 * 64] * g0[2] * F8_SW, p[3 * 64] * g0[3] * F8_SW);
            o8.y = pk4_fp8(p[4 * 64] * g1[0] * F8_SW, p[5 * 64] * g1[1] * F8_SW, p[6 * 64] * g1[2] * F8_SW, p[7 * 64] * g1[3] * F8_SW);
            *(GAS v2u*)((GAS unsigned char*)d.WT + (size_t)(d.n0 + n) * d.ldwt + d.k0 + 8 * c) = o8;
        } else {
        v4u o; o.x = pk2(p[0 * 64] * g0[0], p[1 * 64] * g0[1]); o.y = pk2(p[2 * 64] * g0[2], p[3 * 64] * g0[3]); o.z = pk2(p[4 * 64] * g1[0], p[5 * 64] * g1[1]); o.w = pk2(p[6 * 64] * g1[2], p[7 * 64] * g1[3]);
        *(GAS v4u*)(d.WT + (size_t)dest_row(d.mode, d.n0 + n) * d.ldwt + d.k0 + 8 * c) = o; } }
}
struct Args { const void* in[31]; float* out; unsigned char* ws; int ph_lo, ph_hi; };
typedef const __attribute__((address_space(4))) Args* KA;
__device__ __forceinline__ KA get_ka() { KA p = (KA)__builtin_amdgcn_kernarg_segment_ptr(); asm volatile("" : "+s"(p)); return p; }
#define INF(i) ((const float*)args->in[i])

struct Cplx { float re, im; };
__device__ __forceinline__ void s5_disc(KA args, int g, int p, float& lr, float& li, float& dt) {
    lr = fminf(INF(11)[g * NP + p], -1e-4f); li = INF(12)[g * NP + p]; dt = expf(INF(13)[g]);
}
__device__ __forceinline__ Cplx s5_apow(float lr, float li, float dt, int tau) { const float mag = expf(lr * dt * (float)tau), th = li * dt * (float)tau; float sn, cs; sincosf(th, &sn, &cs); Cplx r; r.re = mag * cs; r.im = mag * sn; return r; }
__device__ __forceinline__ Cplx s5_coef(float lr, float li, float dt) {
    float sn, cs; sincosf(li * dt, &sn, &cs); const float mag = expf(lr * dt), are = mag * cs, aim = mag * sn, den = lr * lr + li * li, nre = are - 1.0f, nim = aim;
    Cplx r; r.re = (nre * lr + nim * li) / den; r.im = (nim * lr - nre * li) / den; return r;
}
__device__ __forceinline__ void s5_tables(KA args, LAS unsigned char* lds, int gw, int NGW) {
    unsigned char* ws = args->ws; const int tid = fresh_tid(), lane = tid & 63;
    { LAS float* AP = (LAS float*)lds; LAS float* CF = AP + 512; LAS float* CR = CF + 128; LAS float* CI = CR + 1040; LAS float* BR = CI + 1040; LAS float* BI = BR + 1024;
      for (int item = blockIdx.x; item < NG * 4; item += gridDim.x) {
        const int g = item >> 2, tq = item & 3;
        __syncthreads();
        if (tid < 256) { const int tl = tid >> 6, p = tid & 63; float lr, li, dt; s5_disc(args, g, p, lr, li, dt); const Cplx a = s5_apow(lr, li, dt, 4 * tq + tl); AP[tid * 2] = (float)a.re; AP[tid * 2 + 1] = (float)a.im; }
        else if (tid < 320) { const int p = tid - 256; float lr, li, dt; s5_disc(args, g, p, lr, li, dt); const Cplx c = s5_coef(lr, li, dt); CF[p * 2] = (float)c.re; CF[p * 2 + 1] = (float)c.im; }
#pragma unroll
        for (int e = 0; e < 2; ++e) { const int idx = tid + 512 * e; CR[(idx >> 6) * 65 + (idx & 63)] = INF(16)[(size_t)g * 1024 + idx]; CI[(idx >> 6) * 65 + (idx & 63)] = INF(17)[(size_t)g * 1024 + idx];
            BR[idx] = INF(14)[(size_t)g * 1024 + idx]; BI[idx] = INF(15)[(size_t)g * 1024 + idx]; }
        __syncthreads();
#pragma unroll
        for (int e = 0; e < 2; ++e) { const int idx = tid + 512 * e, p = idx >> 4; const float fr_ = CF[p * 2], fi_ = CF[p * 2 + 1], br = BR[idx], bi = BI[idx]; BR[idx] = fr_ * br - fi_ * bi; BI[idx] = fr_ * bi + fi_ * br; }
        __syncthreads();
#pragma unroll
        for (int e = 0; e < 2; ++e) { const int idx = tid * 2 + e, tl = idx >> 8, hh = idx & 255, hp = hh >> 4, h = hh & 15, tau = 4 * tq + tl; float acc = 0.f;
#pragma unroll 8
            for (int p = 0; p < NP; ++p) { const float cr = CR[hp * 65 + p], ci = CI[hp * 65 + p], ar = AP[(tl * 64 + p) * 2], ai = AP[(tl * 64 + p) * 2 + 1];
                const float cbr = cr * ar - ci * ai, cbi = cr * ai + ci * ar; acc += cbr * BR[p * 16 + h] - cbi * BI[p * 16 + h]; }
            if (tau == 0 && h == hp) acc += INF(18)[g * GH + hp];
            ((float*)(ws + WS_MT))[(size_t)(g * 16 + tau) * 256 + hh] = acc; }
      }
      __syncthreads(); }
    const int gt = gw * 64 + lane, NT = NGW * 64;
    for (int idx = gt; idx < NG * NP * TC; idx += NT) { const int g = idx >> 10, p = (idx >> 4) & 63, i = idx & 15; float lr, li, dt; s5_disc(args, g, p, lr, li, dt);
        const Cplx a = s5_apow(lr, li, dt, 15 - i), c = s5_coef(lr, li, dt); float vr[16], vi[16];
#pragma unroll
        for (int h = 0; h < GH; ++h) { const float br = INF(14)[(size_t)(g * NP + p) * GH + h], bi = INF(15)[(size_t)(g * NP + p) * GH + h], bbr = c.re * br - c.im * bi, bbi = c.re * bi + c.im * br;
            vr[h] = (float)(a.re * bbr - a.im * bbi); vi[h] = (float)(a.re * bbi + a.im * bbr); }
        bf16* pr = (bf16*)(ws + WS_PALL) + (size_t)(g * 256 + p) * 256 + i * 16; bf16* pi = pr + (size_t)64 * 256; v4u w;
        w.x = pk2(vr[0], vr[1]); w.y = pk2(vr[2], vr[3]); w.z = pk2(vr[4], vr[5]); w.w = pk2(vr[6], vr[7]); *(v4u*)pr = w;
        w.x = pk2(vr[8], vr[9]); w.y = pk2(vr[10], vr[11]); w.z = pk2(vr[12], vr[13]); w.w = pk2(vr[14], vr[15]); *(v4u*)(pr + 8) = w;
        w.x = pk2(vi[0], vi[1]); w.y = pk2(vi[2], vi[3]); w.z = pk2(vi[4], vi[5]); w.w = pk2(vi[6], vi[7]); *(v4u*)pi = w;
        w.x = pk2(vi[8], vi[9]); w.y = pk2(vi[10], vi[11]); w.z = pk2(vi[12], vi[13]); w.w = pk2(vi[14], vi[15]); *(v4u*)(pi + 8) = w; }
    for (int idx = gt; idx < NG * 128 * 32; idx += NT) { const int g = idx >> 12, r = (idx >> 5) & 127, c = idx & 31; *(v4u*)((bf16*)(ws + WS_PALL) + (size_t)(g * 256 + 128 + r) * 256 + c * 8) = (v4u){0u, 0u, 0u, 0u}; }
    for (int idx = gt; idx < NG * TC * NP; idx += NT) { const int g = idx >> 10, j = (idx >> 6) & 15, p = idx & 63; float lr, li, dt; s5_disc(args, g, p, lr, li, dt); const Cplx a = s5_apow(lr, li, dt, j + 1);
        float crv[GH], civ[GH];
#pragma unroll
        for (int hp = 0; hp < GH; ++hp) { crv[hp] = INF(16)[(size_t)(g * GH + hp) * NP + p]; civ[hp] = INF(17)[(size_t)(g * GH + hp) * NP + p]; }
#pragma unroll
        for (int hp = 0; hp < GH; ++hp) { const float cr = crv[hp], ci = civ[hp];
            bf16* wrow = (bf16*)(ws + WS_WALL) + (size_t)(g * 256 + j * 16 + hp) * ASLD + 256 + p; wrow[0] = (bf16)f2bf((float)(cr * a.re - ci * a.im)); wrow[64] = (bf16)f2bf((float)(-(cr * a.im + ci * a.re))); } }
    for (int idx = gt; idx < NG * NP; idx += NT) { float lr, li, dt; s5_disc(args, idx >> 6, idx & 63, lr, li, dt); const Cplx a = s5_apow(lr, li, dt, 16); ((float*)(ws + WS_A16))[2 * idx] = (float)a.re; ((float*)(ws + WS_A16))[2 * idx + 1] = (float)a.im; }
}
__device__ __forceinline__ void s5_fill_w(KA args, int gw, int NGW) {
    unsigned char* ws = args->ws; const int lane = fresh_tid() & 63; const float* MT = (const float*)(ws + WS_MT);
    const int st = NGW * 64;
    for (int i0 = gw * 64 + lane; i0 < NG * 256 * 32; i0 += 4 * st) { f32x4 av[4], bv[4];
#pragma unroll
        for (int q = 0; q < 4; ++q) { const int idx = i0 + q * st < NG * 256 * 32 ? i0 + q * st : i0; const int g = idx >> 13, n = (idx >> 5) & 255, ck = idx & 31, k0 = ck * 8, i = k0 >> 4, h0 = k0 & 15, j = n >> 4, hp = n & 15;
            const float* src = MT + (size_t)(g * 16 + (j >= i ? j - i : 0)) * 256 + hp * 16 + h0; av[q] = *(const f32x4*)src; bv[q] = *(const f32x4*)(src + 4); }
#pragma unroll
        for (int q = 0; q < 4; ++q) { const int idx = i0 + q * st; if (idx < NG * 256 * 32) { const int g = idx >> 13, n = (idx >> 5) & 255, ck = idx & 31, k0 = ck * 8, i = k0 >> 4, j = n >> 4;
            v4u w = (v4u){0u, 0u, 0u, 0u};
            if (j >= i) { w.x = pk2(av[q][0], av[q][1]); w.y = pk2(av[q][2], av[q][3]); w.z = pk2(bv[q][0], bv[q][1]); w.w = pk2(bv[q][2], bv[q][3]); }
            *(v4u*)((bf16*)(ws + WS_WALL) + (size_t)(g * 256 + n) * ASLD + k0) = w; } } }
}
#ifdef PROBE_A
#define PSTAMP(k) do { if (blockIdx.x == 0 && threadIdx.x == 0) ((unsigned long long*)(args->ws + 524288))[k] = __builtin_amdgcn_s_memrealtime(); } while (0)
#else
#define PSTAMP(k) do { } while (0)
#endif
__device__ __forceinline__ void prologue_streams(KA args, LAS unsigned char* lds, int gw, int NGW, int wave) {
    unsigned char* ws = args->ws; const int lane = fresh_tid() & 63;
    LAS float* scr = (LAS float*)(lds + wave * 16384);
    constexpr int I0 = 32 * 29, I1 = 8 * 24, I2 = 4 * 32, I3 = 16 * 16, I4 = 16 * 32, I5 = 16 * 32, I6 = 32 * 88, I7 = 32 * 88, I8 = 88 * 32, I9 = 32 * 32, I10 = 4 * 32;
    constexpr int NITEMS = I0 + I1 + I2 + I3 + I4 + I5 + I6 + I7 + I8 + I9 + I10;
#define TR_DESC(d, it_) do { int r_ = (it_); int nb_; d.f8 = 0; \
        if (r_ < I0) { d.W = INF(4); d.Nsrc = 1856; d.WT = (bf16*)(ws + WS_WIN); d.ldwt = 2048; d.gain = INF(3); d.mode = 1; nb_ = 29; } \
        else if ((r_ -= I0) < I1) { d.W = INF(6); d.Nsrc = 1536; d.WT = (bf16*)(ws + WS_WUQ); d.ldwt = 512; d.gain = INF(5); d.mode = 5; nb_ = 24; } \
        else if ((r_ -= I1) < I2) { d.W = INF(8); d.Nsrc = 2048; d.WT = (bf16*)(ws + WS_WUKV); d.ldwt = 256; d.gain = INF(7); d.mode = 0; nb_ = 32; } \
        else if ((r_ -= I2) < I3) { d.W = INF(19); d.Nsrc = 1024; d.WT = (bf16*)(ws + WS_WGLU); d.ldwt = 1024; d.gain = nullptr; d.mode = 0; nb_ = 16; } \
        else if ((r_ -= I3) < I4) { d.W = INF(23); d.Nsrc = 2048; d.WT = (bf16*)(ws + WS_WO); d.ldwt = 2048; d.gain = INF(21); d.mode = 0; nb_ = 32; } \
        else if ((r_ -= I4) < I5) { d.W = INF(23) + (size_t)1024 * 2048; d.Nsrc = 2048; d.WT = (bf16*)(ws + WS_WO) + 1024; d.ldwt = 2048; d.gain = INF(22); d.mode = 0; nb_ = 32; } \
        else if ((r_ -= I5) < I6) { d.W = INF(25); d.Nsrc = FF; d.WT = (bf16*)(ws + WS_WGU); d.ldwt = 2048; d.gain = INF(24); d.mode = 2; nb_ = 88; } \
        else if ((r_ -= I6) < I7) { d.W = INF(26); d.Nsrc = FF; d.WT = (bf16*)(ws + WS_WGU); d.ldwt = 2048; d.gain = INF(24); d.mode = 3; nb_ = 88; } \
        else if ((r_ -= I7) < I8) { d.W = INF(27); d.Nsrc = 2048; d.WT = (bf16*)(ws + WS_WDN); d.ldwt = FF; d.gain = nullptr; d.mode = 0; nb_ = 32; } \
        else if ((r_ -= I8) < I9) { d.W = INF(29); d.Nsrc = 2048; d.WT = (bf16*)(ws + WS_WPG); d.ldwt = 2048; d.gain = INF(28); d.mode = 0; d.f8 = 1; nb_ = 32; } \
        else { r_ -= I9; d.W = INF(30); d.Nsrc = 2048; d.WT = (bf16*)(ws + WS_WPP); d.ldwt = 256; d.gain = nullptr; d.mode = 0; nb_ = 32; } \
        d.k0 = 64 * (r_ / nb_); d.n0 = 64 * (r_ % nb_); } while (0)
    { int it = gw; TDesc d; f32x4 r[16], g0, g1;
      if (it < NITEMS) { TR_DESC(d, it); tr_load(d, lane, r, g0, g1); }
      while (it < NITEMS) {
        tr_lds_write(scr, lane, r);
        const TDesc dc = d; const f32x4 h0 = g0, h1 = g1; const int nit = it + NGW;
        if (nit < NITEMS) { TR_DESC(d, nit); tr_load(d, lane, r, g0, g1); }
        LDS_WAIT(); asm volatile("" ::: "memory");
        tr_store(dc, scr, lane, h0, h1);
        LDS_WAIT(); asm volatile("" ::: "memory");
        it = nit; } }
#undef TR_DESC
    PSTAMP(16);
    { GAS v4u* z = (GAS v4u*)(ws + WS_WIN + (size_t)832 * 2048 * 2); const int n16 = 192 * 2048 * 2 / 16;
      for (int i = gw * 64 + lane; i < n16; i += NGW * 64) z[i] = (v4u){0u, 0u, 0u, 0u}; }
    PSTAMP(17);
    { const int n16 = 8 * 64 * 512 * 2 / 16;
      for (int i = gw * 64 + lane; i < n16; i += NGW * 64) { const int h = i >> 12, r = (i >> 6) & 63, c = i & 63; *(GAS v4u*)((bf16*)(ws + WS_WUQ) + (size_t)(256 * h + 192 + r) * 512 + c * 8) = (v4u){0u, 0u, 0u, 0u}; } }
    for (int r0 = gw; r0 < M; r0 += 4 * NGW) {
        f32x4 v[4][8];
#pragma unroll
        for (int q = 0; q < 4; ++q) { const int r = r0 + q * NGW < M ? r0 + q * NGW : r0; const GAS f32x4* xr = (const GAS f32x4*)(INF(0) + (size_t)r * D) + lane;
#pragma unroll
            for (int j = 0; j < 8; ++j) v[q][j] = __builtin_nontemporal_load(xr + 64 * j); }
#pragma unroll
        for (int q = 0; q < 4; ++q) { const int r = r0 + q * NGW; float s = 0.f;
#pragma unroll
            for (int j = 0; j < 8; ++j) s += (v[q][j][0] * v[q][j][0] + v[q][j][1] * v[q][j][1]) + (v[q][j][2] * v[q][j][2] + v[q][j][3] * v[q][j][3]);
            const float nrm = sqrtf(wave_sum(s) * (1.0f / D) + EPS), rs = 1.0f / nrm;
            if (r < M) { if (lane == 0) ((float*)(ws + RS0_OFF))[r] = nrm;
                GAS v2u* o = (GAS v2u*)((bf16*)(ws + WS_HN) + (size_t)r * D) + lane;
#pragma unroll
                for (int j = 0; j < 8; ++j) { v2u w; w.x = pk2(v[q][j][0] * rs, v[q][j][1] * rs); w.y = pk2(v[q][j][2] * rs, v[q][j][3] * rs); o[64 * j] = w; } } }
    }
    PSTAMP(18);
}
__device__ __forceinline__ void prologue_tables(KA args, LAS unsigned char* lds, int gw, int NGW) {
    unsigned char* ws = args->ws; const int lane = fresh_tid() & 63;
    { const GAS f32x4* p4 = (const GAS f32x4*)INF(1); GAS v2u* o = (GAS v2u*)(ws + WS_PB); const int n4 = M * PLE / 4;
      const int st = NGW * 64;
      for (int i0 = gw * 64 + lane; i0 < n4; i0 += 8 * st) { f32x4 v[8];
#pragma unroll
          for (int q = 0; q < 8; ++q) v[q] = p4[i0 + q * st < n4 ? i0 + q * st : i0];
#pragma unroll
          for (int q = 0; q < 8; ++q) if (i0 + q * st < n4) { v2u w; w.x = pk2(v[q][0], v[q][1]); w.y = pk2(v[q][2], v[q][3]); o[i0 + q * st] = w; } } }
    { float* co = args->out + OUT_COS; float* si = args->out + OUT_SIN; const int* pos = (const int*)args->in[2];
      const int st = NGW * 64;
      for (int i0 = gw * 64 + lane; i0 < M * 32; i0 += 4 * st) { int pv[4];
#pragma unroll
          for (int q = 0; q < 4; ++q) pv[q] = pos[(i0 + q * st < M * 32 ? i0 + q * st : i0) >> 5];
#pragma unroll
          for (int q = 0; q < 4; ++q) { const int i = i0 + q * st; if (i < M * 32) { float sn, cs; sincosf((float)pv[q] * exp2f(-(float)(i & 31) * (13.287712379549449f / 32.0f)), &sn, &cs); co[i] = cs; si[i] = sn; } } } }
    PSTAMP(19);
    s5_tables(args, lds, gw, NGW);
    PSTAMP(20);
}

__device__ __forceinline__ void phase_prologue(KA args, LAS unsigned char* lds, int gw, int NGW, int wave) {
    const bool tables_first = ((blockIdx.x >> 3) & 1) != 0;
    if (tables_first) { prologue_tables(args, lds, gw, NGW); __syncthreads(); }
    prologue_streams(args, lds, gw, NGW, wave);
    if (!tables_first) { __syncthreads(); prologue_tables(args, lds, gw, NGW); }
}

__device__ __forceinline__ void phase_attn(KA args, char* lds) {
    unsigned char* ws = args->ws;
    const bf16* Q = (const bf16*)(ws + WS_Q); const bf16* K = (const bf16*)(ws + WS_K); const bf16* V = (const bf16*)(ws + WS_V); bf16* OA = (bf16*)(ws + WS_Z); float* sqa = (float*)(ws + SQ_A);
    for (int L = blockIdx.x; L < NB * NH * 4; L += gridDim.x) {
        const int bh = (L & 7) + 8 * (L >> 5), y = (L >> 3) & 3, b = bh / NH, h = bh % NH;
        for (int pass = 0; pass < 2; ++pass) { const int qb = pass ? 7 - y : y;
            att::attn_block(Q + ((size_t)bh * SEQ + qb * 256) * DQK, K + (size_t)bh * SEQ * DQK, V + (size_t)bh * SEQ * DV,
                            OA + ((size_t)(b * SEQ + qb * 256)) * 2048 + h * DV, 2048, sqa + b * SEQ + qb * 256, qb * 256, lds); }
    }
}

struct GroupOrder {
    int G, c;
    __device__ __forceinline__ bool next(int i, Unit& u) const { const int L = i * G + c; if (L >= NG * 4) return false; u.pm = L; u.pn = L >> 2; return true; }
    __device__ __forceinline__ void a_ready(const Unit&) const {}
    __device__ __forceinline__ void done(const Unit&) const {}
};
template <class Epi, bool ALIGN = PG8_ALIGN> __device__ __forceinline__ void run_gemm_grp(LAS unsigned char* lds, const bf16* A, int lda, const bf16* Bt, int ldb, int K, const Epi& E) {
    pg8::Gemm g{A, Bt, NG * SROWS, NG * 256, K, lda, ldb}; GroupOrder S{(int)gridDim.x, (int)blockIdx.x};
    pg8::gemm_phase<Epi, GroupOrder, ALIGN, PG8_SP2>(lds, g, S, E);
}
template <class Epi> __device__ __forceinline__ void run_gemm(LAS unsigned char* lds, const bf16* A, int lda, const bf16* Bt, int ldb, int N, int K, const Epi& E) {
    pg8::Gemm g{A, Bt, M, N, K, lda, ldb}; pg8::StaticOrder S; S.init(M, N, (int)gridDim.x, (int)blockIdx.x);
    pg8::gemm_phase<Epi, pg8::StaticOrder, PG8_ALIGN, PG8_SP2>(lds, g, S, E);
}

__global__ void __launch_bounds__(NWAVES * 64, 2) mega_fwd(Args kernel_args) {
    extern __shared__ __attribute__((aligned(16))) unsigned char lds_raw[];
    LAS unsigned char* lds = (LAS unsigned char*)lds_raw;
    volatile LAS unsigned* MISC = (volatile LAS unsigned*)(lds + MISC_OFF);
    const int wave = __builtin_amdgcn_readfirstlane((int)threadIdx.x >> 6);
    const int G = gridDim.x; const int bx = blockIdx.x; const int vcu = (G % 8 == 0) ? (bx % 8) * (G / 8) + bx / 8 : bx;
    const int gw = vcu * NWAVES + wave, NGW = G * NWAVES;
    unsigned char* ws0; int lo, hi; { KA args = get_ka(); ws0 = args->ws; lo = args->ph_lo; hi = args->ph_hi; }
    for (int u = fresh_tid(); u < (LDS_BYTES - 139264) / 4; u += NWAVES * 64) ((LAS unsigned*)(lds + 139264))[u] = 0u;
    __syncthreads();
    XcdBarrier bar; bar.bar = (unsigned*)(ws0 + WS_CTL) + CW_BAR; bar.x = 0; bar.st = nullptr; bar.members = 0; XcdBarrier barg = bar;
    if (hi - lo > 1) { bar = xcd_barrier_post((unsigned*)(ws0 + WS_CTL) + CW_BAR, MISC + 8, (unsigned)G);
        if ((G & 7) == 0) barg = xcd_barrier_post((unsigned*)(ws0 + WS_CTL) + CW_GBAR + (bx & 7) * 4096, MISC + 10, (unsigned)G / 8u); else barg = bar; }
#ifdef PROBE_A
#define STAMP(k) do { if (blockIdx.x == 0 && threadIdx.x == 0) ((unsigned long long*)(ws0 + 524288))[k] = __builtin_amdgcn_s_memrealtime(); } while (0)
#else
#define STAMP(k) do { } while (0)
#endif
#define IN(k) (lo <= (k) && (k) < hi)
#define SEAM(k) do { if (IN(k) && IN((k) + 1)) xcd_barrier(bar); STAMP((k) + 1); } while (0)
#define SEAMG(k) do { if (IN(k) && IN((k) + 1)) xcd_barrier(barg); STAMP((k) + 1); } while (0)
    STAMP(0);
#define PH_BEGIN KA args = get_ka(); unsigned char* ws = args->ws; float* sqq = (float*)(ws + SQ_Q); float* sqkv = (float*)(ws + SQ_KV); float* sqx1 = (float*)(ws + SQ_X1); float* sqx2 = (float*)(ws + SQ_X2); (void)sqq; (void)sqkv; (void)sqx1; (void)sqx2;

    if (IN(0)) { PH_BEGIN phase_prologue(args, lds, gw, NGW, wave); __syncthreads(); }
    SEAM(0);
    if (IN(1)) { PH_BEGIN s5_fill_w(args, gw, NGW);
        EpiZ E{(bf16*)(ws + WS_Z), (bf16*)(ws + WS_AS), sqq, sqkv, (float*)(ws + SQ_KR), (bf16*)(args->out + OUT_KR), args->out + OUT_COS, args->out + OUT_SIN, INF(10)}; run_gemm(lds, (const bf16*)(ws + WS_HN), D, (const bf16*)(ws + WS_WIN), D, 2048, D, E); }
    SEAM(1);
    if (IN(2)) { PH_BEGIN
        { EpiQ E{(bf16*)(ws + WS_Q), sqq, args->out + OUT_COS, args->out + OUT_SIN, INF(9), (LAS float*)(lds + RING_BYTES)}; run_gemm(lds, (const bf16*)(ws + WS_Z) + ZC_Q, ZLD, (const bf16*)(ws + WS_WUQ), QL, 2048, QL, E); }
        PSTAMP(21);
        { EpiKV E{(bf16*)(ws + WS_K), (bf16*)(ws + WS_V), sqkv, (const float*)(ws + SQ_KR), (const bf16*)(args->out + OUT_KR), INF(10), (LAS float*)(lds + RING_BYTES)}; run_gemm(lds, (const bf16*)(ws + WS_Z) + ZC_KV, ZLD, (const bf16*)(ws + WS_WUKV), KVL, 2048, KVL, E); }
        PSTAMP(22);
        { EpiE E{(bf16*)(ws + WS_AS), (const float*)(ws + WS_A16)}; run_gemm_grp<EpiE, false>(lds, (const bf16*)(ws + WS_AS), ASLD, (const bf16*)(ws + WS_PALL), 256, 256, E); }
        asm volatile("s_waitcnt vmcnt(0)" ::: "memory"); __syncthreads();
        PSTAMP(23);
        { EpiY E{(bf16*)(ws + WS_YG)}; run_gemm_grp(lds, (const bf16*)(ws + WS_AS), ASLD, (const bf16*)(ws + WS_WALL), ASLD, ASLD, E); }
    }
    SEAM(2);
    if (IN(3)) { PH_BEGIN
        { EpiGlu E{(const bf16*)(ws + WS_YG), INF(20), (bf16*)(ws + WS_Z) + 1024, (float*)(ws + SQ_S)}; run_gemm(lds, (const bf16*)(ws + WS_YG), M * 16  , (const bf16*)(ws + WS_WGLU), SSMW, SSMW, SSMW, E); }
        PSTAMP(24); phase_attn(args, (char*)lds_raw); __syncthreads(); PSTAMP(25);
    }
    SEAM(3);
    if (IN(4)) { PH_BEGIN
        const bool pp_first = ((blockIdx.x >> 3) & 1) != 0;
        if (pp_first) { EpiPlain E{(bf16*)(ws + WS_PP), D}; run_gemm(lds, (const bf16*)(ws + WS_PB), PLE, (const bf16*)(ws + WS_WPP), PLE, D, PLE, E); }
        { EpiWo E{(const float*)(ws + RS0_OFF), (bf16*)(ws + WS_HN), sqx1, (const float*)(ws + SQ_A), (const float*)(ws + SQ_S)}; run_gemm(lds, (const bf16*)(ws + WS_Z), D, (const bf16*)(ws + WS_WO), D, D, D, E); }
        if (!pp_first) { EpiPlain E{(bf16*)(ws + WS_PP), D}; run_gemm(lds, (const bf16*)(ws + WS_PB), PLE, (const bf16*)(ws + WS_WPP), PLE, D, PLE, E); }
    }
    SEAMG(4);
    if (IN(5)) { PH_BEGIN
        { EpiGateUp E{(bf16*)(ws + WS_H), sqx1}; run_gemm(lds, (const bf16*)(ws + WS_HN), D, (const bf16*)(ws + WS_WGU), D, 2 * FF, D, E); }
    }
    SEAMG(5);
    if (IN(6)) { PH_BEGIN EpiDown E{(bf16*)(ws + WS_HN), sqx2, ws + WS_Z  }; run_gemm(lds, (const bf16*)(ws + WS_H), FF, (const bf16*)(ws + WS_WDN), FF, D, FF, E); }
    SEAMG(6);
    if (IN(7)) { PH_BEGIN EpiPle E{args->out, (const bf16*)(ws + WS_HN), (const bf16*)(ws + WS_PP), sqx2}; run_gemm(lds, (const bf16*)(ws + WS_Z), D / 2, (const bf16*)(ws + WS_WPG), D / 2, D, D / 2, E); }
#ifdef PROBE_A
    xcd_barrier(bar); STAMP(NPHASES);
    if (blockIdx.x == 0 && threadIdx.x == 0) { const unsigned long long* st = (const unsigned long long*)(ws0 + 524288);
        const unsigned long long t1 = st[NPHASES], d = 8ull * (st[PROBE_B] - st[PROBE_A]);
        while (__builtin_amdgcn_s_memrealtime() - t1 < d) __builtin_amdgcn_s_sleep(8); }
#endif
#undef IN
#undef SEAM
#undef SEAMG
}

extern "C" void kernel_launch(void* const* d_in, const int* in_sizes, int n_in, void* d_out, int out_size, void* d_ws, size_t ws_size, hipStream_t stream) {
    static int grid = 0;
    if (grid == 0) {
        if (n_in != 31 || out_size != M * D || ws_size < WS_END) { fprintf(stderr, "kernel_launch: unexpected shapes (n_in %d, out %d, ws %zu)\n", n_in, out_size, ws_size); grid = -1; return; }
        int dev = 0, cus = 0;
        if (hipGetDevice(&dev) != hipSuccess || hipDeviceGetAttribute(&cus, hipDeviceAttributeMultiprocessorCount, dev) != hipSuccess) { grid = -1; return; }
        if (hipFuncSetAttribute((const void*)mega_fwd, hipFuncAttributeMaxDynamicSharedMemorySize, LDS_BYTES) != hipSuccess) { fprintf(stderr, "kernel_launch: hipFuncSetAttribute failed\n"); grid = -1; return; }
        int per_cu = 0;
        if (hipOccupancyMaxActiveBlocksPerMultiprocessor(&per_cu, (const void*)mega_fwd, NWAVES * 64, LDS_BYTES) != hipSuccess || per_cu < 1) fprintf(stderr, "kernel_launch: occupancy query says %d blocks/CU\n", per_cu);
        (void)hipGetLastError();
        grid = cus > 0 ? cus : 256;
    }
    if (grid < 0) return;
    (void)hipMemsetAsync((char*)d_ws + WS_CTL, 0, CTL_ZERO_BYTES, stream);
    Args a{};
    for (int i = 0; i < 31; ++i) a.in[i] = d_in[i];
    a.out = (float*)d_out; a.ws = (unsigned char*)d_ws;
    constexpr int NL = MK_N_LAUNCHES;
    for (int li = 0; li < NL; ++li) {
        a.ph_lo = (NL == 1) ? 0 : li; a.ph_hi = (NL == 1) ? NPHASES : li + 1;
        hipLaunchKernelGGL(mega_fwd, dim3(grid), dim3(NWAVES * 64), LDS_BYTES, stream, a);
    }
}
```
